# Optimizing an MI355X kernel written in HIP

```python
import jax, jax.numpy as jnp
from jax import lax
import numpy as np

D_MODEL = 1024
BATCH = 16
SEQ = 4096
DEPTH = 2

HEAD_DIM = 64
SWA_HEADS = 8
SWA_KV_HEADS = 2
SWA_WINDOW = 128
SWA_BLOCK = SWA_WINDOW
RWKV_HEADS = 8
RWKV_DIM = RWKV_HEADS * HEAD_DIM
RWKV_W_LORA = 64
RWKV_A_LORA = 64
RWKV_G_LORA = 128
RWKV_GN_EPS = 64e-5
NSA_HEADS = 16
NSA_KV_HEADS = 4
CMP_LEN = 32
CMP_STRIDE = 16
CMP_HIDDEN = 256
SEL_LEN = 64
N_SEL = 8
NSA_WINDOW = 256
NSA_QBLOCK = 64
N_BRANCH = 3
D_FF = 2816
CONV_WIDTH = 3
NORM_EPS = 1e-6

N_EVEN = (DEPTH + 1) // 2
N_ODD = DEPTH // 2

SWA_Q_COLS = SWA_HEADS * HEAD_DIM
SWA_KV_COLS = SWA_KV_HEADS * HEAD_DIM
SWA_COLS = SWA_Q_COLS + 2 * SWA_KV_COLS
RWKV_SPLITS = (RWKV_DIM, RWKV_DIM, RWKV_DIM, RWKV_W_LORA, RWKV_A_LORA, RWKV_G_LORA)
RWKV_COLS = sum(RWKV_SPLITS)
HY_COLS = SWA_COLS + RWKV_COLS
HY_OUT = SWA_Q_COLS + RWKV_DIM
NSA_KV_COLS = NSA_KV_HEADS * HEAD_DIM
NSA_SPLITS = (NSA_HEADS * HEAD_DIM,) + (NSA_KV_COLS,) * 6 + (NSA_HEADS * N_BRANCH,)
NSA_COLS = sum(NSA_SPLITS)
NSA_OUT = NSA_HEADS * HEAD_DIM

kernel_name = "hybrid_swa_rwkv7_nsa_convffn"


def split_cols(z, sizes):
    return jnp.split(z, [int(c) for c in np.cumsum(sizes)[:-1]], axis=-1)


def rms_norm(x, g):
    xf = x.astype(jnp.float32)
    y = xf * lax.rsqrt(jnp.mean(xf * xf, axis=-1, keepdims=True) + NORM_EPS)
    return (y * g.astype(jnp.float32)).astype(x.dtype)


def alibi_slopes(n_heads):
    return jnp.exp2(-8.0 * jnp.arange(1, n_heads + 1, dtype=jnp.float32) / n_heads)


def masked_softmax(s, valid):
    s = jnp.where(valid, s, -jnp.inf)
    m = jnp.max(s, axis=-1, keepdims=True)
    m = jnp.where(jnp.isfinite(m), m, 0.0)
    p = jnp.where(valid, jnp.exp(s - m), 0.0)
    d = jnp.sum(p, axis=-1, keepdims=True)
    return p / jnp.where(d > 0, d, 1.0)


def swa_sink_attention(q, k, v, sinks, slopes):
    B, T, _ = q.shape
    G, H, D, L = SWA_KV_HEADS, SWA_HEADS, HEAD_DIM, SWA_BLOCK
    R = H // G
    nb = T // L
    f32 = jnp.float32
    qb = q.reshape(B, nb, L, G, R, D).astype(f32) * D ** -0.5

    def band(a):
        a = jnp.pad(a.reshape(B, T, G, D), ((0, 0), (L, 0), (0, 0), (0, 0))).reshape(B, nb + 1, L, G, D)
        return jnp.concatenate([a[:, :-1], a[:, 1:]], axis=2).astype(f32)

    kb, vb = band(k), band(v)
    qpos = jnp.arange(nb)[:, None, None] * L + jnp.arange(L)[None, :, None]
    kpos = jnp.arange(nb)[:, None, None] * L - L + jnp.arange(2 * L)[None, None, :]
    dist = qpos - kpos
    valid = (dist >= 0) & (dist < SWA_WINDOW) & (kpos >= 0)
    s = jnp.einsum('bnqgrd,bnkgd->bngrqk', qb, kb)
    s = s - slopes.reshape(G, R)[None, None, :, :, None, None] * dist.astype(f32)[None, :, None, None]
    s = jnp.where(valid[None, :, None, None], s, -jnp.inf)
    sink = sinks.astype(f32).reshape(G, R)[None, None, :, :, None, None]
    m = jnp.maximum(jnp.max(s, axis=-1, keepdims=True), sink)
    p = jnp.exp(s - m)
    p = p / (jnp.sum(p, axis=-1, keepdims=True) + jnp.exp(sink - m))
    o = jnp.einsum('bngrqk,bnkgd->bnqgrd', p, vb)
    return o.reshape(B, T, H * D)


def rwkv7_time_mix(z, mu, w0, w2, a0, a2, g2, k_k, k_a, r_k, ln_g, ln_b):
    B, T, _ = z.shape
    H, N = RWKV_HEADS, HEAD_DIM
    f32 = jnp.float32
    z_prev = jnp.pad(z, ((0, 0), (1, 0), (0, 0)))[:, :-1]
    z = z + (z_prev - z) * mu
    r, k, v, w_lo, a_lo, g_lo = split_cols(z, RWKV_SPLITS)
    log_w = -jax.nn.softplus(-(w0 + jnp.tanh(w_lo) @ w2).astype(f32)) - 0.5
    decay = jnp.exp(-jnp.exp(log_w))
    a = jax.nn.sigmoid((a0 + a_lo @ a2).astype(f32))
    g = (jax.nn.sigmoid(g_lo) @ g2).astype(f32)
    heads = lambda t: t.astype(f32).reshape(B, T, H, N)
    r, k, v, decay, a = heads(r), heads(k), heads(v), heads(decay), heads(a)
    kk = k * k_k.astype(f32).reshape(H, N)
    kk = kk / jnp.maximum(jnp.linalg.norm(kk, axis=-1, keepdims=True), 1e-12)
    k = k * (1.0 + (a - 1.0) * k_a.astype(f32).reshape(H, N))

    def step(S, inp):
        r_t, w_t, k_t, v_t, kk_t, a_t = inp
        sa = jnp.einsum('bhij,bhj->bhi', S, kk_t)
        S = S * w_t[:, :, None, :] - sa[..., None] * (kk_t * a_t)[:, :, None, :] + v_t[..., None] * k_t[:, :, None, :]
        return S, jnp.einsum('bhij,bhj->bhi', S, r_t)

    seq = tuple(jnp.moveaxis(t, 1, 0) for t in (r, decay, k, v, kk, a))
    _, y = lax.scan(step, jnp.zeros((B, H, N, N), f32), seq)
    y = jnp.moveaxis(y, 0, 1)
    mean = jnp.mean(y, axis=-1, keepdims=True)
    var = jnp.mean(jnp.square(y - mean), axis=-1, keepdims=True)
    y = ((y - mean) * lax.rsqrt(var + RWKV_GN_EPS)).reshape(B, T, RWKV_DIM)
    y = y * ln_g.astype(f32) + ln_b.astype(f32)
    bonus = jnp.sum(r * k * r_k.astype(f32), axis=-1, keepdims=True) * v
    return (y + bonus.reshape(B, T, RWKV_DIM)) * g


def hybrid_swa_rwkv(h, w_in, w_out, sinks, mu, w0, w2, a0, a2, g2, k_k, k_a, r_k, ln_g, ln_b):
    z = h @ w_in
    q, k, v = split_cols(z[..., :SWA_COLS], (SWA_Q_COLS, SWA_KV_COLS, SWA_KV_COLS))
    o_a = swa_sink_attention(q, k, v, sinks, alibi_slopes(SWA_HEADS))
    o_b = rwkv7_time_mix(z[..., SWA_COLS:], mu, w0, w2, a0, a2, g2, k_k, k_a, r_k, ln_g, ln_b)
    o = jnp.concatenate([o_a, o_b], axis=-1).astype(h.dtype)
    return o @ w_out


def compress_blocks(a, idx, pos, w1, w2):
    blocks = a[:, idx] + pos[None, None, :, None, :]
    hdn = jax.nn.gelu(jnp.einsum('bclgd,ldf->bcgf', blocks, w1), approximate=True)
    return jnp.einsum('bcgf,fd->bcgd', hdn, w2)


def nsa_layer(h, w_in, w_out, pos_k, w1_k, w2_k, pos_v, w1_v, w2_v):
    B, T, _ = h.shape
    G, H, D = NSA_KV_HEADS, NSA_HEADS, HEAD_DIM
    R = H // G
    Q = NSA_QBLOCK
    f32 = jnp.float32
    z = h @ w_in
    q, kc, vc, ks, vs, kw, vw, gl = split_cols(z, NSA_SPLITS)
    q = q.reshape(B, T, G, R, D).astype(f32) * D ** -0.5
    kv = lambda t: t.reshape(B, T, G, D)
    kc, vc, ks, vs, kw, vw = kv(kc), kv(vc), kv(ks), kv(vs), kv(kw), kv(vw)
    gates = jax.nn.sigmoid(gl.astype(f32)).reshape(B, T, G, R, N_BRANCH)
    slopes = alibi_slopes(H).reshape(G, R)

    n_cmp = (T - CMP_LEN) // CMP_STRIDE + 1
    cmp_idx = np.arange(n_cmp)[:, None] * CMP_STRIDE + np.arange(CMP_LEN)[None, :]
    k_cmp = compress_blocks(kc, cmp_idx, pos_k, w1_k, w2_k).astype(f32)
    v_cmp = compress_blocks(vc, cmp_idx, pos_v, w1_v, w2_v).astype(f32)
    cmp_end = jnp.asarray(cmp_idx[:, -1], jnp.int32)

    n_blk = T // SEL_LEN
    k_sel = min(N_SEL, n_blk)
    ks_blk = ks.reshape(B, n_blk, SEL_LEN, G, D).transpose(0, 3, 1, 2, 4).astype(f32)
    vs_blk = vs.reshape(B, n_blk, SEL_LEN, G, D).transpose(0, 3, 1, 2, 4).astype(f32)
    ratio, span = SEL_LEN // CMP_STRIDE, CMP_LEN // CMP_STRIDE
    ov = (ratio * np.arange(n_blk)[:, None, None] + np.arange(ratio)[None, :, None]
          - np.arange(span)[None, None, :]).reshape(n_blk, ratio * span)
    ov_valid = jnp.asarray((ov >= 0) & (ov < n_cmp), f32)
    ov = jnp.asarray(np.clip(ov, 0, n_cmp - 1), jnp.int32)
    blk_ids = jnp.arange(n_blk)
    b_ix = jnp.arange(B)[:, None, None, None]
    g_ix = jnp.arange(G)[None, :, None, None]

    kw_pad = jnp.pad(kw, ((0, 0), (NSA_WINDOW, 0), (0, 0), (0, 0))).astype(f32)
    vw_pad = jnp.pad(vw, ((0, 0), (NSA_WINDOW, 0), (0, 0), (0, 0))).astype(f32)

    def block(i):
        t0 = i * Q
        t = t0 + jnp.arange(Q)
        qi = lax.dynamic_slice_in_dim(q, t0, Q, axis=1)
        g_blk = lax.dynamic_slice_in_dim(gates, t0, Q, axis=1)
        dist_c = t[:, None] - cmp_end[None, :]
        s = jnp.einsum('bqgrd,bcgd->bgrqc', qi, k_cmp) - slopes[:, :, None, None] * dist_c.astype(f32)
        p_cmp = masked_softmax(s, dist_c >= 0)
        o_cmp = jnp.einsum('bgrqc,bcgd->bqgrd', p_cmp, v_cmp)
        imp = jnp.sum(jnp.sum(p_cmp, axis=2)[..., ov] * ov_valid, axis=-1)
        cur = (t // SEL_LEN)[:, None]
        forced = (blk_ids == 0) | (blk_ids == cur) | (blk_ids == cur - 1)
        imp = jnp.where(forced, jnp.inf, jnp.where(blk_ids > cur, -jnp.inf, imp))
        _, sel = lax.top_k(imp, k_sel)
        k_g = ks_blk[b_ix, g_ix, sel]
        v_g = vs_blk[b_ix, g_ix, sel]
        kpos = sel[..., None] * SEL_LEN + jnp.arange(SEL_LEN)
        dist_s = (t[:, None, None] - kpos)[:, :, None]
        s = jnp.einsum('bqgrd,bgqnkd->bgrqnk', qi, k_g) - slopes[None, :, :, None, None, None] * dist_s.astype(f32)
        p = masked_softmax(s.reshape(B, G, R, Q, k_sel * SEL_LEN), (dist_s >= 0).reshape(B, G, 1, Q, k_sel * SEL_LEN))
        o_slc = jnp.einsum('bgrqnk,bgqnkd->bqgrd', p.reshape(s.shape), v_g)
        kwi = lax.dynamic_slice_in_dim(kw_pad, t0, NSA_WINDOW + Q, axis=1)
        vwi = lax.dynamic_slice_in_dim(vw_pad, t0, NSA_WINDOW + Q, axis=1)
        kp = t0 - NSA_WINDOW + jnp.arange(NSA_WINDOW + Q)
        dist_w = t[:, None] - kp[None, :]
        valid_w = (dist_w >= 0) & (dist_w < NSA_WINDOW) & (kp[None, :] >= 0)
        s = jnp.einsum('bqgrd,bkgd->bgrqk', qi, kwi) - slopes[:, :, None, None] * dist_w.astype(f32)
        o_win = jnp.einsum('bgrqk,bkgd->bqgrd', masked_softmax(s, valid_w), vwi)
        return g_blk[..., 0, None] * o_cmp + g_blk[..., 1, None] * o_slc + g_blk[..., 2, None] * o_win

    o = lax.map(block, jnp.arange(T // Q))
    o = jnp.moveaxis(o, 0, 1).reshape(B, T, NSA_OUT).astype(h.dtype)
    return o @ w_out


def conv_ffn(h, w_up, conv_w, conv_b, w_down):
    T = h.shape[1]
    gate, val = jnp.split(h @ w_up, 2, axis=-1)
    gp = jnp.pad(gate, ((0, 0), (CONV_WIDTH - 1, 0), (0, 0)))
    conv = conv_b + gp[:, CONV_WIDTH - 1:] * conv_w[CONV_WIDTH - 1]
    for j in range(CONV_WIDTH - 1):
        conv = conv + gp[:, j:j + T] * conv_w[j]
    return (jax.nn.gelu(conv, approximate=True) * val) @ w_down


def setup_inputs(seed: int = 0) -> dict:
    key = jax.random.key(seed)
    keys = iter(jax.random.split(key, 48))
    f32 = jnp.float32
    nrm = lambda shape, scale: jax.random.normal(next(keys), shape, f32) * scale
    uni = lambda shape, lo, hi: jax.random.uniform(next(keys), shape, f32, lo, hi)
    NE, NO = N_EVEN, N_ODD
    return {
        "x": nrm((BATCH, SEQ, D_MODEL), 1.0),
        "mix_pre_g": 1.0 + nrm((DEPTH, D_MODEL), 0.05),
        "mix_post_g": 1.0 + nrm((DEPTH, D_MODEL), 0.05),
        "ffn_pre_g": 1.0 + nrm((DEPTH, D_MODEL), 0.05),
        "ffn_post_g": 1.0 + nrm((DEPTH, D_MODEL), 0.05),
        "hy_w_in": nrm((NE, D_MODEL, HY_COLS), D_MODEL ** -0.5),
        "hy_w_out": nrm((NE, HY_OUT, D_MODEL), HY_OUT ** -0.5),
        "swa_sinks": nrm((NE, SWA_HEADS), 0.5),
        "rwkv_mu": uni((NE, RWKV_COLS), 0.0, 1.0),
        "rwkv_w0": uni((NE, RWKV_DIM), -5.0, -1.0),
        "rwkv_w2": nrm((NE, RWKV_W_LORA, RWKV_DIM), 0.1),
        "rwkv_a0": nrm((NE, RWKV_DIM), 0.1),
        "rwkv_a2": nrm((NE, RWKV_A_LORA, RWKV_DIM), 0.1),
        "rwkv_g2": nrm((NE, RWKV_G_LORA, RWKV_DIM), RWKV_G_LORA ** -0.5),
        "rwkv_k_k": 0.85 + nrm((NE, RWKV_DIM), 0.05),
        "rwkv_k_a": 1.0 + nrm((NE, RWKV_DIM), 0.05),
        "rwkv_r_k": nrm((NE, RWKV_HEADS, HEAD_DIM), 0.1),
        "rwkv_ln_g": 1.0 + nrm((NE, RWKV_DIM), 0.05),
        "rwkv_ln_b": nrm((NE, RWKV_DIM), 0.01),
        "nsa_w_in": nrm((NO, D_MODEL, NSA_COLS), D_MODEL ** -0.5),
        "nsa_w_out": nrm((NO, NSA_OUT, D_MODEL), NSA_OUT ** -0.5),
        "nsa_cmp_pos_k": nrm((NO, CMP_LEN, HEAD_DIM), 0.1),
        "nsa_cmp_w1_k": nrm((NO, CMP_LEN, HEAD_DIM, CMP_HIDDEN), (CMP_LEN * HEAD_DIM) ** -0.5),
        "nsa_cmp_w2_k": nrm((NO, CMP_HIDDEN, HEAD_DIM), CMP_HIDDEN ** -0.5),
        "nsa_cmp_pos_v": nrm((NO, CMP_LEN, HEAD_DIM), 0.1),
        "nsa_cmp_w1_v": nrm((NO, CMP_LEN, HEAD_DIM, CMP_HIDDEN), (CMP_LEN * HEAD_DIM) ** -0.5),
        "nsa_cmp_w2_v": nrm((NO, CMP_HIDDEN, HEAD_DIM), CMP_HIDDEN ** -0.5),
        "ffn_w_up": nrm((DEPTH, D_MODEL, 2 * D_FF), D_MODEL ** -0.5),
        "ffn_conv_w": nrm((DEPTH, CONV_WIDTH, D_FF), CONV_WIDTH ** -0.5),
        "ffn_conv_b": nrm((DEPTH, D_FF), 0.01),
        "ffn_w_down": nrm((DEPTH, D_FF, D_MODEL), D_FF ** -0.5),
    }


def reference(x, mix_pre_g, mix_post_g, ffn_pre_g, ffn_post_g, hy_w_in, hy_w_out, swa_sinks,
              rwkv_mu, rwkv_w0, rwkv_w2, rwkv_a0, rwkv_a2, rwkv_g2, rwkv_k_k, rwkv_k_a, rwkv_r_k,
              rwkv_ln_g, rwkv_ln_b, nsa_w_in, nsa_w_out, nsa_cmp_pos_k, nsa_cmp_w1_k, nsa_cmp_w2_k,
              nsa_cmp_pos_v, nsa_cmp_w1_v, nsa_cmp_w2_v, ffn_w_up, ffn_conv_w, ffn_conv_b, ffn_w_down):
    for layer in range(DEPTH):
        i = layer // 2
        h = rms_norm(x, mix_pre_g[layer])
        if layer % 2 == 0:
            m = hybrid_swa_rwkv(h, hy_w_in[i], hy_w_out[i], swa_sinks[i], rwkv_mu[i], rwkv_w0[i],
                                rwkv_w2[i], rwkv_a0[i], rwkv_a2[i], rwkv_g2[i], rwkv_k_k[i],
                                rwkv_k_a[i], rwkv_r_k[i], rwkv_ln_g[i], rwkv_ln_b[i])
        else:
            m = nsa_layer(h, nsa_w_in[i], nsa_w_out[i], nsa_cmp_pos_k[i], nsa_cmp_w1_k[i],
                          nsa_cmp_w2_k[i], nsa_cmp_pos_v[i], nsa_cmp_w1_v[i], nsa_cmp_w2_v[i])
        x = x + rms_norm(m, mix_post_g[layer])
        h = rms_norm(x, ffn_pre_g[layer])
        x = x + rms_norm(conv_ffn(h, ffn_w_up[layer], ffn_conv_w[layer], ffn_conv_b[layer], ffn_w_down[layer]),
                         ffn_post_g[layer])
    return x
```

```cpp
#include <hip/hip_runtime.h>
#include <hip/hip_cooperative_groups.h>
#include <cstdio>
#include <cstdint>
namespace cg = cooperative_groups;

#ifndef ONE_LAUNCH
#define ONE_LAUNCH 0
#endif

namespace pg8 {
#define PG8_LAS __attribute__((address_space(3)))
typedef unsigned short bf16_t;
typedef short bf16x8 __attribute__((ext_vector_type(8)));
typedef float f32x4 __attribute__((ext_vector_type(4)));
typedef unsigned u32x4 __attribute__((ext_vector_type(4)));
constexpr int BM = 256, BK = 64, HALF = 128, HTB = HALF * BK * 2  , STAGE_BYTES = 8 * HTB, NXCD = 8, WGM = 8;

__host__ __device__ __forceinline__ int lds_byte(int r, int c) { const int st = (r >> 4) * 2 + (c >> 5), rr = r & 15, cc = c & 31, ob = rr * 64 + cc * 2; return st * 1024 + (ob ^ (((ob >> 9) & 1) << 5)); }
__host__ __device__ __forceinline__ void stage_rc(int b, int& R, int& C) { const int st = b / 1024, sb = b % 1024, swz = sb ^ (((sb >> 9) & 1) << 5); R = (st >> 1) * 16 + swz / 64; C = (st & 1) * 32 + (swz % 64) / 2; }
__host__ __device__ __forceinline__ int perm32(int rho) { const int n = rho >> 4, i = rho & 15; return 8 * (i >> 2) + 4 * n + (i & 3); }

struct Unit { int pm, pn; };
struct Gemm { const bf16_t* A; const bf16_t* Bt; int M, N, K; int lda; size_t a_kstep; int amode; };
__device__ __forceinline__ const char* a_base(const Gemm& g, int pm) { return g.amode == 0 ? (const char*)g.A + (size_t)pm * ((size_t)BM * g.lda * 2) : (const char*)g.A + (size_t)(pm >> 2) * ((size_t)4096 * 2816 * 2) + (size_t)(pm & 3) * 128; }

struct StaticOrder {
    int nM, nN, nwg, G, c;
    __host__ __device__ void init(int M, int N, int G_, int c_) { nM = M / BM; nN = N / BM; nwg = nM * nN; G = G_; c = c_; }
    __host__ __device__ bool next(int i, Unit& u) const {
        const long L = (long)i * G + c; if (L >= nwg) return false;
        int wgid = (int)L; { const int q = nwg / NXCD, r = nwg % NXCD, xcd = wgid % NXCD, off = wgid / NXCD; wgid = (xcd < r ? xcd * (q + 1) : r * (q + 1) + (xcd - r) * q) + off; }
        const int nig = WGM * nN, gid = wgid / nig, fm = gid * WGM, gsz = (nM - fm) < WGM ? (nM - fm) : WGM;
        u.pm = fm + ((wgid % nig) % gsz); u.pn = (wgid % nig) / gsz; return true;
    }
    __device__ __forceinline__ void a_ready(const Unit&) const {}
    __device__ __forceinline__ void done(const Unit&) const {}
};


__device__ __forceinline__ unsigned cvt_pk_bf16(float lo, float hi) { unsigned r; asm volatile("v_cvt_pk_bf16_f32 %0, %1, %2" : "=v"(r) : "v"(lo), "v"(hi)); return r; }
__device__ __forceinline__ float gelu_tanh(float x) { const float u = 1.5957691216f * (x + 0.044715f * x * x * x); return x / (1.0f + __expf(-u)); }
template <int ACT> struct EpiStore {
    static constexpr bool PERM = true, AFTER_DRAIN = false;
    bf16_t* O; int ldc; const float* bias;
    __device__ __forceinline__ void operator()(const f32x4 (&acc)[2][2][4][2], const Unit& u, int wr, int wc, int fr, int fq) const {
        const int row0 = u.pm * BM + wr * 64 + fr; const int col0 = u.pn * BM + wc * 32 + 8 * fq;
        f32x4 bv[2][2];
#pragma unroll
        for (int bj = 0; bj < 2; ++bj)
#pragma unroll
            for (int n = 0; n < 2; ++n) bv[bj][n] = bias ? *(const f32x4*)(bias + col0 + bj * HALF + 4 * n) : (f32x4){0.f, 0.f, 0.f, 0.f};
#pragma unroll
        for (int ai = 0; ai < 2; ++ai)
#pragma unroll
            for (int m = 0; m < 4; ++m) { bf16_t* rowp = O + (size_t)(row0 + ai * HALF + m * 16) * ldc + col0;
#pragma unroll
                for (int bj = 0; bj < 2; ++bj) { f32x4 v0 = acc[ai][bj][m][0] + bv[bj][0], v1 = acc[ai][bj][m][1] + bv[bj][1];
                    if (ACT == 2) { v0 = (f32x4){gelu_tanh(v0[0]), gelu_tanh(v0[1]), gelu_tanh(v0[2]), gelu_tanh(v0[3])}; v1 = (f32x4){gelu_tanh(v1[0]), gelu_tanh(v1[1]), gelu_tanh(v1[2]), gelu_tanh(v1[3])}; }
                    u32x4 w; w.x = cvt_pk_bf16(v0[0], v0[1]); w.y = cvt_pk_bf16(v0[2], v0[3]); w.z = cvt_pk_bf16(v1[0], v1[1]); w.w = cvt_pk_bf16(v1[2], v1[3]);
                    *(u32x4*)(rowp + bj * HALF) = w; } }
    }
};

template <class Epi, class Sched, bool ALIGN_EPI = false, bool SP2 = false>
__device__ __forceinline__ void gemm_phase(PG8_LAS unsigned char* lds, const Gemm g, const Sched& S, const Epi& E) {
    int tid = threadIdx.x; asm volatile("" : "+v"(tid)); const int wid = __builtin_amdgcn_readfirstlane(tid >> 6), lane = tid & 63, wr = wid >> 2, wc = wid & 3, fr = lane & 15, fq = lane >> 4;
    const int K = g.K, nt = K / BK;
    unsigned voffA[2], voffB[2];
#pragma unroll
    for (int i = 0; i < 2; ++i) { int R, C; stage_rc(tid * 16 + i * 8192, R, C); const int Rb = Epi::PERM ? ((R & ~31) + perm32(R & 31)) : R;
        voffA[i] = (unsigned)(R * g.lda + C) * 2u; voffB[i] = (unsigned)(Rb * K + C) * 2u; }
    const size_t kstep = (size_t)(BK * 2);
    const size_t hstepB = (size_t)HALF * K * 2, hstepA = (size_t)HALF * g.lda * 2, kstepA = g.a_kstep;
    const size_t tstep = 2 * hstepB;
    const unsigned ldsw = (unsigned)wid * 1024u;
    const int aoff = lds_byte(wr * 64 + fr, fq * 8), boff = lds_byte(wc * 32 + fr, fq * 8);
#define PG8_SA(b, h) (((b) * 2 + (h)) * HTB)
#define PG8_SB(b, h) ((4 + (b) * 2 + (h)) * HTB)
#define PG8_STAGE(bufoff, gbase, voff) do { _Pragma("unroll") for (int _i = 0; _i < 2; ++_i) \
        __builtin_amdgcn_global_load_lds((const unsigned*)((const char*)(gbase) + (voff)[_i]), (PG8_LAS unsigned*)(lds + (bufoff) + ldsw + _i * 8192), 16, 0, 0); } while (0)
#define PG8_LDA(dst, b, h) do { _Pragma("unroll") for (int m = 0; m < 4; ++m) _Pragma("unroll") for (int k = 0; k < 2; ++k) dst[m][k] = *(const PG8_LAS bf16x8*)(lds + PG8_SA(b, h) + aoff + m * 2048 + k * 1024); } while (0)
#define PG8_LDB(dst, b, h) do { _Pragma("unroll") for (int n = 0; n < 2; ++n) _Pragma("unroll") for (int k = 0; k < 2; ++k) dst[n][k] = *(const PG8_LAS bf16x8*)(lds + PG8_SB(b, h) + boff + n * 2048 + k * 1024); } while (0)
#define PG8_MMA(ai, bj, At, Bt) do { __builtin_amdgcn_s_setprio(1); _Pragma("unroll") for (int m = 0; m < 4; ++m) _Pragma("unroll") for (int n = 0; n < 2; ++n) _Pragma("unroll") for (int k = 0; k < 2; ++k) \
        acc[ai][bj][m][n] = __builtin_amdgcn_mfma_f32_16x16x32_bf16(Bt[n][k], At[m][k], acc[ai][bj][m][n], 0, 0, 0); __builtin_amdgcn_s_setprio(0); } while (0)
#define PG8_WAIT_V(n) asm volatile("s_waitcnt vmcnt(" #n ")" ::: "memory")
#define PG8_WAIT_L(n) asm volatile("s_waitcnt lgkmcnt(" #n ")" ::: "memory")
#define PG8_BAR __builtin_amdgcn_s_barrier()
#define PG8_SCHED __builtin_amdgcn_sched_barrier(0)
    Unit cur, nxt; int ui = 0;
    if (!S.next(0, cur)) return;
    f32x4 acc[2][2][4][2];
#pragma unroll
    for (int a = 0; a < 2; ++a)
#pragma unroll
        for (int b = 0; b < 2; ++b)
#pragma unroll
            for (int m = 0; m < 4; ++m)
#pragma unroll
                for (int n = 0; n < 2; ++n) acc[a][b][m][n] = (f32x4){0.f, 0.f, 0.f, 0.f};
    bf16x8 At[4][2], B0[2][2], B1[2][2];
    const char* cA = a_base(g, cur.pm); const char* cB = (const char*)g.Bt + (size_t)cur.pn * tstep;
    S.a_ready(cur);
    if constexpr (SP2) {
        PG8_STAGE(PG8_SB(0, 0), cB, voffB); PG8_STAGE(PG8_SB(0, 1), cB + hstepB, voffB); PG8_STAGE(PG8_SA(0, 0), cA, voffA); PG8_STAGE(PG8_SA(0, 1), cA + hstepA, voffA);
        if (wr == 1) PG8_BAR;
        PG8_WAIT_V(2); PG8_BAR;
        PG8_STAGE(PG8_SB(1, 0), cB + kstep, voffB); PG8_STAGE(PG8_SA(1, 0), cA + kstepA, voffA); PG8_STAGE(PG8_SB(1, 1), cB + hstepB + kstep, voffB);
        PG8_WAIT_V(6); PG8_BAR;
    } else {
        PG8_STAGE(PG8_SB(0, 0), cB, voffB); PG8_STAGE(PG8_SA(0, 0), cA, voffA); PG8_STAGE(PG8_SB(0, 1), cB + hstepB, voffB); PG8_STAGE(PG8_SA(0, 1), cA + hstepA, voffA);
        if (wr == 1) PG8_BAR;
        PG8_WAIT_V(4); PG8_BAR;
        PG8_STAGE(PG8_SB(1, 0), cB + kstep, voffB); PG8_STAGE(PG8_SA(1, 0), cA + kstepA, voffA); PG8_STAGE(PG8_SB(1, 1), cB + hstepB + kstep, voffB);
        PG8_WAIT_V(6); PG8_BAR;
    }
    for (;;) {
        const bool has_next = S.next(ui + 1, nxt);
        const char* nA = has_next ? a_base(g, nxt.pm) : cA; const char* nB = has_next ? (const char*)g.Bt + (size_t)nxt.pn * tstep : cB;
        for (int t = 0; t < nt; t += 2) {
            const bool last = (t == nt - 2);
            const char* a1 = cA + (size_t)(t + 1) * kstepA;
            const char* a2 = last ? nA : cA + (size_t)(t + 2) * kstepA; const char* b2 = last ? nB : cB + (size_t)(t + 2) * kstep;
            const char* a3 = a2 + kstepA; const char* b3 = b2 + kstep;
            if (last && has_next) S.a_ready(nxt);
            if constexpr (SP2) {
            PG8_LDB(B0, 0, 0); PG8_LDB(B1, 0, 1); PG8_SCHED; PG8_LDA(At, 0, 0); PG8_STAGE(PG8_SA(1, 1), a1 + hstepA, voffA);
            PG8_WAIT_V(8); PG8_WAIT_L(0); PG8_BAR; PG8_MMA(0, 0, At, B0); PG8_MMA(0, 1, At, B1); PG8_BAR; PG8_SCHED;
            PG8_LDA(At, 0, 1); PG8_STAGE(PG8_SB(0, 0), b2, voffB); PG8_STAGE(PG8_SB(0, 1), b2 + hstepB, voffB); PG8_STAGE(PG8_SA(0, 0), a2, voffA);
            PG8_WAIT_V(8); PG8_WAIT_L(0); PG8_BAR; PG8_MMA(1, 0, At, B0); PG8_MMA(1, 1, At, B1); PG8_BAR; PG8_SCHED;
            PG8_LDB(B0, 1, 0); PG8_LDB(B1, 1, 1); PG8_SCHED; PG8_LDA(At, 1, 0); PG8_STAGE(PG8_SA(0, 1), a2 + hstepA, voffA);
            PG8_WAIT_V(8); PG8_WAIT_L(0); PG8_BAR; PG8_MMA(0, 0, At, B0); PG8_MMA(0, 1, At, B1); PG8_BAR; PG8_SCHED;
            PG8_LDA(At, 1, 1); PG8_STAGE(PG8_SB(1, 0), b3, voffB); PG8_STAGE(PG8_SB(1, 1), b3 + hstepB, voffB); PG8_STAGE(PG8_SA(1, 0), a3, voffA);
            PG8_WAIT_V(8); PG8_WAIT_L(0); PG8_BAR; PG8_MMA(1, 0, At, B0); PG8_MMA(1, 1, At, B1); PG8_BAR; PG8_SCHED;
            } else {
            PG8_LDB(B0, 0, 0); PG8_SCHED; PG8_LDA(At, 0, 0); PG8_STAGE(PG8_SA(1, 1), a1 + hstepA, voffA);
            PG8_WAIT_L(8); PG8_BAR; PG8_WAIT_L(0); PG8_MMA(0, 0, At, B0); PG8_BAR; PG8_SCHED;
            PG8_LDB(B1, 0, 1); PG8_STAGE(PG8_SB(0, 0), b2, voffB);
            PG8_BAR; PG8_WAIT_L(0); PG8_MMA(0, 1, At, B1); PG8_BAR;
            PG8_LDA(At, 0, 1); PG8_STAGE(PG8_SA(0, 0), a2, voffA);
            PG8_BAR; PG8_WAIT_L(0); PG8_MMA(1, 0, At, B0); PG8_BAR; PG8_SCHED;
            PG8_STAGE(PG8_SB(0, 1), b2 + hstepB, voffB);
            PG8_WAIT_V(6); PG8_BAR; PG8_MMA(1, 1, At, B1); PG8_BAR;
            PG8_LDB(B0, 1, 0); PG8_SCHED; PG8_LDA(At, 1, 0); PG8_STAGE(PG8_SA(0, 1), a2 + hstepA, voffA);
            PG8_WAIT_L(8); PG8_BAR; PG8_WAIT_L(0); PG8_MMA(0, 0, At, B0); PG8_BAR; PG8_SCHED;
            PG8_LDB(B1, 1, 1); PG8_STAGE(PG8_SB(1, 0), b3, voffB);
            PG8_BAR; PG8_WAIT_L(0); PG8_MMA(0, 1, At, B1); PG8_BAR;
            PG8_LDA(At, 1, 1); PG8_STAGE(PG8_SA(1, 0), a3, voffA);
            PG8_BAR; PG8_WAIT_L(0); PG8_MMA(1, 0, At, B0); PG8_BAR; PG8_SCHED;
            PG8_STAGE(PG8_SB(1, 1), b3 + hstepB, voffB);
            PG8_WAIT_V(6); PG8_BAR; PG8_MMA(1, 1, At, B1); PG8_BAR;
            }
        }
        if constexpr (ALIGN_EPI) { if (wr == 0) PG8_BAR; }
        if constexpr (!Epi::AFTER_DRAIN) { E(acc, cur, wr, wc, fr, fq); S.done(cur); }
        if (!has_next) break;
#pragma unroll
        for (int a = 0; a < 2; ++a)
#pragma unroll
            for (int b = 0; b < 2; ++b)
#pragma unroll
                for (int m = 0; m < 4; ++m)
#pragma unroll
                    for (int n = 0; n < 2; ++n) acc[a][b][m][n] = (f32x4){0.f, 0.f, 0.f, 0.f};
        cur = nxt; cA = nA; cB = nB; ++ui;
        if constexpr (ALIGN_EPI) { if (wr == 1) PG8_BAR; }
    }
    PG8_WAIT_V(0);
    if constexpr (!ALIGN_EPI) { if (wr == 0) PG8_BAR; }
    PG8_BAR;
    if constexpr (Epi::AFTER_DRAIN) { E.fused(acc, cur, wr, wc, fr, fq, lds, wid, lane); S.done(cur); }
#undef PG8_SA
#undef PG8_SB
#undef PG8_STAGE
#undef PG8_LDA
#undef PG8_LDB
#undef PG8_MMA
#undef PG8_WAIT_V
#undef PG8_WAIT_L
#undef PG8_BAR
#undef PG8_SCHED
}
}


#define LAS __attribute__((address_space(3)))
typedef unsigned short bf16_t;
typedef short bf16x8 __attribute__((ext_vector_type(8)));
typedef short s16x4 __attribute__((ext_vector_type(4)));
typedef float f32x4 __attribute__((ext_vector_type(4)));
typedef float f32x2 __attribute__((ext_vector_type(2)));
typedef float f32x16 __attribute__((ext_vector_type(16)));
typedef unsigned u32x4 __attribute__((ext_vector_type(4)));
typedef unsigned u32x2 __attribute__((ext_vector_type(2)));

constexpr int T_ = 4096, NB_ = 16, M_ = NB_ * T_, DM = 1024;
constexpr int ZLD0 = 2560, ZLD1 = 2816, FF_ = 2816, ULD = 5632, LLD = 1536;
constexpr float NORM_EPS = 1e-6f, GN_EPS = 64e-5f;
constexpr size_t MiB = (size_t)1 << 20;
constexpr size_t WS_HYIN = 1 * MiB, WS_HYOUT = 6 * MiB, WS_NSAIN = 8 * MiB, WS_NSAOUT = 14 * MiB, WS_UP0 = 16 * MiB, WS_UP1 = 27 * MiB,
                 WS_DN0 = 38 * MiB, WS_DN1 = 44 * MiB, WS_LORA = 50 * MiB, WS_CW1K = 51 * MiB, WS_CW1V = 52 * MiB, WS_CBIAS = 53 * MiB;
constexpr size_t WS_H = 64 * MiB, WS_Z = 192 * MiB, WS_AP = 512 * MiB, WS_O = 544 * MiB, WS_L = 672 * MiB, WS_C = 864 * MiB, WS_MM = 896 * MiB;
constexpr size_t WS_HID = 672 * MiB, WS_KCMP = 688 * MiB, WS_VCMP = 690 * MiB, WS_U = 192 * MiB, WS_END = 1024 * MiB;
constexpr int LDS_BYTES = 147456;
constexpr int NPHASE = 23;

__device__ __forceinline__ float bf2f(unsigned u) { return __uint_as_float(u << 16); }
__device__ __forceinline__ unsigned pk2(float lo, float hi) { return pg8::cvt_pk_bf16(lo, hi); }
__device__ __forceinline__ float wave_sum(float v) {
#pragma unroll
    for (int o = 1; o < 64; o <<= 1) v += __shfl_xor(v, o);
    return v;
}
__device__ __forceinline__ float sigmoidf_(float x) { return 1.0f / (1.0f + __expf(-x)); }
#define LDS_WAIT() asm volatile("s_waitcnt lgkmcnt(0)" ::: "memory")

struct Args { const float* in[31]; float* out; unsigned char* ws; int ph_lo, ph_hi; };

__device__ __forceinline__ void transpose_item(const float* W, int N, bf16_t* WT, int ldt, LAS float* scr, int item, int nblk, int lane) {
    const int kb = item / nblk, nb = item % nblk, k0 = 64 * kb, n0 = 32 * nb;
    const int n = n0 + (lane & 31);
#pragma unroll 8
    for (int i = 0; i < 32; ++i) { const int kk = 2 * i + (lane >> 5); scr[kk * 33 + (lane & 31)] = (n < N) ? W[(size_t)(k0 + kk) * N + n] : 0.f; }
    LDS_WAIT(); asm volatile("" ::: "memory");
    const int c = lane & 7;
#pragma unroll
    for (int j = 0; j < 4; ++j) { const int nn = (lane >> 3) + 8 * j; const LAS float* s = scr + (8 * c) * 33 + nn;
        u32x4 o; o.x = pk2(s[0 * 33], s[1 * 33]); o.y = pk2(s[2 * 33], s[3 * 33]); o.z = pk2(s[4 * 33], s[5 * 33]); o.w = pk2(s[6 * 33], s[7 * 33]);
        *(u32x4*)(WT + (size_t)(n0 + nn) * ldt + k0 + 8 * c) = o; }
    LDS_WAIT(); asm volatile("" ::: "memory");
}

__device__ __forceinline__ void norm_phase(const float* xin, const bf16_t* mm, const float* gpost, float* xout, const float* gpre, bf16_t* hout, int gw, int NGW, int lane) {
    for (int m = gw; m < M_; m += NGW) {
        const f32x4* xr = (const f32x4*)(xin + (size_t)m * DM) + lane;
        f32x4 v[4];
#pragma unroll
        for (int j = 0; j < 4; ++j) v[j] = xr[64 * j];
        if (mm) {
            const u32x2* mr = (const u32x2*)(mm + (size_t)m * DM) + lane;
            f32x4 q[4]; float ss = 0.f;
#pragma unroll
            for (int j = 0; j < 4; ++j) { const u32x2 w = mr[64 * j]; q[j] = (f32x4){bf2f(w.x & 0xffffu), bf2f(w.x >> 16), bf2f(w.y & 0xffffu), bf2f(w.y >> 16)};
                ss += (q[j].x * q[j].x + q[j].y * q[j].y) + (q[j].z * q[j].z + q[j].w * q[j].w); }
            const float rs = rsqrtf(wave_sum(ss) * (1.f / DM) + NORM_EPS);
#pragma unroll
            for (int j = 0; j < 4; ++j) { const f32x4 g = *((const f32x4*)gpost + lane + 64 * j); v[j] = v[j] + q[j] * rs * g; }
        }
        if (xout) { f32x4* xo = (f32x4*)(xout + (size_t)m * DM) + lane;
#pragma unroll
            for (int j = 0; j < 4; ++j) xo[64 * j] = v[j]; }
        if (hout) {
            float s2 = 0.f;
#pragma unroll
            for (int j = 0; j < 4; ++j) s2 += (v[j].x * v[j].x + v[j].y * v[j].y) + (v[j].z * v[j].z + v[j].w * v[j].w);
            const float rs2 = rsqrtf(wave_sum(s2) * (1.f / DM) + NORM_EPS);
            u32x2* ho = (u32x2*)(hout + (size_t)m * DM) + lane;
#pragma unroll
            for (int j = 0; j < 4; ++j) { const f32x4 g = *((const f32x4*)gpre + lane + 64 * j); const f32x4 h = v[j] * rs2 * g;
                u32x2 w; w.x = pk2(h.x, h.y); w.y = pk2(h.z, h.w); ho[64 * j] = w; }
        }
    }
}

constexpr int KROW = 144, VROW = 152, KT_BYTES = 64 * KROW, VT_BYTES = 64 * VROW;
constexpr float NEGBIG = -1e30f;
__device__ __forceinline__ int crow(int r, int hi) { return (r & 3) + 8 * (r >> 2) + 4 * hi; }
struct TileRegs { u32x4 k, v; };
__device__ __forceinline__ void tile_gload(TileRegs& r, const bf16_t* Kg, const bf16_t* Vg, size_t ld, int tid) {
    r.k = *(const u32x4*)(Kg + (size_t)(tid >> 3) * ld + (tid & 7) * 8);
    r.v = *(const u32x4*)(Vg + (size_t)(tid & 63) * ld + (tid >> 6) * 8);
}
__device__ __forceinline__ void tile_lstore(const TileRegs& r, LAS unsigned char* Ks, LAS unsigned char* Vs, int tid) {
    *(LAS u32x4*)(Ks + (tid >> 3) * KROW + (tid & 7) * 16) = r.k;
    LAS unsigned char* vb = Vs + ((tid >> 6) * 8) * VROW + (tid & 63) * 2;
    *(LAS unsigned short*)(vb + 0 * VROW) = (unsigned short)(r.v.x & 0xffffu); *(LAS unsigned short*)(vb + 1 * VROW) = (unsigned short)(r.v.x >> 16);
    *(LAS unsigned short*)(vb + 2 * VROW) = (unsigned short)(r.v.y & 0xffffu); *(LAS unsigned short*)(vb + 3 * VROW) = (unsigned short)(r.v.y >> 16);
    *(LAS unsigned short*)(vb + 4 * VROW) = (unsigned short)(r.v.z & 0xffffu); *(LAS unsigned short*)(vb + 5 * VROW) = (unsigned short)(r.v.z >> 16);
    *(LAS unsigned short*)(vb + 6 * VROW) = (unsigned short)(r.v.w & 0xffffu); *(LAS unsigned short*)(vb + 7 * VROW) = (unsigned short)(r.v.w >> 16);
}
__device__ __forceinline__ void load_qfrag(bf16x8 (&qf)[4], const bf16_t* qrow, int hi) {
#pragma unroll
    for (int d0 = 0; d0 < 4; ++d0) { const u32x4 w = *(const u32x4*)(qrow + d0 * 16 + hi * 8);
        u32x4 o; o.x = pk2(bf2f(w.x & 0xffffu) * 0.125f, bf2f(w.x >> 16) * 0.125f); o.y = pk2(bf2f(w.y & 0xffffu) * 0.125f, bf2f(w.y >> 16) * 0.125f);
        o.z = pk2(bf2f(w.z & 0xffffu) * 0.125f, bf2f(w.z >> 16) * 0.125f); o.w = pk2(bf2f(w.w & 0xffffu) * 0.125f, bf2f(w.w >> 16) * 0.125f);
        qf[d0] = __builtin_bit_cast(bf16x8, o); }
}
__device__ __forceinline__ void tile_scores(f32x16& s0, f32x16& s1, const LAS unsigned char* Ks, const bf16x8 (&qf)[4], int r32, int hi) {
#pragma unroll
    for (int r = 0; r < 16; ++r) { s0[r] = 0.f; s1[r] = 0.f; }
#pragma unroll
    for (int d0 = 0; d0 < 4; ++d0) {
        const bf16x8 k0 = *(const LAS bf16x8*)(Ks + r32 * KROW + (d0 * 16 + hi * 8) * 2);
        const bf16x8 k1 = *(const LAS bf16x8*)(Ks + (32 + r32) * KROW + (d0 * 16 + hi * 8) * 2);
        s0 = __builtin_amdgcn_mfma_f32_32x32x16_bf16(k0, qf[d0], s0, 0, 0, 0);
        s1 = __builtin_amdgcn_mfma_f32_32x32x16_bf16(k1, qf[d0], s1, 0, 0, 0);
    }
}
__device__ __forceinline__ void tile_softmax_pv(f32x16& s0, f32x16& s1, const LAS unsigned char* Vs, f32x16 (&o)[2], float& m, float& l, int r32, int hi) {
    float mt = NEGBIG;
#pragma unroll
    for (int r = 0; r < 16; ++r) mt = fmaxf(mt, fmaxf(s0[r], s1[r]));
    mt = fmaxf(mt, __shfl_xor(mt, 32));
    const float mn = fmaxf(m, mt), alpha = __expf(m - mn); m = mn;
    float ps = 0.f;
#pragma unroll
    for (int r = 0; r < 16; ++r) { s0[r] = __expf(s0[r] - mn); s1[r] = __expf(s1[r] - mn); ps += s0[r] + s1[r]; }
    l = l * alpha + ps;
#pragma unroll
    for (int r = 0; r < 16; ++r) { o[0][r] *= alpha; o[1][r] *= alpha; }
    bf16x8 pb[4];
    { u32x4 w; w.x = pk2(s0[0], s0[1]); w.y = pk2(s0[2], s0[3]); w.z = pk2(s0[4], s0[5]); w.w = pk2(s0[6], s0[7]); pb[0] = __builtin_bit_cast(bf16x8, w); }
    { u32x4 w; w.x = pk2(s0[8], s0[9]); w.y = pk2(s0[10], s0[11]); w.z = pk2(s0[12], s0[13]); w.w = pk2(s0[14], s0[15]); pb[1] = __builtin_bit_cast(bf16x8, w); }
    { u32x4 w; w.x = pk2(s1[0], s1[1]); w.y = pk2(s1[2], s1[3]); w.z = pk2(s1[4], s1[5]); w.w = pk2(s1[6], s1[7]); pb[2] = __builtin_bit_cast(bf16x8, w); }
    { u32x4 w; w.x = pk2(s1[8], s1[9]); w.y = pk2(s1[10], s1[11]); w.z = pk2(s1[12], s1[13]); w.w = pk2(s1[14], s1[15]); pb[3] = __builtin_bit_cast(bf16x8, w); }
#pragma unroll
    for (int dh = 0; dh < 2; ++dh)
#pragma unroll
        for (int ks = 0; ks < 4; ++ks) {
            const LAS unsigned char* vp = Vs + (dh * 32 + r32) * VROW + (16 * ks + 4 * hi) * 2;
            const u32x2 lo = *(const LAS u32x2*)vp, hh = *(const LAS u32x2*)(vp + 16);
            const u32x4 a4 = (u32x4){lo.x, lo.y, hh.x, hh.y};
            o[dh] = __builtin_amdgcn_mfma_f32_32x32x16_bf16(__builtin_bit_cast(bf16x8, a4), pb[ks], o[dh], 0, 0, 0);
        }
}
__device__ __forceinline__ void store_o(const f32x16 (&o)[2], bf16_t* orow, int hi) {
#pragma unroll
    for (int dh = 0; dh < 2; ++dh)
#pragma unroll
        for (int r4 = 0; r4 < 4; ++r4) { u32x2 w; w.x = pk2(o[dh][4 * r4], o[dh][4 * r4 + 1]); w.y = pk2(o[dh][4 * r4 + 2], o[dh][4 * r4 + 3]);
            *(u32x2*)(orow + dh * 32 + 8 * r4 + 4 * hi) = w; }
}

__device__ __forceinline__ void swa_unit(int u, const bf16_t* Z, bf16_t* O, const float* sinks, LAS unsigned char* lds, int tid) {
    const int g = u & 1, sb = (u >> 1) & 63, b = u >> 7;
    const int lane = tid & 63, w = tid >> 6, r32 = lane & 31, hi = lane >> 5;
    const int h = g * 4 + (w >> 1), t0 = sb * 64, t = t0 + (w & 1) * 32 + r32;
    const size_t mrow = (size_t)b * T_ + t;
    LAS unsigned char* Ks = lds; LAS unsigned char* Vs = lds + KT_BYTES;
    bf16x8 qf[4]; load_qfrag(qf, Z + mrow * ZLD0 + h * 64, hi);
    const float slope = exp2f(-(float)(h + 1));
    float m = sinks[h], l = hi == 0 ? 1.f : 0.f;
    f32x16 o[2];
#pragma unroll
    for (int r = 0; r < 16; ++r) { o[0][r] = 0.f; o[1][r] = 0.f; }
    const int first = sb >= 2 ? 0 : 2 - sb;
    TileRegs tr;
    { const int kp0 = t0 - 128 + 64 * first; const bf16_t* base = Z + ((size_t)b * T_ + kp0) * ZLD0; tile_gload(tr, base + 512 + g * 64, base + 640 + g * 64, ZLD0, tid); }
    for (int ti = first; ti < 3; ++ti) {
        const int kp0 = t0 - 128 + 64 * ti;
        __syncthreads(); tile_lstore(tr, Ks, Vs, tid); __syncthreads();
        if (ti + 1 < 3) { const bf16_t* base = Z + ((size_t)b * T_ + kp0 + 64) * ZLD0; tile_gload(tr, base + 512 + g * 64, base + 640 + g * 64, ZLD0, tid); }
        f32x16 s0, s1; tile_scores(s0, s1, Ks, qf, r32, hi);
#pragma unroll
        for (int r = 0; r < 16; ++r) {
            const int d0 = t - (kp0 + crow(r, hi)), d1 = d0 - 32;
            s0[r] = (d0 >= 0 && d0 < 128) ? s0[r] - slope * (float)d0 : NEGBIG;
            s1[r] = (d1 >= 0 && d1 < 128) ? s1[r] - slope * (float)d1 : NEGBIG;
        }
        tile_softmax_pv(s0, s1, Vs, o, m, l, r32, hi);
    }
    l += __shfl_xor(l, 32);
    const float inv = 1.f / l;
#pragma unroll
    for (int r = 0; r < 16; ++r) { o[0][r] *= inv; o[1][r] *= inv; }
    store_o(o, O + mrow * DM + h * 64, hi);
}

constexpr int IMP_OFF = 19456, IMP_LD = 257, SELM_OFF = IMP_OFF + 64 * IMP_LD * 4  , UNI_OFF = SELM_OFF + 512;
__device__ __forceinline__ void nsa_unit(int u, const bf16_t* Z, const bf16_t* KC, const bf16_t* VC, bf16_t* O, LAS unsigned char* lds, int tid) {
    const int bg = u & 63, i = u >> 6, g = bg & 3, b = bg >> 2;
    const int lane = tid & 63, w = tid >> 6, r32 = lane & 31, hi = lane >> 5;
    const int hr = w >> 1, h = g * 4 + hr, t0 = i * 64, ql = (w & 1) * 32 + r32, t = t0 + ql;
    const size_t mrow = (size_t)b * T_ + t;
    LAS unsigned char* Ks = lds; LAS unsigned char* Vs = lds + KT_BYTES;
    LAS float* imp = (LAS float*)(lds + IMP_OFF);
    LAS unsigned* selm = (LAS unsigned*)(lds + SELM_OFF); LAS unsigned* uni = (LAS unsigned*)(lds + UNI_OFF);
    bf16x8 qf[4]; load_qfrag(qf, Z + mrow * ZLD1 + h * 64, hi);
    const float slope = exp2f(-0.5f * (float)(h + 1));
    const bf16_t* gatep = Z + mrow * ZLD1 + 2560 + h * 3;
    LAS float* park = (LAS float*)(lds + IMP_OFF) + tid;
    f32x16 o[2]; float m, l; TileRegs tr;
    const size_t cbase = ((size_t)(b * 4 + g) * 256) * 64;
    const int ncv = min(4 * i + 3, 255), nct = (ncv + 63) >> 6;
    m = NEGBIG; l = 0.f;
#pragma unroll
    for (int r = 0; r < 16; ++r) { o[0][r] = 0.f; o[1][r] = 0.f; }
    tile_gload(tr, KC + cbase, VC + cbase, 64, tid);
    for (int ti = 0; ti < nct; ++ti) {
        __syncthreads(); tile_lstore(tr, Ks, Vs, tid); __syncthreads();
        if (ti + 1 < nct) tile_gload(tr, KC + cbase + (size_t)(ti + 1) * 4096, VC + cbase + (size_t)(ti + 1) * 4096, 64, tid);
        f32x16 s0, s1; tile_scores(s0, s1, Ks, qf, r32, hi);
#pragma unroll
        for (int r = 0; r < 16; ++r) {
            const int d0 = t - (16 * (ti * 64 + crow(r, hi)) + 31), d1 = d0 - 512;
            s0[r] = d0 >= 0 ? s0[r] - slope * (float)d0 : NEGBIG;
            s1[r] = d1 >= 0 ? s1[r] - slope * (float)d1 : NEGBIG;
        }
        tile_softmax_pv(s0, s1, Vs, o, m, l, r32, hi);
    }
    l += __shfl_xor(l, 32);
    const bool rowok = t >= 31;
    const float invc = rowok ? 1.f / l : 0.f;
    { const float wg = sigmoidf_(bf2f(gatep[0])) * invc;
#pragma unroll
      for (int r = 0; r < 16; ++r) { o[0][r] *= wg; o[1][r] *= wg; } }
    if (i > 7) {
        const float mc = m;
        tile_gload(tr, KC + cbase, VC + cbase, 64, tid);
        for (int ti = 0; ti < nct; ++ti) {
            __syncthreads(); tile_lstore(tr, Ks, Vs, tid); __syncthreads();
            if (ti + 1 < nct) tile_gload(tr, KC + cbase + (size_t)(ti + 1) * 4096, VC + cbase + (size_t)(ti + 1) * 4096, 64, tid);
            f32x16 s0, s1; tile_scores(s0, s1, Ks, qf, r32, hi);
#pragma unroll
            for (int r = 0; r < 16; ++r) {
                const int d0 = t - (16 * (ti * 64 + crow(r, hi)) + 31), d1 = d0 - 512;
                s0[r] = d0 >= 0 ? __expf(s0[r] - slope * (float)d0 - mc) * invc : 0.f;
                s1[r] = d1 >= 0 ? __expf(s1[r] - slope * (float)d1 - mc) * invc : 0.f;
            }
            LAS float* ip = imp + ql * IMP_LD + ti * 64;
#pragma unroll
            for (int rr = 0; rr < 4; ++rr) {
                if (hr == rr) {
#pragma unroll
                    for (int r = 0; r < 16; ++r) { const int c = crow(r, hi);
                        if (rr == 0) { ip[c] = s0[r]; ip[32 + c] = s1[r]; } else { ip[c] += s0[r]; ip[32 + c] += s1[r]; } }
                }
                __syncthreads();
            }
        }
    }
    if (tid == 0) { uni[0] = 0u; uni[1] = 0u; }
    __syncthreads();
    if (tid < 64) {
        unsigned long long mask;
        if (i <= 7) mask = (2ull << i) - 1ull;
        else {
            float v0 = -1.f, v1 = -1.f, v2 = -1.f, v3 = -1.f, v4 = -1.f; int j0 = 0, j1 = 0, j2 = 0, j3 = 0, j4 = 0;
            const LAS float* ip = imp + tid * IMP_LD;
            for (int j = 1; j <= i - 2; ++j) {
                float v = ip[4 * j - 1] + 2.f * (ip[4 * j] + ip[4 * j + 1] + ip[4 * j + 2]) + ip[4 * j + 3]; int jj = j;
#define INS(vk, jk) if (v > vk) { const float tv = vk; const int tj = jk; vk = v; jk = jj; v = tv; jj = tj; }
                INS(v0, j0) INS(v1, j1) INS(v2, j2) INS(v3, j3) INS(v4, j4)
#undef INS
            }
            mask = 1ull | (1ull << i) | (1ull << (i - 1)) | (1ull << j0) | (1ull << j1) | (1ull << j2) | (1ull << j3) | (1ull << j4);
        }
        selm[2 * tid] = (unsigned)mask; selm[2 * tid + 1] = (unsigned)(mask >> 32);
        atomicOr((unsigned*)(uni), (unsigned)mask); atomicOr((unsigned*)(uni + 1), (unsigned)(mask >> 32));
    }
    __syncthreads();
#pragma unroll
    for (int r = 0; r < 16; ++r) { park[r * 512] = o[0][r]; park[(16 + r) * 512] = o[1][r]; }
    {
        unsigned long long um = (unsigned long long)uni[0] | ((unsigned long long)uni[1] << 32);
        const unsigned long long mym = (unsigned long long)selm[2 * ql] | ((unsigned long long)selm[2 * ql + 1] << 32);
        m = NEGBIG; l = 0.f;
#pragma unroll
        for (int r = 0; r < 16; ++r) { o[0][r] = 0.f; o[1][r] = 0.f; }
        int j = __builtin_ctzll(um); um &= um - 1;
        { const bf16_t* base = Z + ((size_t)b * T_ + 64 * j) * ZLD1; tile_gload(tr, base + 1536 + g * 64, base + 1792 + g * 64, ZLD1, tid); }
        for (;;) {
            __syncthreads(); tile_lstore(tr, Ks, Vs, tid); __syncthreads();
            const int jn = um ? __builtin_ctzll(um) : -1; um &= um - 1;
            if (jn >= 0) { const bf16_t* base = Z + ((size_t)b * T_ + 64 * jn) * ZLD1; tile_gload(tr, base + 1536 + g * 64, base + 1792 + g * 64, ZLD1, tid); }
            f32x16 s0, s1; tile_scores(s0, s1, Ks, qf, r32, hi);
            const bool sel = (mym >> j) & 1ull;
#pragma unroll
            for (int r = 0; r < 16; ++r) {
                const int d0 = t - (64 * j + crow(r, hi)), d1 = d0 - 32;
                s0[r] = (sel && d0 >= 0) ? s0[r] - slope * (float)d0 : NEGBIG;
                s1[r] = (sel && d1 >= 0) ? s1[r] - slope * (float)d1 : NEGBIG;
            }
            tile_softmax_pv(s0, s1, Vs, o, m, l, r32, hi);
            if (jn < 0) break;
            j = jn;
        }
        l += __shfl_xor(l, 32);
        const float wg = sigmoidf_(bf2f(gatep[1])) / l;
#pragma unroll
        for (int r = 0; r < 16; ++r) { park[r * 512] += wg * o[0][r]; park[(16 + r) * 512] += wg * o[1][r]; }
    }
    {
        m = NEGBIG; l = 0.f;
#pragma unroll
        for (int r = 0; r < 16; ++r) { o[0][r] = 0.f; o[1][r] = 0.f; }
        const int first = i >= 4 ? 0 : 4 - i;
        { const int kp0 = t0 - 256 + 64 * first; const bf16_t* base = Z + ((size_t)b * T_ + kp0) * ZLD1; tile_gload(tr, base + 2048 + g * 64, base + 2304 + g * 64, ZLD1, tid); }
        for (int ti = first; ti < 5; ++ti) {
            const int kp0 = t0 - 256 + 64 * ti;
            __syncthreads(); tile_lstore(tr, Ks, Vs, tid); __syncthreads();
            if (ti + 1 < 5) { const bf16_t* base = Z + ((size_t)b * T_ + kp0 + 64) * ZLD1; tile_gload(tr, base + 2048 + g * 64, base + 2304 + g * 64, ZLD1, tid); }
            f32x16 s0, s1; tile_scores(s0, s1, Ks, qf, r32, hi);
#pragma unroll
            for (int r = 0; r < 16; ++r) {
                const int d0 = t - (kp0 + crow(r, hi)), d1 = d0 - 32;
                s0[r] = (d0 >= 0 && d0 < 256) ? s0[r] - slope * (float)d0 : NEGBIG;
                s1[r] = (d1 >= 0 && d1 < 256) ? s1[r] - slope * (float)d1 : NEGBIG;
            }
            tile_softmax_pv(s0, s1, Vs, o, m, l, r32, hi);
        }
        l += __shfl_xor(l, 32);
        const float wg = sigmoidf_(bf2f(gatep[2])) / l;
#pragma unroll
        for (int r = 0; r < 16; ++r) { o[0][r] = park[r * 512] + wg * o[0][r]; o[1][r] = park[(16 + r) * 512] + wg * o[1][r]; }
    }
    store_o(o, O + mrow * DM + h * 64, hi);
    __syncthreads();
}

__device__ __forceinline__ float dpp_xadd(float x, int which) {
    int r;
    const int xi = __float_as_int(x);
    if (which == 0) r = __builtin_amdgcn_update_dpp(0, xi, 0xB1, 0xf, 0xf, false);
    else if (which == 1) r = __builtin_amdgcn_update_dpp(0, xi, 0x4E, 0xf, 0xf, false);
    else if (which == 2) r = __builtin_amdgcn_update_dpp(0, xi, 0x141, 0xf, 0xf, false);
    else r = __builtin_amdgcn_update_dpp(0, xi, 0x140, 0xf, 0xf, false);
    return x + __int_as_float(r);
}
__device__ __forceinline__ float row16_sum(float x) { x = dpp_xadd(x, 0); x = dpp_xadd(x, 1); x = dpp_xadd(x, 2); x = dpp_xadd(x, 3); return x; }

__device__ __forceinline__ void rwkv_prep(const Args& a, const bf16_t* Z, const bf16_t* L, bf16_t* KK, bf16_t* WR, bf16_t* WE, bf16_t* KKA, bf16_t* KT, bf16_t* VS, float* C, int gw, int NGW, int lane) {
    const int h = gw & 7, col = h * 64 + lane;
    const float mu_r = a.in[8][col], mu_k = a.in[8][512 + col], mu_v = a.in[8][1024 + col];
    const float w0 = a.in[9][col], a0 = a.in[11][col], k_k = a.in[14][col], k_a = a.in[15][col], r_k = a.in[16][col];
    for (int m = gw >> 3; m < M_; m += NGW >> 3) {
        const bf16_t* zr = Z + (size_t)m * ZLD0 + 768 + col;
        float r = bf2f(zr[0]), k = bf2f(zr[512]), v = bf2f(zr[1024]);
        float rp = 0.f, kp = 0.f, vp = 0.f;
        if ((m & (T_ - 1)) != 0) { rp = bf2f(zr[-ZLD0]); kp = bf2f(zr[512 - ZLD0]); vp = bf2f(zr[1024 - ZLD0]); }
        r += (rp - r) * mu_r; k += (kp - k) * mu_k; v += (vp - v) * mu_v;
        const float lw = bf2f(L[(size_t)m * LLD + col]), la = bf2f(L[(size_t)m * LLD + 512 + col]);
        const float e = 0.60653065971f * sigmoidf_(w0 + lw);
        const unsigned eb = pk2(e, 0.f) & 0xffffu;
        const float wdec = __expf(-bf2f(eb));
        const float av = sigmoidf_(a0 + la);
        float kk = k * k_k;
        const float nrm = sqrtf(wave_sum(kk * kk));
        kk = kk / fmaxf(nrm, 1e-12f);
        const float kt = k * (1.f + (av - 1.f) * k_a);
        const float kka = kk * av;
        const float c1 = wave_sum(kka * r), c2 = wave_sum(kt * r), c3 = wave_sum(r * kt * r_k);
        const size_t o = (size_t)m * 512 + col;
        KK[o] = (bf16_t)(pk2(kk, 0.f) & 0xffffu); WR[o] = (bf16_t)(pk2(wdec * r, 0.f) & 0xffffu); WE[o] = (bf16_t)eb;
        KKA[o] = (bf16_t)(pk2(kka, 0.f) & 0xffffu); KT[o] = (bf16_t)(pk2(kt, 0.f) & 0xffffu); VS[o] = (bf16_t)(pk2(v, 0.f) & 0xffffu);
        if (lane == 0) *(f32x4*)(C + (size_t)m * 32 + h * 4) = (f32x4){c1, c2, c3, 0.f};
    }
}

constexpr int SC_TS = 32, SC_BUF = 5 * SC_TS * 64 + SC_TS * 32 + SC_TS * 2;
__device__ __forceinline__ void scan_unit(int u, const bf16_t* KK, const bf16_t* WR, const bf16_t* WE, const bf16_t* KKA, const bf16_t* KT, const bf16_t* VS, const float* C, float* Y, LAS unsigned char* lds, int tid) {
    const int half = u & 1, h = (u >> 1) & 7, b = u >> 4;
    const int il = tid >> 4, jg = tid & 15;
    LAS float* buf0 = (LAS float*)lds; LAS float* buf1 = buf0 + SC_BUF; LAS float* ybuf = buf1 + SC_BUF;
    float S0 = 0.f, S1 = 0.f, S2 = 0.f, S3 = 0.f;
    const size_t rowbase = (size_t)b * T_;
    const size_t goff = (rowbase + il) * 512 + h * 64 + jg * 4;
    const size_t voff = (rowbase + il) * 512 + h * 64 + half * 32 + jg * 2;
    u32x2 rkk, rwr, rwe, rkka, rkt; unsigned rv; f32x2 rc;
#define SC_GLOAD(t0) do { const size_t d_ = (size_t)(t0) * 512; rkk = *(const u32x2*)(KK + goff + d_); rwr = *(const u32x2*)(WR + goff + d_); rwe = *(const u32x2*)(WE + goff + d_); \
        rkka = *(const u32x2*)(KKA + goff + d_); rkt = *(const u32x2*)(KT + goff + d_); rv = *(const unsigned*)(VS + voff + d_); \
        if (tid < SC_TS) rc = *(const f32x2*)(C + (rowbase + (t0) + tid) * 32 + h * 4); } while (0)
#define SC_EXP4(w) (f32x4){bf2f((w).x & 0xffffu), bf2f((w).x >> 16), bf2f((w).y & 0xffffu), bf2f((w).y >> 16)}
#define SC_LSTORE(bf) do { LAS float* p_ = (bf) + il * 64 + jg * 4; *(LAS f32x4*)(p_) = SC_EXP4(rkk); *(LAS f32x4*)(p_ + 2048) = SC_EXP4(rwr); \
        { f32x4 e_ = SC_EXP4(rwe); *(LAS f32x4*)(p_ + 4096) = (f32x4){__expf(-e_.x), __expf(-e_.y), __expf(-e_.z), __expf(-e_.w)}; } \
        *(LAS f32x4*)(p_ + 6144) = SC_EXP4(rkka); *(LAS f32x4*)(p_ + 8192) = SC_EXP4(rkt); \
        *(LAS f32x2*)((bf) + 10240 + il * 32 + jg * 2) = (f32x2){bf2f(rv & 0xffffu), bf2f(rv >> 16)}; \
        if (tid < SC_TS) *(LAS f32x2*)((bf) + 11264 + tid * 2) = rc; } while (0)
    __syncthreads();
    SC_GLOAD(0); SC_LSTORE(buf0);
    __syncthreads();
    for (int n = 0; n < T_ / SC_TS; ++n) {
        LAS float* cb = (n & 1) ? buf1 : buf0; LAS float* nb = (n & 1) ? buf0 : buf1;
        if (n + 1 < T_ / SC_TS) SC_GLOAD((n + 1) * SC_TS);
#pragma unroll 8
        for (int s = 0; s < SC_TS; ++s) {
            const LAS float* B = cb + s * 64 + jg * 4;
            const f32x4 kk = *(const LAS f32x4*)B, wr = *(const LAS f32x4*)(B + 2048), w = *(const LAS f32x4*)(B + 4096), kka = *(const LAS f32x4*)(B + 6144), kt = *(const LAS f32x4*)(B + 8192);
            const float v = cb[10240 + s * 32 + il]; const f32x2 c = *(const LAS f32x2*)(cb + 11264 + s * 2);
            float sa = (S0 * kk.x + S1 * kk.y) + (S2 * kk.z + S3 * kk.w);
            float uu = (S0 * wr.x + S1 * wr.y) + (S2 * wr.z + S3 * wr.w);
            sa = row16_sum(sa); uu = row16_sum(uu);
            const float y = uu - sa * c.x + v * c.y;
            if (jg == 0) ybuf[s * 32 + il] = y;
            S0 = S0 * w.x + (v * kt.x - sa * kka.x); S1 = S1 * w.y + (v * kt.y - sa * kka.y);
            S2 = S2 * w.z + (v * kt.z - sa * kka.z); S3 = S3 * w.w + (v * kt.w - sa * kka.w);
        }
        __syncthreads();
        if (n + 1 < T_ / SC_TS) SC_LSTORE(nb);
        { const f32x2 yv = *(const LAS f32x2*)(ybuf + il * 32 + jg * 2);
          *(f32x2*)(Y + (rowbase + (size_t)n * SC_TS + il) * 512 + h * 64 + half * 32 + jg * 2) = yv; }
        __syncthreads();
    }
#undef SC_GLOAD
#undef SC_EXP4
#undef SC_LSTORE
}

__device__ __forceinline__ void rwkv_post(const Args& a, const float* Y, const bf16_t* VS, const bf16_t* L, const float* C, bf16_t* O, int gw, int NGW, int lane) {
    const int h = gw & 7, col = h * 64 + lane;
    const float lg = a.in[17][col], lb = a.in[18][col];
    for (int m = gw >> 3; m < M_; m += NGW >> 3) {
        const float y = Y[(size_t)m * 512 + col];
        const float mean = wave_sum(y) * (1.f / 64.f); const float d = y - mean;
        const float var = wave_sum(d * d) * (1.f / 64.f);
        const float yn = d * rsqrtf(var + GN_EPS) * lg + lb;
        const float v = bf2f(VS[(size_t)m * 512 + col]), g = bf2f(L[(size_t)m * LLD + 1024 + col]);
        const float c3 = C[(size_t)m * 32 + h * 4 + 2];
        O[(size_t)m * DM + 512 + col] = (bf16_t)(pk2((yn + c3 * v) * g, 0.f) & 0xffffu);
    }
}

__device__ __forceinline__ void run_gemm0(LAS unsigned char* lds, const bf16_t* A, const bf16_t* Bt, int M, int N, int K, int lda, bf16_t* Oo, int ldc) {
    pg8::Gemm g{A, Bt, M, N, K, lda, (size_t)128, 0}; pg8::StaticOrder S; S.init(M, N, (int)gridDim.x, (int)blockIdx.x);
    pg8::EpiStore<0> E{Oo, ldc, nullptr};

#ifndef NO_GEMM
    pg8::gemm_phase<pg8::EpiStore<0>, pg8::StaticOrder, true, true>(lds, g, S, E);
#endif
}


#define Wt_hyin ((bf16_t*)(ws + WS_HYIN))
#define Wt_hyout ((bf16_t*)(ws + WS_HYOUT))
#define Wt_nsain ((bf16_t*)(ws + WS_NSAIN))
#define Wt_nsaout ((bf16_t*)(ws + WS_NSAOUT))
#define Wt_lora ((bf16_t*)(ws + WS_LORA))
#define Wt_cw1k ((bf16_t*)(ws + WS_CW1K))
#define Wt_cw1v ((bf16_t*)(ws + WS_CW1V))
#define cbias ((float*)(ws + WS_CBIAS))
#define H ((bf16_t*)(ws + WS_H))
#define Z ((bf16_t*)(ws + WS_Z))
#define AP ((bf16_t*)(ws + WS_AP))
#define O ((bf16_t*)(ws + WS_O))
#define L ((bf16_t*)(ws + WS_L))
#define C ((float*)(ws + WS_C))
#define MM ((bf16_t*)(ws + WS_MM))
#define Y ((float*)(ws + WS_MM))
#define HID ((bf16_t*)(ws + WS_HID))
#define KC ((bf16_t*)(ws + WS_KCMP))
#define VC ((bf16_t*)(ws + WS_VCMP))
#define U ((bf16_t*)(ws + WS_U))
#define KK ((bf16_t*)(ws + WS_H))
#define WR (KK + (size_t)M_ * 512)
#define WE ((bf16_t*)args.out)
#define KKA (WE + (size_t)M_ * 512)
#define KT (WE + (size_t)M_ * 1024)
#define VS (WE + (size_t)M_ * 1536)
#define XIN (args.in[0])
#define X (args.out)
#define PH_BEGIN unsigned char* ws = args.ws; asm volatile("" : "+s"(ws)); int tid_ = threadIdx.x; asm volatile("" : "+v"(tid_)); const int tid = tid_, lane = tid & 63, wave = __builtin_amdgcn_readfirstlane(tid >> 6); const int G = gridDim.x, gw = blockIdx.x * 8 + wave, NGW = G * 8; const int gtid = blockIdx.x * 512 + tid, NT = G * 512; (void)lane; (void)gw; (void)NGW; (void)gtid; (void)NT; (void)ws;
__global__ void __launch_bounds__(512, 2) mega_fwd(Args args) {
    extern __shared__ __attribute__((aligned(16))) unsigned char lds_raw[];
    LAS unsigned char* lds = (LAS unsigned char*)lds_raw;
    cg::grid_group grid = cg::this_grid();
    const int lo = args.ph_lo, hi = args.ph_hi;
#define IN(k) (lo <= (k) && (k) < hi)
#define SEAM(k) do { if (IN(k) && IN((k) + 1)) grid.sync(); } while (0)

    if (IN(0)) { PH_BEGIN
        LAS float* scr = (LAS float*)(lds + wave * 16384);
        constexpr int I0 = 16 * 80, I1 = 16 * 32, I2 = 16 * 88, I3 = 16 * 32, I4 = 16 * 176, I5 = 44 * 32, I6 = 32 * 8;
        constexpr int NIT = I0 + I1 + I2 + I3 + 2 * I4 + 2 * I5 + 2 * I6;
        for (int it = gw; it < NIT; it += NGW) {
            int r = it;
            if (r < I0) { transpose_item(args.in[5], 2560, Wt_hyin, 1024, scr, r, 80, lane); continue; } r -= I0;
            if (r < I1) { transpose_item(args.in[6], 1024, Wt_hyout, 1024, scr, r, 32, lane); continue; } r -= I1;
            if (r < I2) { transpose_item(args.in[19], 2608, Wt_nsain, 1024, scr, r, 88, lane); continue; } r -= I2;
            if (r < I3) { transpose_item(args.in[20], 1024, Wt_nsaout, 1024, scr, r, 32, lane); continue; } r -= I3;
            if (r < 2 * I4) { const int l = r / I4; transpose_item(args.in[27] + (size_t)l * 1024 * 5632, 5632, (bf16_t*)(ws + (l ? WS_UP1 : WS_UP0)), 1024, scr, r % I4, 176, lane); continue; } r -= 2 * I4;
            if (r < 2 * I5) { const int l = r / I5; transpose_item(args.in[30] + (size_t)l * 2816 * 1024, 1024, (bf16_t*)(ws + (l ? WS_DN1 : WS_DN0)), 2816, scr, r % I5, 32, lane); continue; } r -= 2 * I5;
            if (r < I6) { transpose_item(args.in[22], 256, Wt_cw1k, 2048, scr, r, 8, lane); continue; } r -= I6;
            transpose_item(args.in[25], 256, Wt_cw1v, 2048, scr, r, 8, lane);
        }
        for (int e = gtid; e < 1536 * 256; e += NT) {
            const int n = e >> 8, k = e & 255; float v = 0.f;
            if (n < 512) { if (k < 64) v = args.in[10][k * 512 + n]; }
            else if (n < 1024) { if (k >= 64 && k < 128) v = args.in[12][(k - 64) * 512 + (n - 512)]; }
            else { if (k >= 128) v = args.in[13][(k - 128) * 512 + (n - 1024)]; }
            Wt_lora[e] = (bf16_t)(pk2(v, 0.f) & 0xffffu);
        }
        for (int it = gw; it < 512; it += NGW) {
            const int which = it >> 8, f = it & 255; const float* pos = args.in[which ? 24 : 21]; const float* w1 = args.in[which ? 25 : 22];
            float s = 0.f;
            for (int e = lane; e < 2048; e += 64) s += pos[e] * w1[(size_t)e * 256 + f];
            s = wave_sum(s);
            if (lane == 0) cbias[it] = s;
        }
        norm_phase(XIN, nullptr, nullptr, nullptr, args.in[1], H, gw, NGW, lane);
    }
    SEAM(0);
    if (IN(1)) { PH_BEGIN run_gemm0(lds, H, Wt_hyin, M_, ZLD0, 1024, 1024, Z, ZLD0); }
    SEAM(1);
    if (IN(2)) { PH_BEGIN
        const float* mu = args.in[8];
        for (int it = gtid; it < M_ * 32; it += NT) {
            const int m = it >> 5, col = (it & 31) * 8;
            const bf16_t* zp = Z + (size_t)m * ZLD0 + 2304 + col;
            const u32x4 zc = *(const u32x4*)zp; u32x4 zq = (u32x4){0u, 0u, 0u, 0u};
            if ((m & (T_ - 1)) != 0) zq = *(const u32x4*)(zp - ZLD0);
            const unsigned cw[4] = {zc.x, zc.y, zc.z, zc.w}, pw[4] = {zq.x, zq.y, zq.z, zq.w}; unsigned ow[4];
#pragma unroll
            for (int e = 0; e < 4; ++e) {
                float a0 = bf2f(cw[e] & 0xffffu), a1 = bf2f(cw[e] >> 16); const float p0 = bf2f(pw[e] & 0xffffu), p1 = bf2f(pw[e] >> 16);
                a0 += (p0 - a0) * mu[1536 + col + 2 * e]; a1 += (p1 - a1) * mu[1536 + col + 2 * e + 1];
                if (col < 64) { a0 = tanhf(a0); a1 = tanhf(a1); } else if (col >= 128) { a0 = sigmoidf_(a0); a1 = sigmoidf_(a1); }
                ow[e] = pk2(a0, a1);
            }
            *(u32x4*)(AP + (size_t)m * 256 + col) = (u32x4){ow[0], ow[1], ow[2], ow[3]};
        }

#ifndef NO_SWA
for (int u = blockIdx.x; u < NB_ * 64 * 2; u += G) swa_unit(u, Z, O, args.in[7], lds, tid);
#endif

        __syncthreads();
    }
    SEAM(2);
    if (IN(3)) { PH_BEGIN run_gemm0(lds, AP, Wt_lora, M_, LLD, 256, 256, L, LLD); }
    SEAM(3);
    if (IN(4)) { PH_BEGIN rwkv_prep(args, Z, L, KK, WR, WE, KKA, KT, VS, C, gw, NGW, lane); }
    SEAM(4);
    if (IN(5)) { PH_BEGIN
#ifndef NO_SCAN
for (int u = blockIdx.x; u < 256; u += G) scan_unit(u, KK, WR, WE, KKA, KT, VS, C, Y, lds, tid);
#endif
 }
    SEAM(5);
    if (IN(6)) { PH_BEGIN rwkv_post(args, Y, VS, L, C, O, gw, NGW, lane); }
    SEAM(6);
    if (IN(7)) { PH_BEGIN run_gemm0(lds, O, Wt_hyout, M_, 1024, 1024, 1024, MM, 1024); }
    SEAM(7);
    if (IN(8)) { PH_BEGIN norm_phase(XIN, MM, args.in[2], X, args.in[3], H, gw, NGW, lane); }
    SEAM(8);
#pragma unroll
    for (int l = 0; l < 2; ++l) {
        const int pb = l ? 19 : 9;
        if (IN(pb)) { PH_BEGIN run_gemm0(lds, H, (const bf16_t*)(ws + (l ? WS_UP1 : WS_UP0)), M_, ULD, 1024, 1024, U, ULD); }
        SEAM(pb);
        if (IN(pb + 1)) { PH_BEGIN
            const float* cw = args.in[28] + (size_t)l * 3 * FF_; const float* cbv = args.in[29] + (size_t)l * FF_;
            for (int it = gtid; it < M_ * (FF_ / 8); it += NT) {
                const int m = it / (FF_ / 8), f = (it % (FF_ / 8)) * 8, t = m & (T_ - 1);
                const bf16_t* up = U + (size_t)m * ULD + f;
                const u32x4 g0 = *(const u32x4*)up, vv = *(const u32x4*)(up + FF_);
                u32x4 g1 = (u32x4){0u, 0u, 0u, 0u}, g2 = g1;
                if (t >= 1) g1 = *(const u32x4*)(up - ULD);
                if (t >= 2) g2 = *(const u32x4*)(up - 2 * ULD);
                const unsigned a0[4] = {g0.x, g0.y, g0.z, g0.w}, a1[4] = {g1.x, g1.y, g1.z, g1.w}, a2[4] = {g2.x, g2.y, g2.z, g2.w}, av[4] = {vv.x, vv.y, vv.z, vv.w}; unsigned ow[4];
#pragma unroll
                for (int e = 0; e < 4; ++e) {
                    const int f0 = f + 2 * e;
                    const float c0 = cbv[f0] + bf2f(a0[e] & 0xffffu) * cw[2 * FF_ + f0] + bf2f(a1[e] & 0xffffu) * cw[FF_ + f0] + bf2f(a2[e] & 0xffffu) * cw[f0];
                    const float c1 = cbv[f0 + 1] + bf2f(a0[e] >> 16) * cw[2 * FF_ + f0 + 1] + bf2f(a1[e] >> 16) * cw[FF_ + f0 + 1] + bf2f(a2[e] >> 16) * cw[f0 + 1];
                    ow[e] = pk2(pg8::gelu_tanh(c0) * bf2f(av[e] & 0xffffu), pg8::gelu_tanh(c1) * bf2f(av[e] >> 16));
                }
                *(u32x4*)(U + (size_t)m * ULD + FF_ + f) = (u32x4){ow[0], ow[1], ow[2], ow[3]};
            }
        }
        SEAM(pb + 1);
        if (IN(pb + 2)) { PH_BEGIN run_gemm0(lds, U + FF_, (const bf16_t*)(ws + (l ? WS_DN1 : WS_DN0)), M_, 1024, FF_, ULD, MM, 1024); }
        SEAM(pb + 2);
        if (IN(pb + 3)) { PH_BEGIN
            if (l == 0) norm_phase(X, MM, args.in[4], X, args.in[1] + 1024, H, gw, NGW, lane);
            else norm_phase(X, MM, args.in[4] + 1024, X, nullptr, nullptr, gw, NGW, lane);
        }
        if (l == 0) {
            SEAM(12);
            if (IN(13)) { PH_BEGIN run_gemm0(lds, H, Wt_nsain, M_, ZLD1, 1024, 1024, Z, ZLD1); }
            SEAM(13);
            if (IN(14)) { PH_BEGIN
                const int G2 = G >> 1, which = (int)blockIdx.x >= G2 ? 1 : 0;
                pg8::Gemm g{Z + 1024 + which * 256, which ? Wt_cw1v : Wt_cw1k, 16384, 256, 2048, 16 * ZLD1, (size_t)ZLD1 * 2, 1};
                pg8::StaticOrder S; S.init(16384, 256, G2, (int)blockIdx.x - which * G2);
                pg8::EpiStore<2> E{HID + (size_t)which * 16384 * 256, 256, cbias + which * 256};

#ifndef NO_GEMM2
if ((int)blockIdx.x < 2 * G2) pg8::gemm_phase<pg8::EpiStore<2>, pg8::StaticOrder, true, true>(lds, g, S, E);
#endif

            }
            SEAM(14);
            if (IN(15)) { PH_BEGIN
                for (int row = gw; row < 2 * 16384; row += NGW) {
                    const int which = row >> 14; const float* w2 = args.in[which ? 26 : 23]; const bf16_t* hp = HID + (size_t)row * 256;
                    float acc = 0.f;
#pragma unroll 8
                    for (int f = 0; f < 256; ++f) acc += bf2f(hp[f]) * w2[f * 64 + lane];
                    (which ? VC : KC)[(size_t)(row & 16383) * 64 + lane] = (bf16_t)(pk2(acc, 0.f) & 0xffffu);
                }
            }
            SEAM(15);
            if (IN(16)) { PH_BEGIN
#ifndef NO_NSA
for (int u = blockIdx.x; u < 64 * 64; u += G) nsa_unit(u, Z, KC, VC, O, lds, tid);
#endif
 }
            SEAM(16);
            if (IN(17)) { PH_BEGIN run_gemm0(lds, O, Wt_nsaout, M_, 1024, 1024, 1024, MM, 1024); }
            SEAM(17);
            if (IN(18)) { PH_BEGIN norm_phase(X, MM, args.in[2] + 1024, X, args.in[3] + 1024, H, gw, NGW, lane); }
            SEAM(18);
        }
    }
#undef IN
#undef SEAM
}

#undef XIN
#undef X
#undef H
#undef Z
#undef O
#undef L
#undef C
#undef U
#undef Y
extern "C" void kernel_launch(void* const* d_in, const int* in_sizes, int n_in, void* d_out, int out_size, void* d_ws, size_t ws_size, hipStream_t stream) {
    static int grid = 0;
    if (grid == 0) {
        if (n_in != 31 || out_size != M_ * DM || ws_size < WS_END) { fprintf(stderr, "kernel_launch: unexpected shapes (n_in %d out %d ws %zu)\n", n_in, out_size, ws_size); grid = -1; return; }
        int dev = 0, cus = 0, per_cu = 0;
        hipGetDevice(&dev); hipDeviceGetAttribute(&cus, hipDeviceAttributeMultiprocessorCount, dev);
        hipFuncSetAttribute((const void*)mega_fwd, hipFuncAttributeMaxDynamicSharedMemorySize, LDS_BYTES);
        hipOccupancyMaxActiveBlocksPerMultiprocessor(&per_cu, (const void*)mega_fwd, 512, LDS_BYTES);
        if (per_cu < 1) { fprintf(stderr, "kernel_launch: occupancy query says %d blocks/CU\n", per_cu); per_cu = 1; }
        (void)hipGetLastError();
        grid = cus * 1;
    }
    if (grid < 0) return;
    Args a{};
    for (int i = 0; i < 31; ++i) a.in[i] = (const float*)d_in[i];
    a.out = (float*)d_out; a.ws = (unsigned char*)d_ws;
#if ONE_LAUNCH
    a.ph_lo = 0; a.ph_hi = NPHASE;
    void* kargs[] = {&a};
    hipError_t e = hipLaunchCooperativeKernel((const void*)mega_fwd, dim3(grid), dim3(512), kargs, LDS_BYTES, stream);
    if (e != hipSuccess) fprintf(stderr, "cooperative launch failed: %s (grid %d)\n", hipGetErrorString(e), grid);
#else
    for (int p = 0; p < NPHASE; ++p) { a.ph_lo = p; a.ph_hi = p + 1; hipLaunchKernelGGL(mega_fwd, dim3(grid), dim3(512), LDS_BYTES, stream, a); }
#endif
}
```

```cpp
#include <hip/hip_runtime.h>
#include <hip/hip_cooperative_groups.h>
#include <cstdio>
#include <cstdint>
namespace cg = cooperative_groups;

#ifndef ONE_LAUNCH
#define ONE_LAUNCH 1
#endif

namespace pg8 {
#define PG8_LAS __attribute__((address_space(3)))
typedef unsigned short bf16_t;
typedef short bf16x8 __attribute__((ext_vector_type(8)));
typedef float f32x4 __attribute__((ext_vector_type(4)));
typedef unsigned u32x4 __attribute__((ext_vector_type(4)));
constexpr int BM = 256, BK = 64, HALF = 128, HTB = HALF * BK * 2  , STAGE_BYTES = 8 * HTB, NXCD = 8, WGM = 8;

__host__ __device__ __forceinline__ int lds_byte(int r, int c) { const int st = (r >> 4) * 2 + (c >> 5), rr = r & 15, cc = c & 31, ob = rr * 64 + cc * 2; return st * 1024 + (ob ^ (((ob >> 9) & 1) << 5)); }
__host__ __device__ __forceinline__ void stage_rc(int b, int& R, int& C) { const int st = b / 1024, sb = b % 1024, swz = sb ^ (((sb >> 9) & 1) << 5); R = (st >> 1) * 16 + swz / 64; C = (st & 1) * 32 + (swz % 64) / 2; }
__host__ __device__ __forceinline__ int perm32(int rho) { const int n = rho >> 4, i = rho & 15; return 8 * (i >> 2) + 4 * n + (i & 3); }

struct Unit { int pm, pn; };
struct Gemm { const bf16_t* A; const bf16_t* Bt; int M, N, K; int lda; size_t a_kstep; int amode; };
__device__ __forceinline__ const char* a_base(const Gemm& g, int pm) { return g.amode == 0 ? (const char*)g.A + (size_t)pm * ((size_t)BM * g.lda * 2) : (const char*)g.A + (size_t)(pm >> 2) * ((size_t)4096 * 2816 * 2) + (size_t)(pm & 3) * 128; }

struct StaticOrder {
    int nM, nN, nwg, G, c;
    __host__ __device__ void init(int M, int N, int G_, int c_) { nM = M / BM; nN = N / BM; nwg = nM * nN; G = G_; c = c_; }
    __host__ __device__ bool next(int i, Unit& u) const {
        const long L = (long)i * G + c; if (L >= nwg) return false;
        int wgid = (int)L; { const int q = nwg / NXCD, r = nwg % NXCD, xcd = wgid % NXCD, off = wgid / NXCD; wgid = (xcd < r ? xcd * (q + 1) : r * (q + 1) + (xcd - r) * q) + off; }
        const int nig = WGM * nN, gid = wgid / nig, fm = gid * WGM, gsz = (nM - fm) < WGM ? (nM - fm) : WGM;
        u.pm = fm + ((wgid % nig) % gsz); u.pn = (wgid % nig) / gsz; return true;
    }
    __device__ __forceinline__ void a_ready(const Unit&) const {}
    __device__ __forceinline__ void done(const Unit&) const {}
};


__device__ __forceinline__ unsigned cvt_pk_bf16(float lo, float hi) { unsigned r; asm volatile("v_cvt_pk_bf16_f32 %0, %1, %2" : "=v"(r) : "v"(lo), "v"(hi)); return r; }
__device__ __forceinline__ float gelu_tanh(float x) { const float u = 1.5957691216f * (x + 0.044715f * x * x * x); return x / (1.0f + __expf(-u)); }
template <int ACT> struct EpiStore {
    static constexpr bool PERM = true, AFTER_DRAIN = false;
    bf16_t* O; int ldc; const float* bias;
    __device__ __forceinline__ void operator()(const f32x4 (&acc)[2][2][4][2], const Unit& u, int wr, int wc, int fr, int fq) const {
        const int row0 = u.pm * BM + wr * 64 + fr; const int col0 = u.pn * BM + wc * 32 + 8 * fq;
        f32x4 bv[2][2];
#pragma unroll
        for (int bj = 0; bj < 2; ++bj)
#pragma unroll
            for (int n = 0; n < 2; ++n) bv[bj][n] = bias ? *(const f32x4*)(bias + col0 + bj * HALF + 4 * n) : (f32x4){0.f, 0.f, 0.f, 0.f};
#pragma unroll
        for (int ai = 0; ai < 2; ++ai)
#pragma unroll
            for (int m = 0; m < 4; ++m) { bf16_t* rowp = O + (size_t)(row0 + ai * HALF + m * 16) * ldc + col0;
#pragma unroll
                for (int bj = 0; bj < 2; ++bj) { f32x4 v0 = acc[ai][bj][m][0] + bv[bj][0], v1 = acc[ai][bj][m][1] + bv[bj][1];
                    if (ACT == 2) { v0 = (f32x4){gelu_tanh(v0[0]), gelu_tanh(v0[1]), gelu_tanh(v0[2]), gelu_tanh(v0[3])}; v1 = (f32x4){gelu_tanh(v1[0]), gelu_tanh(v1[1]), gelu_tanh(v1[2]), gelu_tanh(v1[3])}; }
                    u32x4 w; w.x = cvt_pk_bf16(v0[0], v0[1]); w.y = cvt_pk_bf16(v0[2], v0[3]); w.z = cvt_pk_bf16(v1[0], v1[1]); w.w = cvt_pk_bf16(v1[2], v1[3]);
                    *(u32x4*)(rowp + bj * HALF) = w; } }
    }
};

template <class Epi, class Sched, bool ALIGN_EPI = false, bool SP2 = false>
__device__ __forceinline__ void gemm_phase(PG8_LAS unsigned char* lds, const Gemm g, const Sched& S, const Epi& E) {
    int tid = threadIdx.x; asm volatile("" : "+v"(tid)); const int wid = __builtin_amdgcn_readfirstlane(tid >> 6), lane = tid & 63, wr = wid >> 2, wc = wid & 3, fr = lane & 15, fq = lane >> 4;
    const int K = g.K, nt = K / BK;
    unsigned voffA[2], voffB[2];
#pragma unroll
    for (int i = 0; i < 2; ++i) { int R, C; stage_rc(tid * 16 + i * 8192, R, C); const int Rb = Epi::PERM ? ((R & ~31) + perm32(R & 31)) : R;
        voffA[i] = (unsigned)(R * g.lda + C) * 2u; voffB[i] = (unsigned)(Rb * K + C) * 2u; }
    const size_t kstep = (size_t)(BK * 2);
    const size_t hstepB = (size_t)HALF * K * 2, hstepA = (size_t)HALF * g.lda * 2, kstepA = g.a_kstep;
    const size_t tstep = 2 * hstepB;
    const unsigned ldsw = (unsigned)wid * 1024u;
    const int aoff = lds_byte(wr * 64 + fr, fq * 8), boff = lds_byte(wc * 32 + fr, fq * 8);
#define PG8_SA(b, h) (((b) * 2 + (h)) * HTB)
#define PG8_SB(b, h) ((4 + (b) * 2 + (h)) * HTB)
#define PG8_STAGE(bufoff, gbase, voff) do { _Pragma("unroll") for (int _i = 0; _i < 2; ++_i) \
        __builtin_amdgcn_global_load_lds((const unsigned*)((const char*)(gbase) + (voff)[_i]), (PG8_LAS unsigned*)(lds + (bufoff) + ldsw + _i * 8192), 16, 0, 0); } while (0)
#define PG8_LDA(dst, b, h) do { _Pragma("unroll") for (int m = 0; m < 4; ++m) _Pragma("unroll") for (int k = 0; k < 2; ++k) dst[m][k] = *(const PG8_LAS bf16x8*)(lds + PG8_SA(b, h) + aoff + m * 2048 + k * 1024); } while (0)
#define PG8_LDB(dst, b, h) do { _Pragma("unroll") for (int n = 0; n < 2; ++n) _Pragma("unroll") for (int k = 0; k < 2; ++k) dst[n][k] = *(const PG8_LAS bf16x8*)(lds + PG8_SB(b, h) + boff + n * 2048 + k * 1024); } while (0)
#define PG8_MMA(ai, bj, At, Bt) do { __builtin_amdgcn_s_setprio(1); _Pragma("unroll") for (int m = 0; m < 4; ++m) _Pragma("unroll") for (int n = 0; n < 2; ++n) _Pragma("unroll") for (int k = 0; k < 2; ++k) \
        acc[ai][bj][m][n] = __builtin_amdgcn_mfma_f32_16x16x32_bf16(Bt[n][k], At[m][k], acc[ai][bj][m][n], 0, 0, 0); __builtin_amdgcn_s_setprio(0); } while (0)
#define PG8_WAIT_V(n) asm volatile("s_waitcnt vmcnt(" #n ")" ::: "memory")
#define PG8_WAIT_L(n) asm volatile("s_waitcnt lgkmcnt(" #n ")" ::: "memory")
#define PG8_BAR __builtin_amdgcn_s_barrier()
#define PG8_SCHED __builtin_amdgcn_sched_barrier(0)
    Unit cur, nxt; int ui = 0;
    if (!S.next(0, cur)) return;
    f32x4 acc[2][2][4][2];
#pragma unroll
    for (int a = 0; a < 2; ++a)
#pragma unroll
        for (int b = 0; b < 2; ++b)
#pragma unroll
            for (int m = 0; m < 4; ++m)
#pragma unroll
                for (int n = 0; n < 2; ++n) acc[a][b][m][n] = (f32x4){0.f, 0.f, 0.f, 0.f};
    bf16x8 At[4][2], B0[2][2], B1[2][2];
    const char* cA = a_base(g, cur.pm); const char* cB = (const char*)g.Bt + (size_t)cur.pn * tstep;
    S.a_ready(cur);
    if constexpr (SP2) {
        PG8_STAGE(PG8_SB(0, 0), cB, voffB); PG8_STAGE(PG8_SB(0, 1), cB + hstepB, voffB); PG8_STAGE(PG8_SA(0, 0), cA, voffA); PG8_STAGE(PG8_SA(0, 1), cA + hstepA, voffA);
        if (wr == 1) PG8_BAR;
        PG8_WAIT_V(2); PG8_BAR;
        PG8_STAGE(PG8_SB(1, 0), cB + kstep, voffB); PG8_STAGE(PG8_SA(1, 0), cA + kstepA, voffA); PG8_STAGE(PG8_SB(1, 1), cB + hstepB + kstep, voffB);
        PG8_WAIT_V(6); PG8_BAR;
    } else {
        PG8_STAGE(PG8_SB(0, 0), cB, voffB); PG8_STAGE(PG8_SA(0, 0), cA, voffA); PG8_STAGE(PG8_SB(0, 1), cB + hstepB, voffB); PG8_STAGE(PG8_SA(0, 1), cA + hstepA, voffA);
        if (wr == 1) PG8_BAR;
        PG8_WAIT_V(4); PG8_BAR;
        PG8_STAGE(PG8_SB(1, 0), cB + kstep, voffB); PG8_STAGE(PG8_SA(1, 0), cA + kstepA, voffA); PG8_STAGE(PG8_SB(1, 1), cB + hstepB + kstep, voffB);
        PG8_WAIT_V(6); PG8_BAR;
    }
    for (;;) {
        const bool has_next = S.next(ui + 1, nxt);
        const char* nA = has_next ? a_base(g, nxt.pm) : cA; const char* nB = has_next ? (const char*)g.Bt + (size_t)nxt.pn * tstep : cB;
        for (int t = 0; t < nt; t += 2) {
            const bool last = (t == nt - 2);
            const char* a1 = cA + (size_t)(t + 1) * kstepA;
            const char* a2 = last ? nA : cA + (size_t)(t + 2) * kstepA; const char* b2 = last ? nB : cB + (size_t)(t + 2) * kstep;
            const char* a3 = a2 + kstepA; const char* b3 = b2 + kstep;
            if (last && has_next) S.a_ready(nxt);
            if constexpr (SP2) {
            PG8_LDB(B0, 0, 0); PG8_LDB(B1, 0, 1); PG8_SCHED; PG8_LDA(At, 0, 0); PG8_STAGE(PG8_SA(1, 1), a1 + hstepA, voffA);
            PG8_WAIT_V(8); PG8_WAIT_L(0); PG8_BAR; PG8_MMA(0, 0, At, B0); PG8_MMA(0, 1, At, B1); PG8_BAR; PG8_SCHED;
            PG8_LDA(At, 0, 1); PG8_STAGE(PG8_SB(0, 0), b2, voffB); PG8_STAGE(PG8_SB(0, 1), b2 + hstepB, voffB); PG8_STAGE(PG8_SA(0, 0), a2, voffA);
            PG8_WAIT_V(8); PG8_WAIT_L(0); PG8_BAR; PG8_MMA(1, 0, At, B0); PG8_MMA(1, 1, At, B1); PG8_BAR; PG8_SCHED;
            PG8_LDB(B0, 1, 0); PG8_LDB(B1, 1, 1); PG8_SCHED; PG8_LDA(At, 1, 0); PG8_STAGE(PG8_SA(0, 1), a2 + hstepA, voffA);
            PG8_WAIT_V(8); PG8_WAIT_L(0); PG8_BAR; PG8_MMA(0, 0, At, B0); PG8_MMA(0, 1, At, B1); PG8_BAR; PG8_SCHED;
            PG8_LDA(At, 1, 1); PG8_STAGE(PG8_SB(1, 0), b3, voffB); PG8_STAGE(PG8_SB(1, 1), b3 + hstepB, voffB); PG8_STAGE(PG8_SA(1, 0), a3, voffA);
            PG8_WAIT_V(8); PG8_WAIT_L(0); PG8_BAR; PG8_MMA(1, 0, At, B0); PG8_MMA(1, 1, At, B1); PG8_BAR; PG8_SCHED;
            } else {
            PG8_LDB(B0, 0, 0); PG8_SCHED; PG8_LDA(At, 0, 0); PG8_STAGE(PG8_SA(1, 1), a1 + hstepA, voffA);
            PG8_WAIT_L(8); PG8_BAR; PG8_WAIT_L(0); PG8_MMA(0, 0, At, B0); PG8_BAR; PG8_SCHED;
            PG8_LDB(B1, 0, 1); PG8_STAGE(PG8_SB(0, 0), b2, voffB);
            PG8_BAR; PG8_WAIT_L(0); PG8_MMA(0, 1, At, B1); PG8_BAR;
            PG8_LDA(At, 0, 1); PG8_STAGE(PG8_SA(0, 0), a2, voffA);
            PG8_BAR; PG8_WAIT_L(0); PG8_MMA(1, 0, At, B0); PG8_BAR; PG8_SCHED;
            PG8_STAGE(PG8_SB(0, 1), b2 + hstepB, voffB);
            PG8_WAIT_V(6); PG8_BAR; PG8_MMA(1, 1, At, B1); PG8_BAR;
            PG8_LDB(B0, 1, 0); PG8_SCHED; PG8_LDA(At, 1, 0); PG8_STAGE(PG8_SA(0, 1), a2 + hstepA, voffA);
            PG8_WAIT_L(8); PG8_BAR; PG8_WAIT_L(0); PG8_MMA(0, 0, At, B0); PG8_BAR; PG8_SCHED;
            PG8_LDB(B1, 1, 1); PG8_STAGE(PG8_SB(1, 0), b3, voffB);
            PG8_BAR; PG8_WAIT_L(0); PG8_MMA(0, 1, At, B1); PG8_BAR;
            PG8_LDA(At, 1, 1); PG8_STAGE(PG8_SA(1, 0), a3, voffA);
            PG8_BAR; PG8_WAIT_L(0); PG8_MMA(1, 0, At, B0); PG8_BAR; PG8_SCHED;
            PG8_STAGE(PG8_SB(1, 1), b3 + hstepB, voffB);
            PG8_WAIT_V(6); PG8_BAR; PG8_MMA(1, 1, At, B1); PG8_BAR;
            }
        }
        if constexpr (ALIGN_EPI) { if (wr == 0) PG8_BAR; }
        if constexpr (!Epi::AFTER_DRAIN) { E(acc, cur, wr, wc, fr, fq); S.done(cur); }
        if (!has_next) break;
#pragma unroll
        for (int a = 0; a < 2; ++a)
#pragma unroll
            for (int b = 0; b < 2; ++b)
#pragma unroll
                for (int m = 0; m < 4; ++m)
#pragma unroll
                    for (int n = 0; n < 2; ++n) acc[a][b][m][n] = (f32x4){0.f, 0.f, 0.f, 0.f};
        cur = nxt; cA = nA; cB = nB; ++ui;
        if constexpr (ALIGN_EPI) { if (wr == 1) PG8_BAR; }
    }
    PG8_WAIT_V(0);
    if constexpr (!ALIGN_EPI) { if (wr == 0) PG8_BAR; }
    PG8_BAR;
    if constexpr (Epi::AFTER_DRAIN) { E.fused(acc, cur, wr, wc, fr, fq, lds, wid, lane); S.done(cur); }
#undef PG8_SA
#undef PG8_SB
#undef PG8_STAGE
#undef PG8_LDA
#undef PG8_LDB
#undef PG8_MMA
#undef PG8_WAIT_V
#undef PG8_WAIT_L
#undef PG8_BAR
#undef PG8_SCHED
}
}


#define LAS __attribute__((address_space(3)))
typedef unsigned short bf16_t;
typedef short bf16x8 __attribute__((ext_vector_type(8)));
typedef short s16x4 __attribute__((ext_vector_type(4)));
typedef float f32x4 __attribute__((ext_vector_type(4)));
typedef float f32x2 __attribute__((ext_vector_type(2)));
typedef float f32x16 __attribute__((ext_vector_type(16)));
typedef unsigned u32x4 __attribute__((ext_vector_type(4)));
typedef unsigned u32x2 __attribute__((ext_vector_type(2)));

constexpr int T_ = 4096, NB_ = 16, M_ = NB_ * T_, DM = 1024;
constexpr int ZLD0 = 2560, ZLD1 = 2816, FF_ = 2816, ULD = 5632, LLD = 1536;
constexpr float NORM_EPS = 1e-6f, GN_EPS = 64e-5f;
constexpr size_t MiB = (size_t)1 << 20;
constexpr size_t WS_HYIN = 1 * MiB, WS_HYOUT = 6 * MiB, WS_NSAIN = 8 * MiB, WS_NSAOUT = 14 * MiB, WS_UP0 = 16 * MiB, WS_UP1 = 27 * MiB,
                 WS_DN0 = 38 * MiB, WS_DN1 = 44 * MiB, WS_LORA = 50 * MiB, WS_CW1K = 51 * MiB, WS_CW1V = 52 * MiB, WS_CBIAS = 53 * MiB;
constexpr size_t WS_H = 64 * MiB, WS_Z = 192 * MiB, WS_AP = 512 * MiB, WS_O = 544 * MiB, WS_L = 672 * MiB, WS_C = 864 * MiB, WS_MM = 896 * MiB;
constexpr size_t WS_HID = 672 * MiB, WS_KCMP = 688 * MiB, WS_VCMP = 690 * MiB, WS_U = 192 * MiB, WS_END = 1024 * MiB;
constexpr int LDS_BYTES = 147456;
constexpr int NPHASE = 23;

__device__ __forceinline__ float bf2f(unsigned u) { return __uint_as_float(u << 16); }
__device__ __forceinline__ unsigned pk2(float lo, float hi) { return pg8::cvt_pk_bf16(lo, hi); }
__device__ __forceinline__ float wave_sum(float v) {
#pragma unroll
    for (int o = 1; o < 64; o <<= 1) v += __shfl_xor(v, o);
    return v;
}
__device__ __forceinline__ float sigmoidf_(float x) { return 1.0f / (1.0f + __expf(-x)); }
#define LDS_WAIT() asm volatile("s_waitcnt lgkmcnt(0)" ::: "memory")

struct Args { const float* in[31]; float* out; unsigned char* ws; int ph_lo, ph_hi; };

__device__ __forceinline__ void transpose_item(const float* W, int N, bf16_t* WT, int ldt, LAS float* scr, int item, int nblk, int lane) {
    const int kb = item / nblk, nb = item % nblk, k0 = 64 * kb, n0 = 32 * nb;
    const int n = n0 + (lane & 31);
#pragma unroll 8
    for (int i = 0; i < 32; ++i) { const int kk = 2 * i + (lane >> 5); scr[kk * 33 + (lane & 31)] = (n < N) ? W[(size_t)(k0 + kk) * N + n] : 0.f; }
    LDS_WAIT(); asm volatile("" ::: "memory");
    const int c = lane & 7;
#pragma unroll
    for (int j = 0; j < 4; ++j) { const int nn = (lane >> 3) + 8 * j; const LAS float* s = scr + (8 * c) * 33 + nn;
        u32x4 o; o.x = pk2(s[0 * 33], s[1 * 33]); o.y = pk2(s[2 * 33], s[3 * 33]); o.z = pk2(s[4 * 33], s[5 * 33]); o.w = pk2(s[6 * 33], s[7 * 33]);
        *(u32x4*)(WT + (size_t)(n0 + nn) * ldt + k0 + 8 * c) = o; }
    LDS_WAIT(); asm volatile("" ::: "memory");
}

__device__ __forceinline__ void norm_phase(const float* xin, const bf16_t* mm, const float* gpost, float* xout, const float* gpre, bf16_t* hout, int gw, int NGW, int lane) {
    for (int m = gw; m < M_; m += NGW) {
        const f32x4* xr = (const f32x4*)(xin + (size_t)m * DM) + lane;
        f32x4 v[4];
#pragma unroll
        for (int j = 0; j < 4; ++j) v[j] = xr[64 * j];
        if (mm) {
            const u32x2* mr = (const u32x2*)(mm + (size_t)m * DM) + lane;
            f32x4 q[4]; float ss = 0.f;
#pragma unroll
            for (int j = 0; j < 4; ++j) { const u32x2 w = mr[64 * j]; q[j] = (f32x4){bf2f(w.x & 0xffffu), bf2f(w.x >> 16), bf2f(w.y & 0xffffu), bf2f(w.y >> 16)};
                ss += (q[j].x * q[j].x + q[j].y * q[j].y) + (q[j].z * q[j].z + q[j].w * q[j].w); }
            const float rs = rsqrtf(wave_sum(ss) * (1.f / DM) + NORM_EPS);
#pragma unroll
            for (int j = 0; j < 4; ++j) { const f32x4 g = *((const f32x4*)gpost + lane + 64 * j); v[j] = v[j] + q[j] * rs * g; }
        }
        if (xout) { f32x4* xo = (f32x4*)(xout + (size_t)m * DM) + lane;
#pragma unroll
            for (int j = 0; j < 4; ++j) xo[64 * j] = v[j]; }
        if (hout) {
            float s2 = 0.f;
#pragma unroll
            for (int j = 0; j < 4; ++j) s2 += (v[j].x * v[j].x + v[j].y * v[j].y) + (v[j].z * v[j].z + v[j].w * v[j].w);
            const float rs2 = rsqrtf(wave_sum(s2) * (1.f / DM) + NORM_EPS);
            u32x2* ho = (u32x2*)(hout + (size_t)m * DM) + lane;
#pragma unroll
            for (int j = 0; j < 4; ++j) { const f32x4 g = *((const f32x4*)gpre + lane + 64 * j); const f32x4 h = v[j] * rs2 * g;
                u32x2 w; w.x = pk2(h.x, h.y); w.y = pk2(h.z, h.w); ho[64 * j] = w; }
        }
    }
}

constexpr int KROW = 144, VROW = 152, KT_BYTES = 64 * KROW, VT_BYTES = 64 * VROW;
constexpr float NEGBIG = -1e30f;
__device__ __forceinline__ int crow(int r, int hi) { return (r & 3) + 8 * (r >> 2) + 4 * hi; }
struct TileRegs { u32x4 k, v; };
__device__ __forceinline__ void tile_gload(TileRegs& r, const bf16_t* Kg, const bf16_t* Vg, size_t ld, int tid) {
    r.k = *(const u32x4*)(Kg + (size_t)(tid >> 3) * ld + (tid & 7) * 8);
    r.v = *(const u32x4*)(Vg + (size_t)(tid & 63) * ld + (tid >> 6) * 8);
}
__device__ __forceinline__ void tile_lstore(const TileRegs& r, LAS unsigned char* Ks, LAS unsigned char* Vs, int tid) {
    *(LAS u32x4*)(Ks + (tid >> 3) * KROW + (tid & 7) * 16) = r.k;
    LAS unsigned char* vb = Vs + ((tid >> 6) * 8) * VROW + (tid & 63) * 2;
    *(LAS unsigned short*)(vb + 0 * VROW) = (unsigned short)(r.v.x & 0xffffu); *(LAS unsigned short*)(vb + 1 * VROW) = (unsigned short)(r.v.x >> 16);
    *(LAS unsigned short*)(vb + 2 * VROW) = (unsigned short)(r.v.y & 0xffffu); *(LAS unsigned short*)(vb + 3 * VROW) = (unsigned short)(r.v.y >> 16);
    *(LAS unsigned short*)(vb + 4 * VROW) = (unsigned short)(r.v.z & 0xffffu); *(LAS unsigned short*)(vb + 5 * VROW) = (unsigned short)(r.v.z >> 16);
    *(LAS unsigned short*)(vb + 6 * VROW) = (unsigned short)(r.v.w & 0xffffu); *(LAS unsigned short*)(vb + 7 * VROW) = (unsigned short)(r.v.w >> 16);
}
__device__ __forceinline__ void load_qfrag(bf16x8 (&qf)[4], const bf16_t* qrow, int hi) {
#pragma unroll
    for (int d0 = 0; d0 < 4; ++d0) { const u32x4 w = *(const u32x4*)(qrow + d0 * 16 + hi * 8);
        u32x4 o; o.x = pk2(bf2f(w.x & 0xffffu) * 0.125f, bf2f(w.x >> 16) * 0.125f); o.y = pk2(bf2f(w.y & 0xffffu) * 0.125f, bf2f(w.y >> 16) * 0.125f);
        o.z = pk2(bf2f(w.z & 0xffffu) * 0.125f, bf2f(w.z >> 16) * 0.125f); o.w = pk2(bf2f(w.w & 0xffffu) * 0.125f, bf2f(w.w >> 16) * 0.125f);
        qf[d0] = __builtin_bit_cast(bf16x8, o); }
}
__device__ __forceinline__ void tile_scores(f32x16& s0, f32x16& s1, const LAS unsigned char* Ks, const bf16x8 (&qf)[4], int r32, int hi) {
#pragma unroll
    for (int r = 0; r < 16; ++r) { s0[r] = 0.f; s1[r] = 0.f; }
#pragma unroll
    for (int d0 = 0; d0 < 4; ++d0) {
        const bf16x8 k0 = *(const LAS bf16x8*)(Ks + r32 * KROW + (d0 * 16 + hi * 8) * 2);
        const bf16x8 k1 = *(const LAS bf16x8*)(Ks + (32 + r32) * KROW + (d0 * 16 + hi * 8) * 2);
        s0 = __builtin_amdgcn_mfma_f32_32x32x16_bf16(k0, qf[d0], s0, 0, 0, 0);
        s1 = __builtin_amdgcn_mfma_f32_32x32x16_bf16(k1, qf[d0], s1, 0, 0, 0);
    }
}
__device__ __forceinline__ void tile_softmax_pv(f32x16& s0, f32x16& s1, const LAS unsigned char* Vs, f32x16 (&o)[2], float& m, float& l, int r32, int hi) {
    float mt = NEGBIG;
#pragma unroll
    for (int r = 0; r < 16; ++r) mt = fmaxf(mt, fmaxf(s0[r], s1[r]));
    mt = fmaxf(mt, __shfl_xor(mt, 32));
    const float mn = fmaxf(m, mt), alpha = __expf(m - mn); m = mn;
    float ps = 0.f;
#pragma unroll
    for (int r = 0; r < 16; ++r) { s0[r] = __expf(s0[r] - mn); s1[r] = __expf(s1[r] - mn); ps += s0[r] + s1[r]; }
    l = l * alpha + ps;
#pragma unroll
    for (int r = 0; r < 16; ++r) { o[0][r] *= alpha; o[1][r] *= alpha; }
    bf16x8 pb[4];
    { u32x4 w; w.x = pk2(s0[0], s0[1]); w.y = pk2(s0[2], s0[3]); w.z = pk2(s0[4], s0[5]); w.w = pk2(s0[6], s0[7]); pb[0] = __builtin_bit_cast(bf16x8, w); }
    { u32x4 w; w.x = pk2(s0[8], s0[9]); w.y = pk2(s0[10], s0[11]); w.z = pk2(s0[12], s0[13]); w.w = pk2(s0[14], s0[15]); pb[1] = __builtin_bit_cast(bf16x8, w); }
    { u32x4 w; w.x = pk2(s1[0], s1[1]); w.y = pk2(s1[2], s1[3]); w.z = pk2(s1[4], s1[5]); w.w = pk2(s1[6], s1[7]); pb[2] = __builtin_bit_cast(bf16x8, w); }
    { u32x4 w; w.x = pk2(s1[8], s1[9]); w.y = pk2(s1[10], s1[11]); w.z = pk2(s1[12], s1[13]); w.w = pk2(s1[14], s1[15]); pb[3] = __builtin_bit_cast(bf16x8, w); }
#pragma unroll
    for (int dh = 0; dh < 2; ++dh)
#pragma unroll
        for (int ks = 0; ks < 4; ++ks) {
            const LAS unsigned char* vp = Vs + (dh * 32 + r32) * VROW + (16 * ks + 4 * hi) * 2;
            const u32x2 lo = *(const LAS u32x2*)vp, hh = *(const LAS u32x2*)(vp + 16);
            const u32x4 a4 = (u32x4){lo.x, lo.y, hh.x, hh.y};
            o[dh] = __builtin_amdgcn_mfma_f32_32x32x16_bf16(__builtin_bit_cast(bf16x8, a4), pb[ks], o[dh], 0, 0, 0);
        }
}
__device__ __forceinline__ void store_o(const f32x16 (&o)[2], bf16_t* orow, int hi) {
#pragma unroll
    for (int dh = 0; dh < 2; ++dh)
#pragma unroll
        for (int r4 = 0; r4 < 4; ++r4) { u32x2 w; w.x = pk2(o[dh][4 * r4], o[dh][4 * r4 + 1]); w.y = pk2(o[dh][4 * r4 + 2], o[dh][4 * r4 + 3]);
            *(u32x2*)(orow + dh * 32 + 8 * r4 + 4 * hi) = w; }
}

__device__ __forceinline__ void swa_unit(int u, const bf16_t* Z, bf16_t* O, const float* sinks, LAS unsigned char* lds, int tid) {
    const int g = u & 1, sb = (u >> 1) & 63, b = u >> 7;
    const int lane = tid & 63, w = tid >> 6, r32 = lane & 31, hi = lane >> 5;
    const int h = g * 4 + (w >> 1), t0 = sb * 64, t = t0 + (w & 1) * 32 + r32;
    const size_t mrow = (size_t)b * T_ + t;
    LAS unsigned char* Ks = lds; LAS unsigned char* Vs = lds + KT_BYTES;
    bf16x8 qf[4]; load_qfrag(qf, Z + mrow * ZLD0 + h * 64, hi);
    const float slope = exp2f(-(float)(h + 1));
    float m = sinks[h], l = hi == 0 ? 1.f : 0.f;
    f32x16 o[2];
#pragma unroll
    for (int r = 0; r < 16; ++r) { o[0][r] = 0.f; o[1][r] = 0.f; }
    const int first = sb >= 2 ? 0 : 2 - sb;
    TileRegs tr;
    { const int kp0 = t0 - 128 + 64 * first; const bf16_t* base = Z + ((size_t)b * T_ + kp0) * ZLD0; tile_gload(tr, base + 512 + g * 64, base + 640 + g * 64, ZLD0, tid); }
    for (int ti = first; ti < 3; ++ti) {
        const int kp0 = t0 - 128 + 64 * ti;
        __syncthreads(); tile_lstore(tr, Ks, Vs, tid); __syncthreads();
        if (ti + 1 < 3) { const bf16_t* base = Z + ((size_t)b * T_ + kp0 + 64) * ZLD0; tile_gload(tr, base + 512 + g * 64, base + 640 + g * 64, ZLD0, tid); }
        f32x16 s0, s1; tile_scores(s0, s1, Ks, qf, r32, hi);
#pragma unroll
        for (int r = 0; r < 16; ++r) {
            const int d0 = t - (kp0 + crow(r, hi)), d1 = d0 - 32;
            s0[r] = (d0 >= 0 && d0 < 128) ? s0[r] - slope * (float)d0 : NEGBIG;
            s1[r] = (d1 >= 0 && d1 < 128) ? s1[r] - slope * (float)d1 : NEGBIG;
        }
        tile_softmax_pv(s0, s1, Vs, o, m, l, r32, hi);
    }
    l += __shfl_xor(l, 32);
    const float inv = 1.f / l;
#pragma unroll
    for (int r = 0; r < 16; ++r) { o[0][r] *= inv; o[1][r] *= inv; }
    store_o(o, O + mrow * DM + h * 64, hi);
}

constexpr int IMP_OFF = 19456, IMP_LD = 257, SELM_OFF = IMP_OFF + 64 * IMP_LD * 4  , UNI_OFF = SELM_OFF + 512;
__device__ __forceinline__ void nsa_unit(int u, const bf16_t* Z, const bf16_t* KC, const bf16_t* VC, bf16_t* O, LAS unsigned char* lds, int tid) {
    const int bg = u & 63, i = u >> 6, g = bg & 3, b = bg >> 2;
    const int lane = tid & 63, w = tid >> 6, r32 = lane & 31, hi = lane >> 5;
    const int hr = w >> 1, h = g * 4 + hr, t0 = i * 64, ql = (w & 1) * 32 + r32, t = t0 + ql;
    const size_t mrow = (size_t)b * T_ + t;
    LAS unsigned char* Ks = lds; LAS unsigned char* Vs = lds + KT_BYTES;
    LAS float* imp = (LAS float*)(lds + IMP_OFF);
    LAS unsigned* selm = (LAS unsigned*)(lds + SELM_OFF); LAS unsigned* uni = (LAS unsigned*)(lds + UNI_OFF);
    bf16x8 qf[4]; load_qfrag(qf, Z + mrow * ZLD1 + h * 64, hi);
    const float slope = exp2f(-0.5f * (float)(h + 1));
    const bf16_t* gatep = Z + mrow * ZLD1 + 2560 + h * 3;
    LAS float* park = (LAS float*)(lds + IMP_OFF) + tid;
    f32x16 o[2]; float m, l; TileRegs tr;
    const size_t cbase = ((size_t)(b * 4 + g) * 256) * 64;
    const int ncv = min(4 * i + 3, 255), nct = (ncv + 63) >> 6;
    m = NEGBIG; l = 0.f;
#pragma unroll
    for (int r = 0; r < 16; ++r) { o[0][r] = 0.f; o[1][r] = 0.f; }
    tile_gload(tr, KC + cbase, VC + cbase, 64, tid);
    for (int ti = 0; ti < nct; ++ti) {
        __syncthreads(); tile_lstore(tr, Ks, Vs, tid); __syncthreads();
        if (ti + 1 < nct) tile_gload(tr, KC + cbase + (size_t)(ti + 1) * 4096, VC + cbase + (size_t)(ti + 1) * 4096, 64, tid);
        f32x16 s0, s1; tile_scores(s0, s1, Ks, qf, r32, hi);
#pragma unroll
        for (int r = 0; r < 16; ++r) {
            const int d0 = t - (16 * (ti * 64 + crow(r, hi)) + 31), d1 = d0 - 512;
            s0[r] = d0 >= 0 ? s0[r] - slope * (float)d0 : NEGBIG;
            s1[r] = d1 >= 0 ? s1[r] - slope * (float)d1 : NEGBIG;
        }
        tile_softmax_pv(s0, s1, Vs, o, m, l, r32, hi);
    }
    l += __shfl_xor(l, 32);
    const bool rowok = t >= 31;
    const float invc = rowok ? 1.f / l : 0.f;
    { const float wg = sigmoidf_(bf2f(gatep[0])) * invc;
#pragma unroll
      for (int r = 0; r < 16; ++r) { o[0][r] *= wg; o[1][r] *= wg; } }
    if (i > 7) {
        const float mc = m;
        tile_gload(tr, KC + cbase, VC + cbase, 64, tid);
        for (int ti = 0; ti < nct; ++ti) {
            __syncthreads(); tile_lstore(tr, Ks, Vs, tid); __syncthreads();
            if (ti + 1 < nct) tile_gload(tr, KC + cbase + (size_t)(ti + 1) * 4096, VC + cbase + (size_t)(ti + 1) * 4096, 64, tid);
            f32x16 s0, s1; tile_scores(s0, s1, Ks, qf, r32, hi);
#pragma unroll
            for (int r = 0; r < 16; ++r) {
                const int d0 = t - (16 * (ti * 64 + crow(r, hi)) + 31), d1 = d0 - 512;
                s0[r] = d0 >= 0 ? __expf(s0[r] - slope * (float)d0 - mc) * invc : 0.f;
                s1[r] = d1 >= 0 ? __expf(s1[r] - slope * (float)d1 - mc) * invc : 0.f;
            }
            LAS float* ip = imp + ql * IMP_LD + ti * 64;
#pragma unroll
            for (int rr = 0; rr < 4; ++rr) {
                if (hr == rr) {
#pragma unroll
                    for (int r = 0; r < 16; ++r) { const int c = crow(r, hi);
                        if (rr == 0) { ip[c] = s0[r]; ip[32 + c] = s1[r]; } else { ip[c] += s0[r]; ip[32 + c] += s1[r]; } }
                }
                __syncthreads();
            }
        }
    }
    if (tid == 0) { uni[0] = 0u; uni[1] = 0u; }
    __syncthreads();
    if (tid < 64) {
        unsigned long long mask;
        if (i <= 7) mask = (2ull << i) - 1ull;
        else {
            float v0 = -1.f, v1 = -1.f, v2 = -1.f, v3 = -1.f, v4 = -1.f; int j0 = 0, j1 = 0, j2 = 0, j3 = 0, j4 = 0;
            const LAS float* ip = imp + tid * IMP_LD;
            for (int j = 1; j <= i - 2; ++j) {
                float v = ip[4 * j - 1] + 2.f * (ip[4 * j] + ip[4 * j + 1] + ip[4 * j + 2]) + ip[4 * j + 3]; int jj = j;
#define INS(vk, jk) if (v > vk) { const float tv = vk; const int tj = jk; vk = v; jk = jj; v = tv; jj = tj; }
                INS(v0, j0) INS(v1, j1) INS(v2, j2) INS(v3, j3) INS(v4, j4)
#undef INS
            }
            mask = 1ull | (1ull << i) | (1ull << (i - 1)) | (1ull << j0) | (1ull << j1) | (1ull << j2) | (1ull << j3) | (1ull << j4);
        }
        selm[2 * tid] = (unsigned)mask; selm[2 * tid + 1] = (unsigned)(mask >> 32);
        atomicOr((unsigned*)(uni), (unsigned)mask); atomicOr((unsigned*)(uni + 1), (unsigned)(mask >> 32));
    }
    __syncthreads();
#pragma unroll
    for (int r = 0; r < 16; ++r) { park[r * 512] = o[0][r]; park[(16 + r) * 512] = o[1][r]; }
    {
        unsigned long long um = (unsigned long long)uni[0] | ((unsigned long long)uni[1] << 32);
        const unsigned long long mym = (unsigned long long)selm[2 * ql] | ((unsigned long long)selm[2 * ql + 1] << 32);
        m = NEGBIG; l = 0.f;
#pragma unroll
        for (int r = 0; r < 16; ++r) { o[0][r] = 0.f; o[1][r] = 0.f; }
        int j = __builtin_ctzll(um); um &= um - 1;
        { const bf16_t* base = Z + ((size_t)b * T_ + 64 * j) * ZLD1; tile_gload(tr, base + 1536 + g * 64, base + 1792 + g * 64, ZLD1, tid); }
        for (;;) {
            __syncthreads(); tile_lstore(tr, Ks, Vs, tid); __syncthreads();
            const int jn = um ? __builtin_ctzll(um) : -1; um &= um - 1;
            if (jn >= 0) { const bf16_t* base = Z + ((size_t)b * T_ + 64 * jn) * ZLD1; tile_gload(tr, base + 1536 + g * 64, base + 1792 + g * 64, ZLD1, tid); }
            f32x16 s0, s1; tile_scores(s0, s1, Ks, qf, r32, hi);
            const bool sel = (mym >> j) & 1ull;
#pragma unroll
            for (int r = 0; r < 16; ++r) {
                const int d0 = t - (64 * j + crow(r, hi)), d1 = d0 - 32;
                s0[r] = (sel && d0 >= 0) ? s0[r] - slope * (float)d0 : NEGBIG;
                s1[r] = (sel && d1 >= 0) ? s1[r] - slope * (float)d1 : NEGBIG;
            }
            tile_softmax_pv(s0, s1, Vs, o, m, l, r32, hi);
            if (jn < 0) break;
            j = jn;
        }
        l += __shfl_xor(l, 32);
        const float wg = sigmoidf_(bf2f(gatep[1])) / l;
#pragma unroll
        for (int r = 0; r < 16; ++r) { park[r * 512] += wg * o[0][r]; park[(16 + r) * 512] += wg * o[1][r]; }
    }
    {
        m = NEGBIG; l = 0.f;
#pragma unroll
        for (int r = 0; r < 16; ++r) { o[0][r] = 0.f; o[1][r] = 0.f; }
        const int first = i >= 4 ? 0 : 4 - i;
        { const int kp0 = t0 - 256 + 64 * first; const bf16_t* base = Z + ((size_t)b * T_ + kp0) * ZLD1; tile_gload(tr, base + 2048 + g * 64, base + 2304 + g * 64, ZLD1, tid); }
        for (int ti = first; ti < 5; ++ti) {
            const int kp0 = t0 - 256 + 64 * ti;
            __syncthreads(); tile_lstore(tr, Ks, Vs, tid); __syncthreads();
            if (ti + 1 < 5) { const bf16_t* base = Z + ((size_t)b * T_ + kp0 + 64) * ZLD1; tile_gload(tr, base + 2048 + g * 64, base + 2304 + g * 64, ZLD1, tid); }
            f32x16 s0, s1; tile_scores(s0, s1, Ks, qf, r32, hi);
#pragma unroll
            for (int r = 0; r < 16; ++r) {
                const int d0 = t - (kp0 + crow(r, hi)), d1 = d0 - 32;
                s0[r] = (d0 >= 0 && d0 < 256) ? s0[r] - slope * (float)d0 : NEGBIG;
                s1[r] = (d1 >= 0 && d1 < 256) ? s1[r] - slope * (float)d1 : NEGBIG;
            }
            tile_softmax_pv(s0, s1, Vs, o, m, l, r32, hi);
        }
        l += __shfl_xor(l, 32);
        const float wg = sigmoidf_(bf2f(gatep[2])) / l;
#pragma unroll
        for (int r = 0; r < 16; ++r) { o[0][r] = park[r * 512] + wg * o[0][r]; o[1][r] = park[(16 + r) * 512] + wg * o[1][r]; }
    }
    store_o(o, O + mrow * DM + h * 64, hi);
    __syncthreads();
}

__device__ __forceinline__ float dpp_xadd(float x, int which) {
    int r;
    const int xi = __float_as_int(x);
    if (which == 0) r = __builtin_amdgcn_update_dpp(0, xi, 0xB1, 0xf, 0xf, false);
    else if (which == 1) r = __builtin_amdgcn_update_dpp(0, xi, 0x4E, 0xf, 0xf, false);
    else if (which == 2) r = __builtin_amdgcn_update_dpp(0, xi, 0x141, 0xf, 0xf, false);
    else r = __builtin_amdgcn_update_dpp(0, xi, 0x140, 0xf, 0xf, false);
    return x + __int_as_float(r);
}
__device__ __forceinline__ float row16_sum(float x) { x = dpp_xadd(x, 0); x = dpp_xadd(x, 1); x = dpp_xadd(x, 2); x = dpp_xadd(x, 3); return x; }

__device__ __forceinline__ void rwkv_prep(const Args& a, const bf16_t* Z, const bf16_t* L, bf16_t* KK, bf16_t* WR, bf16_t* WE, bf16_t* KKA, bf16_t* KT, bf16_t* VS, float* C, int gw, int NGW, int lane) {
    const int h = gw & 7, col = h * 64 + lane;
    const float mu_r = a.in[8][col], mu_k = a.in[8][512 + col], mu_v = a.in[8][1024 + col];
    const float w0 = a.in[9][col], a0 = a.in[11][col], k_k = a.in[14][col], k_a = a.in[15][col], r_k = a.in[16][col];
    for (int m = gw >> 3; m < M_; m += NGW >> 3) {
        const bf16_t* zr = Z + (size_t)m * ZLD0 + 768 + col;
        float r = bf2f(zr[0]), k = bf2f(zr[512]), v = bf2f(zr[1024]);
        float rp = 0.f, kp = 0.f, vp = 0.f;
        if ((m & (T_ - 1)) != 0) { rp = bf2f(zr[-ZLD0]); kp = bf2f(zr[512 - ZLD0]); vp = bf2f(zr[1024 - ZLD0]); }
        r += (rp - r) * mu_r; k += (kp - k) * mu_k; v += (vp - v) * mu_v;
        const float lw = bf2f(L[(size_t)m * LLD + col]), la = bf2f(L[(size_t)m * LLD + 512 + col]);
        const float e = 0.60653065971f * sigmoidf_(w0 + lw);
        const unsigned eb = pk2(e, 0.f) & 0xffffu;
        const float wdec = __expf(-bf2f(eb));
        const float av = sigmoidf_(a0 + la);
        float kk = k * k_k;
        const float nrm = sqrtf(wave_sum(kk * kk));
        kk = kk / fmaxf(nrm, 1e-12f);
        const float kt = k * (1.f + (av - 1.f) * k_a);
        const float kka = kk * av;
        const float c1 = wave_sum(kka * r), c2 = wave_sum(kt * r), c3 = wave_sum(r * kt * r_k);
        const size_t o = (size_t)m * 512 + col;
        KK[o] = (bf16_t)(pk2(kk, 0.f) & 0xffffu); WR[o] = (bf16_t)(pk2(wdec * r, 0.f) & 0xffffu); WE[o] = (bf16_t)eb;
        KKA[o] = (bf16_t)(pk2(kka, 0.f) & 0xffffu); KT[o] = (bf16_t)(pk2(kt, 0.f) & 0xffffu); VS[o] = (bf16_t)(pk2(v, 0.f) & 0xffffu);
        if (lane == 0) *(f32x4*)(C + (size_t)m * 32 + h * 4) = (f32x4){c1, c2, c3, 0.f};
    }
}

constexpr int SC_TS = 32, SC_BUF = 5 * SC_TS * 64 + SC_TS * 32 + SC_TS * 2;
__device__ __forceinline__ void scan_unit(int u, const bf16_t* KK, const bf16_t* WR, const bf16_t* WE, const bf16_t* KKA, const bf16_t* KT, const bf16_t* VS, const float* C, float* Y, LAS unsigned char* lds, int tid) {
    const int half = u & 1, h = (u >> 1) & 7, b = u >> 4;
    const int il = tid >> 4, jg = tid & 15;
    LAS float* buf0 = (LAS float*)lds; LAS float* buf1 = buf0 + SC_BUF; LAS float* ybuf = buf1 + SC_BUF;
    float S0 = 0.f, S1 = 0.f, S2 = 0.f, S3 = 0.f;
    const size_t rowbase = (size_t)b * T_;
    const size_t goff = (rowbase + il) * 512 + h * 64 + jg * 4;
    const size_t voff = (rowbase + il) * 512 + h * 64 + half * 32 + jg * 2;
    u32x2 rkk, rwr, rwe, rkka, rkt; unsigned rv; f32x2 rc;
#define SC_GLOAD(t0) do { const size_t d_ = (size_t)(t0) * 512; rkk = *(const u32x2*)(KK + goff + d_); rwr = *(const u32x2*)(WR + goff + d_); rwe = *(const u32x2*)(WE + goff + d_); \
        rkka = *(const u32x2*)(KKA + goff + d_); rkt = *(const u32x2*)(KT + goff + d_); rv = *(const unsigned*)(VS + voff + d_); \
        if (tid < SC_TS) rc = *(const f32x2*)(C + (rowbase + (t0) + tid) * 32 + h * 4); } while (0)
#define SC_EXP4(w) (f32x4){bf2f((w).x & 0xffffu), bf2f((w).x >> 16), bf2f((w).y & 0xffffu), bf2f((w).y >> 16)}
#define SC_LSTORE(bf) do { LAS float* p_ = (bf) + il * 64 + jg * 4; *(LAS f32x4*)(p_) = SC_EXP4(rkk); *(LAS f32x4*)(p_ + 2048) = SC_EXP4(rwr); \
        { f32x4 e_ = SC_EXP4(rwe); *(LAS f32x4*)(p_ + 4096) = (f32x4){__expf(-e_.x), __expf(-e_.y), __expf(-e_.z), __expf(-e_.w)}; } \
        *(LAS f32x4*)(p_ + 6144) = SC_EXP4(rkka); *(LAS f32x4*)(p_ + 8192) = SC_EXP4(rkt); \
        *(LAS f32x2*)((bf) + 10240 + il * 32 + jg * 2) = (f32x2){bf2f(rv & 0xffffu), bf2f(rv >> 16)}; \
        if (tid < SC_TS) *(LAS f32x2*)((bf) + 11264 + tid * 2) = rc; } while (0)
    __syncthreads();
    SC_GLOAD(0); SC_LSTORE(buf0);
    __syncthreads();
    for (int n = 0; n < T_ / SC_TS; ++n) {
        LAS float* cb = (n & 1) ? buf1 : buf0; LAS float* nb = (n & 1) ? buf0 : buf1;
        if (n + 1 < T_ / SC_TS) SC_GLOAD((n + 1) * SC_TS);
#pragma unroll 8
        for (int s = 0; s < SC_TS; ++s) {
            const LAS float* B = cb + s * 64 + jg * 4;
            const f32x4 kk = *(const LAS f32x4*)B, wr = *(const LAS f32x4*)(B + 2048), w = *(const LAS f32x4*)(B + 4096), kka = *(const LAS f32x4*)(B + 6144), kt = *(const LAS f32x4*)(B + 8192);
            const float v = cb[10240 + s * 32 + il]; const f32x2 c = *(const LAS f32x2*)(cb + 11264 + s * 2);
            float sa = (S0 * kk.x + S1 * kk.y) + (S2 * kk.z + S3 * kk.w);
            float uu = (S0 * wr.x + S1 * wr.y) + (S2 * wr.z + S3 * wr.w);
            sa = row16_sum(sa); uu = row16_sum(uu);
            const float y = uu - sa * c.x + v * c.y;
            if (jg == 0) ybuf[s * 32 + il] = y;
            S0 = S0 * w.x + (v * kt.x - sa * kka.x); S1 = S1 * w.y + (v * kt.y - sa * kka.y);
            S2 = S2 * w.z + (v * kt.z - sa * kka.z); S3 = S3 * w.w + (v * kt.w - sa * kka.w);
        }
        __syncthreads();
        if (n + 1 < T_ / SC_TS) SC_LSTORE(nb);
        { const f32x2 yv = *(const LAS f32x2*)(ybuf + il * 32 + jg * 2);
          *(f32x2*)(Y + (rowbase + (size_t)n * SC_TS + il) * 512 + h * 64 + half * 32 + jg * 2) = yv; }
        __syncthreads();
    }
#undef SC_GLOAD
#undef SC_EXP4
#undef SC_LSTORE
}

__device__ __forceinline__ void rwkv_post(const Args& a, const float* Y, const bf16_t* VS, const bf16_t* L, const float* C, bf16_t* O, int gw, int NGW, int lane) {
    const int h = gw & 7, col = h * 64 + lane;
    const float lg = a.in[17][col], lb = a.in[18][col];
    for (int m = gw >> 3; m < M_; m += NGW >> 3) {
        const float y = Y[(size_t)m * 512 + col];
        const float mean = wave_sum(y) * (1.f / 64.f); const float d = y - mean;
        const float var = wave_sum(d * d) * (1.f / 64.f);
        const float yn = d * rsqrtf(var + GN_EPS) * lg + lb;
        const float v = bf2f(VS[(size_t)m * 512 + col]), g = bf2f(L[(size_t)m * LLD + 1024 + col]);
        const float c3 = C[(size_t)m * 32 + h * 4 + 2];
        O[(size_t)m * DM + 512 + col] = (bf16_t)(pk2((yn + c3 * v) * g, 0.f) & 0xffffu);
    }
}

__device__ __forceinline__ void run_gemm0(LAS unsigned char* lds, const bf16_t* A, const bf16_t* Bt, int M, int N, int K, int lda, bf16_t* Oo, int ldc) {
    pg8::Gemm g{A, Bt, M, N, K, lda, (size_t)128, 0}; pg8::StaticOrder S; S.init(M, N, (int)gridDim.x, (int)blockIdx.x);
    pg8::EpiStore<0> E{Oo, ldc, nullptr};

#ifndef NO_GEMM
    pg8::gemm_phase<pg8::EpiStore<0>, pg8::StaticOrder, true, true>(lds, g, S, E);
#endif
}


#define Wt_hyin ((bf16_t*)(ws + WS_HYIN))
#define Wt_hyout ((bf16_t*)(ws + WS_HYOUT))
#define Wt_nsain ((bf16_t*)(ws + WS_NSAIN))
#define Wt_nsaout ((bf16_t*)(ws + WS_NSAOUT))
#define Wt_lora ((bf16_t*)(ws + WS_LORA))
#define Wt_cw1k ((bf16_t*)(ws + WS_CW1K))
#define Wt_cw1v ((bf16_t*)(ws + WS_CW1V))
#define cbias ((float*)(ws + WS_CBIAS))
#define H ((bf16_t*)(ws + WS_H))
#define Z ((bf16_t*)(ws + WS_Z))
#define AP ((bf16_t*)(ws + WS_AP))
#define O ((bf16_t*)(ws + WS_O))
#define L ((bf16_t*)(ws + WS_L))
#define C ((float*)(ws + WS_C))
#define MM ((bf16_t*)(ws + WS_MM))
#define Y ((float*)(ws + WS_MM))
#define HID ((bf16_t*)(ws + WS_HID))
#define KC ((bf16_t*)(ws + WS_KCMP))
#define VC ((bf16_t*)(ws + WS_VCMP))
#define U ((bf16_t*)(ws + WS_U))
#define KK ((bf16_t*)(ws + WS_H))
#define WR (KK + (size_t)M_ * 512)
#define WE ((bf16_t*)args.out)
#define KKA (WE + (size_t)M_ * 512)
#define KT (WE + (size_t)M_ * 1024)
#define VS (WE + (size_t)M_ * 1536)
#define XIN (args.in[0])
#define X (args.out)
#define PH_BEGIN unsigned char* ws = args.ws; asm volatile("" : "+s"(ws)); int tid_ = threadIdx.x; asm volatile("" : "+v"(tid_)); const int tid = tid_, lane = tid & 63, wave = __builtin_amdgcn_readfirstlane(tid >> 6); const int G = gridDim.x, gw = blockIdx.x * 8 + wave, NGW = G * 8; const int gtid = blockIdx.x * 512 + tid, NT = G * 512; (void)lane; (void)gw; (void)NGW; (void)gtid; (void)NT; (void)ws;
__global__ void __launch_bounds__(512, 2) mega_fwd(Args args) {
    extern __shared__ __attribute__((aligned(16))) unsigned char lds_raw[];
    LAS unsigned char* lds = (LAS unsigned char*)lds_raw;
    cg::grid_group grid = cg::this_grid();
    const int lo = args.ph_lo, hi = args.ph_hi;
#define IN(k) (lo <= (k) && (k) < hi)
#define SEAM(k) do { if (IN(k) && IN((k) + 1)) grid.sync(); } while (0)

    if (IN(0)) { PH_BEGIN
        LAS float* scr = (LAS float*)(lds + wave * 16384);
        constexpr int I0 = 16 * 80, I1 = 16 * 32, I2 = 16 * 88, I3 = 16 * 32, I4 = 16 * 176, I5 = 44 * 32, I6 = 32 * 8;
        constexpr int NIT = I0 + I1 + I2 + I3 + 2 * I4 + 2 * I5 + 2 * I6;
        for (int it = gw; it < NIT; it += NGW) {
            int r = it;
            if (r < I0) { transpose_item(args.in[5], 2560, Wt_hyin, 1024, scr, r, 80, lane); continue; } r -= I0;
            if (r < I1) { transpose_item(args.in[6], 1024, Wt_hyout, 1024, scr, r, 32, lane); continue; } r -= I1;
            if (r < I2) { transpose_item(args.in[19], 2608, Wt_nsain, 1024, scr, r, 88, lane); continue; } r -= I2;
            if (r < I3) { transpose_item(args.in[20], 1024, Wt_nsaout, 1024, scr, r, 32, lane); continue; } r -= I3;
            if (r < 2 * I4) { const int l = r / I4; transpose_item(args.in[27] + (size_t)l * 1024 * 5632, 5632, (bf16_t*)(ws + (l ? WS_UP1 : WS_UP0)), 1024, scr, r % I4, 176, lane); continue; } r -= 2 * I4;
            if (r < 2 * I5) { const int l = r / I5; transpose_item(args.in[30] + (size_t)l * 2816 * 1024, 1024, (bf16_t*)(ws + (l ? WS_DN1 : WS_DN0)), 2816, scr, r % I5, 32, lane); continue; } r -= 2 * I5;
            if (r < I6) { transpose_item(args.in[22], 256, Wt_cw1k, 2048, scr, r, 8, lane); continue; } r -= I6;
            transpose_item(args.in[25], 256, Wt_cw1v, 2048, scr, r, 8, lane);
        }
        for (int e = gtid; e < 1536 * 256; e += NT) {
            const int n = e >> 8, k = e & 255; float v = 0.f;
            if (n < 512) { if (k < 64) v = args.in[10][k * 512 + n]; }
            else if (n < 1024) { if (k >= 64 && k < 128) v = args.in[12][(k - 64) * 512 + (n - 512)]; }
            else { if (k >= 128) v = args.in[13][(k - 128) * 512 + (n - 1024)]; }
            Wt_lora[e] = (bf16_t)(pk2(v, 0.f) & 0xffffu);
        }
        for (int it = gw; it < 512; it += NGW) {
            const int which = it >> 8, f = it & 255; const float* pos = args.in[which ? 24 : 21]; const float* w1 = args.in[which ? 25 : 22];
            float s = 0.f;
            for (int e = lane; e < 2048; e += 64) s += pos[e] * w1[(size_t)e * 256 + f];
            s = wave_sum(s);
            if (lane == 0) cbias[it] = s;
        }
        norm_phase(XIN, nullptr, nullptr, nullptr, args.in[1], H, gw, NGW, lane);
    }
    SEAM(0);
    if (IN(1)) { PH_BEGIN run_gemm0(lds, H, Wt_hyin, M_, ZLD0, 1024, 1024, Z, ZLD0); }
    SEAM(1);
    if (IN(2)) { PH_BEGIN
        const float* mu = args.in[8];
        for (int it = gtid; it < M_ * 32; it += NT) {
            const int m = it >> 5, col = (it & 31) * 8;
            const bf16_t* zp = Z + (size_t)m * ZLD0 + 2304 + col;
            const u32x4 zc = *(const u32x4*)zp; u32x4 zq = (u32x4){0u, 0u, 0u, 0u};
            if ((m & (T_ - 1)) != 0) zq = *(const u32x4*)(zp - ZLD0);
            const unsigned cw[4] = {zc.x, zc.y, zc.z, zc.w}, pw[4] = {zq.x, zq.y, zq.z, zq.w}; unsigned ow[4];
#pragma unroll
            for (int e = 0; e < 4; ++e) {
                float a0 = bf2f(cw[e] & 0xffffu), a1 = bf2f(cw[e] >> 16); const float p0 = bf2f(pw[e] & 0xffffu), p1 = bf2f(pw[e] >> 16);
                a0 += (p0 - a0) * mu[1536 + col + 2 * e]; a1 += (p1 - a1) * mu[1536 + col + 2 * e + 1];
                if (col < 64) { a0 = tanhf(a0); a1 = tanhf(a1); } else if (col >= 128) { a0 = sigmoidf_(a0); a1 = sigmoidf_(a1); }
                ow[e] = pk2(a0, a1);
            }
            *(u32x4*)(AP + (size_t)m * 256 + col) = (u32x4){ow[0], ow[1], ow[2], ow[3]};
        }

#ifndef NO_SWA
for (int u = blockIdx.x; u < NB_ * 64 * 2; u += G) swa_unit(u, Z, O, args.in[7], lds, tid);
#endif

        __syncthreads();
    }
    SEAM(2);
    if (IN(3)) { PH_BEGIN run_gemm0(lds, AP, Wt_lora, M_, LLD, 256, 256, L, LLD); }
    SEAM(3);
    if (IN(4)) { PH_BEGIN rwkv_prep(args, Z, L, KK, WR, WE, KKA, KT, VS, C, gw, NGW, lane); }
    SEAM(4);
    if (IN(5)) { PH_BEGIN
#ifndef NO_SCAN
for (int u = blockIdx.x; u < 256; u += G) scan_unit(u, KK, WR, WE, KKA, KT, VS, C, Y, lds, tid);
#endif
 }
    SEAM(5);
    if (IN(6)) { PH_BEGIN rwkv_post(args, Y, VS, L, C, O, gw, NGW, lane); }
    SEAM(6);
    if (IN(7)) { PH_BEGIN run_gemm0(lds, O, Wt_hyout, M_, 1024, 1024, 1024, MM, 1024); }
    SEAM(7);
    if (IN(8)) { PH_BEGIN norm_phase(XIN, MM, args.in[2], X, args.in[3], H, gw, NGW, lane); }
    SEAM(8);
#pragma unroll
    for (int l = 0; l < 2; ++l) {
        const int pb = l ? 19 : 9;
        if (IN(pb)) { PH_BEGIN run_gemm0(lds, H, (const bf16_t*)(ws + (l ? WS_UP1 : WS_UP0)), M_, ULD, 1024, 1024, U, ULD); }
        SEAM(pb);
        if (IN(pb + 1)) { PH_BEGIN
            const float* cw = args.in[28] + (size_t)l * 3 * FF_; const float* cbv = args.in[29] + (size_t)l * FF_;
            for (int it = gtid; it < M_ * (FF_ / 8); it += NT) {
                const int m = it / (FF_ / 8), f = (it % (FF_ / 8)) * 8, t = m & (T_ - 1);
                const bf16_t* up = U + (size_t)m * ULD + f;
                const u32x4 g0 = *(const u32x4*)up, vv = *(const u32x4*)(up + FF_);
                u32x4 g1 = (u32x4){0u, 0u, 0u, 0u}, g2 = g1;
                if (t >= 1) g1 = *(const u32x4*)(up - ULD);
                if (t >= 2) g2 = *(const u32x4*)(up - 2 * ULD);
                const unsigned a0[4] = {g0.x, g0.y, g0.z, g0.w}, a1[4] = {g1.x, g1.y, g1.z, g1.w}, a2[4] = {g2.x, g2.y, g2.z, g2.w}, av[4] = {vv.x, vv.y, vv.z, vv.w}; unsigned ow[4];
#pragma unroll
                for (int e = 0; e < 4; ++e) {
                    const int f0 = f + 2 * e;
                    const float c0 = cbv[f0] + bf2f(a0[e] & 0xffffu) * cw[2 * FF_ + f0] + bf2f(a1[e] & 0xffffu) * cw[FF_ + f0] + bf2f(a2[e] & 0xffffu) * cw[f0];
                    const float c1 = cbv[f0 + 1] + bf2f(a0[e] >> 16) * cw[2 * FF_ + f0 + 1] + bf2f(a1[e] >> 16) * cw[FF_ + f0 + 1] + bf2f(a2[e] >> 16) * cw[f0 + 1];
                    ow[e] = pk2(pg8::gelu_tanh(c0) * bf2f(av[e] & 0xffffu), pg8::gelu_tanh(c1) * bf2f(av[e] >> 16));
                }
                *(u32x4*)(U + (size_t)m * ULD + FF_ + f) = (u32x4){ow[0], ow[1], ow[2], ow[3]};
            }
        }
        SEAM(pb + 1);
        if (IN(pb + 2)) { PH_BEGIN run_gemm0(lds, U + FF_, (const bf16_t*)(ws + (l ? WS_DN1 : WS_DN0)), M_, 1024, FF_, ULD, MM, 1024); }
        SEAM(pb + 2);
        if (IN(pb + 3)) { PH_BEGIN
            if (l == 0) norm_phase(X, MM, args.in[4], X, args.in[1] + 1024, H, gw, NGW, lane);
            else norm_phase(X, MM, args.in[4] + 1024, X, nullptr, nullptr, gw, NGW, lane);
        }
        if (l == 0) {
            SEAM(12);
            if (IN(13)) { PH_BEGIN run_gemm0(lds, H, Wt_nsain, M_, ZLD1, 1024, 1024, Z, ZLD1); }
            SEAM(13);
            if (IN(14)) { PH_BEGIN
                const int G2 = G >> 1, which = (int)blockIdx.x >= G2 ? 1 : 0;
                pg8::Gemm g{Z + 1024 + which * 256, which ? Wt_cw1v : Wt_cw1k, 16384, 256, 2048, 16 * ZLD1, (size_t)ZLD1 * 2, 1};
                pg8::StaticOrder S; S.init(16384, 256, G2, (int)blockIdx.x - which * G2);
                pg8::EpiStore<2> E{HID + (size_t)which * 16384 * 256, 256, cbias + which * 256};

#ifndef NO_GEMM2
if ((int)blockIdx.x < 2 * G2) pg8::gemm_phase<pg8::EpiStore<2>, pg8::StaticOrder, true, true>(lds, g, S, E);
#endif

            }
            SEAM(14);
            if (IN(15)) { PH_BEGIN
                for (int row = gw; row < 2 * 16384; row += NGW) {
                    const int which = row >> 14; const float* w2 = args.in[which ? 26 : 23]; const bf16_t* hp = HID + (size_t)row * 256;
                    float acc = 0.f;
#pragma unroll 8
                    for (int f = 0; f < 256; ++f) acc += bf2f(hp[f]) * w2[f * 64 + lane];
                    (which ? VC : KC)[(size_t)(row & 16383) * 64 + lane] = (bf16_t)(pk2(acc, 0.f) & 0xffffu);
                }
            }
            SEAM(15);
            if (IN(16)) { PH_BEGIN
#ifndef NO_NSA
for (int u = blockIdx.x; u < 64 * 64; u += G) nsa_unit(u, Z, KC, VC, O, lds, tid);
#endif
 }
            SEAM(16);
            if (IN(17)) { PH_BEGIN run_gemm0(lds, O, Wt_nsaout, M_, 1024, 1024, 1024, MM, 1024); }
            SEAM(17);
            if (IN(18)) { PH_BEGIN norm_phase(X, MM, args.in[2] + 1024, X, args.in[3] + 1024, H, gw, NGW, lane); }
            SEAM(18);
        }
    }
#undef IN
#undef SEAM
}

#undef XIN
#undef X
#undef H
#undef Z
#undef O
#undef L
#undef C
#undef U
#undef Y
extern "C" void kernel_launch(void* const* d_in, const int* in_sizes, int n_in, void* d_out, int out_size, void* d_ws, size_t ws_size, hipStream_t stream) {
    static int grid = 0;
    if (grid == 0) {
        if (n_in != 31 || out_size != M_ * DM || ws_size < WS_END) { fprintf(stderr, "kernel_launch: unexpected shapes (n_in %d out %d ws %zu)\n", n_in, out_size, ws_size); grid = -1; return; }
        int dev = 0, cus = 0, per_cu = 0;
        hipGetDevice(&dev); hipDeviceGetAttribute(&cus, hipDeviceAttributeMultiprocessorCount, dev);
        hipFuncSetAttribute((const void*)mega_fwd, hipFuncAttributeMaxDynamicSharedMemorySize, LDS_BYTES);
        hipOccupancyMaxActiveBlocksPerMultiprocessor(&per_cu, (const void*)mega_fwd, 512, LDS_BYTES);
        if (per_cu < 1) { fprintf(stderr, "kernel_launch: occupancy query says %d blocks/CU\n", per_cu); per_cu = 1; }
        (void)hipGetLastError();
        grid = cus * 1;
    }
    if (grid < 0) return;
    Args a{};
    for (int i = 0; i < 31; ++i) a.in[i] = (const float*)d_in[i];
    a.out = (float*)d_out; a.ws = (unsigned char*)d_ws;
#if ONE_LAUNCH
    a.ph_lo = 0; a.ph_hi = NPHASE;
    void* kargs[] = {&a};
    hipError_t e = hipLaunchCooperativeKernel((const void*)mega_fwd, dim3(grid), dim3(512), kargs, LDS_BYTES, stream);
    if (e != hipSuccess) fprintf(stderr, "cooperative launch failed: %s (grid %d)\n", hipGetErrorString(e), grid);
#else
    for (int p = 0; p < NPHASE; ++p) { a.ph_lo = p; a.ph_hi = p + 1; hipLaunchKernelGGL(mega_fwd, dim3(grid), dim3(512), LDS_BYTES, stream, a); }
#endif
}
```

```cpp
#include <hip/hip_runtime.h>
#include <hip/hip_cooperative_groups.h>
#include <cstdio>
#include <cstdint>
namespace cg = cooperative_groups;

#ifndef ONE_LAUNCH
#define ONE_LAUNCH 1
#endif

namespace pg8 {
#define PG8_LAS __attribute__((address_space(3)))
typedef unsigned short bf16_t;
typedef short bf16x8 __attribute__((ext_vector_type(8)));
typedef float f32x4 __attribute__((ext_vector_type(4)));
typedef unsigned u32x4 __attribute__((ext_vector_type(4)));
constexpr int BM = 256, BK = 64, HALF = 128, HTB = HALF * BK * 2  , STAGE_BYTES = 8 * HTB, NXCD = 8, WGM = 8;

__host__ __device__ __forceinline__ int lds_byte(int r, int c) { const int st = (r >> 4) * 2 + (c >> 5), rr = r & 15, cc = c & 31, ob = rr * 64 + cc * 2; return st * 1024 + (ob ^ (((ob >> 9) & 1) << 5)); }
__host__ __device__ __forceinline__ void stage_rc(int b, int& R, int& C) { const int st = b / 1024, sb = b % 1024, swz = sb ^ (((sb >> 9) & 1) << 5); R = (st >> 1) * 16 + swz / 64; C = (st & 1) * 32 + (swz % 64) / 2; }
__host__ __device__ __forceinline__ int perm32(int rho) { const int n = rho >> 4, i = rho & 15; return 8 * (i >> 2) + 4 * n + (i & 3); }

struct Unit { int pm, pn; };
struct Gemm { const bf16_t* A; const bf16_t* Bt; int M, N, K; int lda; size_t a_kstep; int amode; };
__device__ __forceinline__ const char* a_base(const Gemm& g, int pm) { return g.amode == 0 ? (const char*)g.A + (size_t)pm * ((size_t)BM * g.lda * 2) : (const char*)g.A + (size_t)(pm >> 2) * ((size_t)4096 * 2816 * 2) + (size_t)(pm & 3) * 128; }

struct StaticOrder {
    int nM, nN, nwg, G, c;
    __host__ __device__ void init(int M, int N, int G_, int c_) { nM = M / BM; nN = N / BM; nwg = nM * nN; G = G_; c = c_; }
    __host__ __device__ bool next(int i, Unit& u) const {
        const long L = (long)i * G + c; if (L >= nwg) return false;
        int wgid = (int)L; { const int q = nwg / NXCD, r = nwg % NXCD, xcd = wgid % NXCD, off = wgid / NXCD; wgid = (xcd < r ? xcd * (q + 1) : r * (q + 1) + (xcd - r) * q) + off; }
        const int nig = WGM * nN, gid = wgid / nig, fm = gid * WGM, gsz = (nM - fm) < WGM ? (nM - fm) : WGM;
        u.pm = fm + ((wgid % nig) % gsz); u.pn = (wgid % nig) / gsz; return true;
    }
    __device__ __forceinline__ void a_ready(const Unit&) const {}
    __device__ __forceinline__ void done(const Unit&) const {}
};


__device__ __forceinline__ unsigned cvt_pk_bf16(float lo, float hi) { unsigned r; asm volatile("v_cvt_pk_bf16_f32 %0, %1, %2" : "=v"(r) : "v"(lo), "v"(hi)); return r; }
__device__ __forceinline__ float gelu_tanh(float x) { const float u = 1.5957691216f * (x + 0.044715f * x * x * x); return x / (1.0f + __expf(-u)); }
template <int ACT> struct EpiStore {
    static constexpr bool PERM = true, AFTER_DRAIN = false;
    bf16_t* O; int ldc; const float* bias;
    __device__ __forceinline__ void operator()(const f32x4 (&acc)[2][2][4][2], const Unit& u, int wr, int wc, int fr, int fq) const {
        const int row0 = u.pm * BM + wr * 64 + fr; const int col0 = u.pn * BM + wc * 32 + 8 * fq;
        f32x4 bv[2][2];
#pragma unroll
        for (int bj = 0; bj < 2; ++bj)
#pragma unroll
            for (int n = 0; n < 2; ++n) bv[bj][n] = bias ? *(const f32x4*)(bias + col0 + bj * HALF + 4 * n) : (f32x4){0.f, 0.f, 0.f, 0.f};
#pragma unroll
        for (int ai = 0; ai < 2; ++ai)
#pragma unroll
            for (int m = 0; m < 4; ++m) { bf16_t* rowp = O + (size_t)(row0 + ai * HALF + m * 16) * ldc + col0;
#pragma unroll
                for (int bj = 0; bj < 2; ++bj) { f32x4 v0 = acc[ai][bj][m][0] + bv[bj][0], v1 = acc[ai][bj][m][1] + bv[bj][1];
                    if (ACT == 2) { v0 = (f32x4){gelu_tanh(v0[0]), gelu_tanh(v0[1]), gelu_tanh(v0[2]), gelu_tanh(v0[3])}; v1 = (f32x4){gelu_tanh(v1[0]), gelu_tanh(v1[1]), gelu_tanh(v1[2]), gelu_tanh(v1[3])}; }
                    u32x4 w; w.x = cvt_pk_bf16(v0[0], v0[1]); w.y = cvt_pk_bf16(v0[2], v0[3]); w.z = cvt_pk_bf16(v1[0], v1[1]); w.w = cvt_pk_bf16(v1[2], v1[3]);
                    *(u32x4*)(rowp + bj * HALF) = w; } }
    }
};

template <class Epi, class Sched, bool ALIGN_EPI = false, bool SP2 = false>
__device__ __forceinline__ void gemm_phase(PG8_LAS unsigned char* lds, const Gemm g, const Sched& S, const Epi& E) {
    int tid = threadIdx.x; asm volatile("" : "+v"(tid)); const int wid = __builtin_amdgcn_readfirstlane(tid >> 6), lane = tid & 63, wr = wid >> 2, wc = wid & 3, fr = lane & 15, fq = lane >> 4;
    const int K = g.K, nt = K / BK;
    unsigned voffA[2], voffB[2];
#pragma unroll
    for (int i = 0; i < 2; ++i) { int R, C; stage_rc(tid * 16 + i * 8192, R, C); const int Rb = Epi::PERM ? ((R & ~31) + perm32(R & 31)) : R;
        voffA[i] = (unsigned)(R * g.lda + C) * 2u; voffB[i] = (unsigned)(Rb * K + C) * 2u; }
    const size_t kstep = (size_t)(BK * 2);
    const size_t hstepB = (size_t)HALF * K * 2, hstepA = (size_t)HALF * g.lda * 2, kstepA = g.a_kstep;
    const size_t tstep = 2 * hstepB;
    const unsigned ldsw = (unsigned)wid * 1024u;
    const int aoff = lds_byte(wr * 64 + fr, fq * 8), boff = lds_byte(wc * 32 + fr, fq * 8);
#define PG8_SA(b, h) (((b) * 2 + (h)) * HTB)
#define PG8_SB(b, h) ((4 + (b) * 2 + (h)) * HTB)
#define PG8_STAGE(bufoff, gbase, voff) do { _Pragma("unroll") for (int _i = 0; _i < 2; ++_i) \
        __builtin_amdgcn_global_load_lds((const unsigned*)((const char*)(gbase) + (voff)[_i]), (PG8_LAS unsigned*)(lds + (bufoff) + ldsw + _i * 8192), 16, 0, 0); } while (0)
#define PG8_LDA(dst, b, h) do { _Pragma("unroll") for (int m = 0; m < 4; ++m) _Pragma("unroll") for (int k = 0; k < 2; ++k) dst[m][k] = *(const PG8_LAS bf16x8*)(lds + PG8_SA(b, h) + aoff + m * 2048 + k * 1024); } while (0)
#define PG8_LDB(dst, b, h) do { _Pragma("unroll") for (int n = 0; n < 2; ++n) _Pragma("unroll") for (int k = 0; k < 2; ++k) dst[n][k] = *(const PG8_LAS bf16x8*)(lds + PG8_SB(b, h) + boff + n * 2048 + k * 1024); } while (0)
#define PG8_MMA(ai, bj, At, Bt) do { __builtin_amdgcn_s_setprio(1); _Pragma("unroll") for (int m = 0; m < 4; ++m) _Pragma("unroll") for (int n = 0; n < 2; ++n) _Pragma("unroll") for (int k = 0; k < 2; ++k) \
        acc[ai][bj][m][n] = __builtin_amdgcn_mfma_f32_16x16x32_bf16(Bt[n][k], At[m][k], acc[ai][bj][m][n], 0, 0, 0); __builtin_amdgcn_s_setprio(0); } while (0)
#define PG8_WAIT_V(n) asm volatile("s_waitcnt vmcnt(" #n ")" ::: "memory")
#define PG8_WAIT_L(n) asm volatile("s_waitcnt lgkmcnt(" #n ")" ::: "memory")
#define PG8_BAR __builtin_amdgcn_s_barrier()
#define PG8_SCHED __builtin_amdgcn_sched_barrier(0)
    Unit cur, nxt; int ui = 0;
    if (!S.next(0, cur)) return;
    f32x4 acc[2][2][4][2];
#pragma unroll
    for (int a = 0; a < 2; ++a)
#pragma unroll
        for (int b = 0; b < 2; ++b)
#pragma unroll
            for (int m = 0; m < 4; ++m)
#pragma unroll
                for (int n = 0; n < 2; ++n) acc[a][b][m][n] = (f32x4){0.f, 0.f, 0.f, 0.f};
    bf16x8 At[4][2], B0[2][2], B1[2][2];
    const char* cA = a_base(g, cur.pm); const char* cB = (const char*)g.Bt + (size_t)cur.pn * tstep;
    S.a_ready(cur);
    if constexpr (SP2) {
        PG8_STAGE(PG8_SB(0, 0), cB, voffB); PG8_STAGE(PG8_SB(0, 1), cB + hstepB, voffB); PG8_STAGE(PG8_SA(0, 0), cA, voffA); PG8_STAGE(PG8_SA(0, 1), cA + hstepA, voffA);
        if (wr == 1) PG8_BAR;
        PG8_WAIT_V(2); PG8_BAR;
        PG8_STAGE(PG8_SB(1, 0), cB + kstep, voffB); PG8_STAGE(PG8_SA(1, 0), cA + kstepA, voffA); PG8_STAGE(PG8_SB(1, 1), cB + hstepB + kstep, voffB);
        PG8_WAIT_V(6); PG8_BAR;
    } else {
        PG8_STAGE(PG8_SB(0, 0), cB, voffB); PG8_STAGE(PG8_SA(0, 0), cA, voffA); PG8_STAGE(PG8_SB(0, 1), cB + hstepB, voffB); PG8_STAGE(PG8_SA(0, 1), cA + hstepA, voffA);
        if (wr == 1) PG8_BAR;
        PG8_WAIT_V(4); PG8_BAR;
        PG8_STAGE(PG8_SB(1, 0), cB + kstep, voffB); PG8_STAGE(PG8_SA(1, 0), cA + kstepA, voffA); PG8_STAGE(PG8_SB(1, 1), cB + hstepB + kstep, voffB);
        PG8_WAIT_V(6); PG8_BAR;
    }
    for (;;) {
        const bool has_next = S.next(ui + 1, nxt);
        const char* nA = has_next ? a_base(g, nxt.pm) : cA; const char* nB = has_next ? (const char*)g.Bt + (size_t)nxt.pn * tstep : cB;
        for (int t = 0; t < nt; t += 2) {
            const bool last = (t == nt - 2);
            const char* a1 = cA + (size_t)(t + 1) * kstepA;
            const char* a2 = last ? nA : cA + (size_t)(t + 2) * kstepA; const char* b2 = last ? nB : cB + (size_t)(t + 2) * kstep;
            const char* a3 = a2 + kstepA; const char* b3 = b2 + kstep;
            if (last && has_next) S.a_ready(nxt);
            if constexpr (SP2) {
            PG8_LDB(B0, 0, 0); PG8_LDB(B1, 0, 1); PG8_SCHED; PG8_LDA(At, 0, 0); PG8_STAGE(PG8_SA(1, 1), a1 + hstepA, voffA);
            PG8_WAIT_V(8); PG8_WAIT_L(0); PG8_BAR; PG8_MMA(0, 0, At, B0); PG8_MMA(0, 1, At, B1); PG8_BAR; PG8_SCHED;
            PG8_LDA(At, 0, 1); PG8_STAGE(PG8_SB(0, 0), b2, voffB); PG8_STAGE(PG8_SB(0, 1), b2 + hstepB, voffB); PG8_STAGE(PG8_SA(0, 0), a2, voffA);
            PG8_WAIT_V(8); PG8_WAIT_L(0); PG8_BAR; PG8_MMA(1, 0, At, B0); PG8_MMA(1, 1, At, B1); PG8_BAR; PG8_SCHED;
            PG8_LDB(B0, 1, 0); PG8_LDB(B1, 1, 1); PG8_SCHED; PG8_LDA(At, 1, 0); PG8_STAGE(PG8_SA(0, 1), a2 + hstepA, voffA);
            PG8_WAIT_V(8); PG8_WAIT_L(0); PG8_BAR; PG8_MMA(0, 0, At, B0); PG8_MMA(0, 1, At, B1); PG8_BAR; PG8_SCHED;
            PG8_LDA(At, 1, 1); PG8_STAGE(PG8_SB(1, 0), b3, voffB); PG8_STAGE(PG8_SB(1, 1), b3 + hstepB, voffB); PG8_STAGE(PG8_SA(1, 0), a3, voffA);
            PG8_WAIT_V(8); PG8_WAIT_L(0); PG8_BAR; PG8_MMA(1, 0, At, B0); PG8_MMA(1, 1, At, B1); PG8_BAR; PG8_SCHED;
            } else {
            PG8_LDB(B0, 0, 0); PG8_SCHED; PG8_LDA(At, 0, 0); PG8_STAGE(PG8_SA(1, 1), a1 + hstepA, voffA);
            PG8_WAIT_L(8); PG8_BAR; PG8_WAIT_L(0); PG8_MMA(0, 0, At, B0); PG8_BAR; PG8_SCHED;
            PG8_LDB(B1, 0, 1); PG8_STAGE(PG8_SB(0, 0), b2, voffB);
            PG8_BAR; PG8_WAIT_L(0); PG8_MMA(0, 1, At, B1); PG8_BAR;
            PG8_LDA(At, 0, 1); PG8_STAGE(PG8_SA(0, 0), a2, voffA);
            PG8_BAR; PG8_WAIT_L(0); PG8_MMA(1, 0, At, B0); PG8_BAR; PG8_SCHED;
            PG8_STAGE(PG8_SB(0, 1), b2 + hstepB, voffB);
            PG8_WAIT_V(6); PG8_BAR; PG8_MMA(1, 1, At, B1); PG8_BAR;
            PG8_LDB(B0, 1, 0); PG8_SCHED; PG8_LDA(At, 1, 0); PG8_STAGE(PG8_SA(0, 1), a2 + hstepA, voffA);
            PG8_WAIT_L(8); PG8_BAR; PG8_WAIT_L(0); PG8_MMA(0, 0, At, B0); PG8_BAR; PG8_SCHED;
            PG8_LDB(B1, 1, 1); PG8_STAGE(PG8_SB(1, 0), b3, voffB);
            PG8_BAR; PG8_WAIT_L(0); PG8_MMA(0, 1, At, B1); PG8_BAR;
            PG8_LDA(At, 1, 1); PG8_STAGE(PG8_SA(1, 0), a3, voffA);
            PG8_BAR; PG8_WAIT_L(0); PG8_MMA(1, 0, At, B0); PG8_BAR; PG8_SCHED;
            PG8_STAGE(PG8_SB(1, 1), b3 + hstepB, voffB);
            PG8_WAIT_V(6); PG8_BAR; PG8_MMA(1, 1, At, B1); PG8_BAR;
            }
        }
        if constexpr (ALIGN_EPI) { if (wr == 0) PG8_BAR; }
        if constexpr (!Epi::AFTER_DRAIN) { E(acc, cur, wr, wc, fr, fq); S.done(cur); }
        if (!has_next) break;
#pragma unroll
        for (int a = 0; a < 2; ++a)
#pragma unroll
            for (int b = 0; b < 2; ++b)
#pragma unroll
                for (int m = 0; m < 4; ++m)
#pragma unroll
                    for (int n = 0; n < 2; ++n) acc[a][b][m][n] = (f32x4){0.f, 0.f, 0.f, 0.f};
        cur = nxt; cA = nA; cB = nB; ++ui;
        if constexpr (ALIGN_EPI) { if (wr == 1) PG8_BAR; }
    }
    PG8_WAIT_V(0);
    if constexpr (!ALIGN_EPI) { if (wr == 0) PG8_BAR; }
    PG8_BAR;
    if constexpr (Epi::AFTER_DRAIN) { E.fused(acc, cur, wr, wc, fr, fq, lds, wid, lane); S.done(cur); }
#undef PG8_SA
#undef PG8_SB
#undef PG8_STAGE
#undef PG8_LDA
#undef PG8_LDB
#undef PG8_MMA
#undef PG8_WAIT_V
#undef PG8_WAIT_L
#undef PG8_BAR
#undef PG8_SCHED
}
}


#define LAS __attribute__((address_space(3)))
typedef unsigned short bf16_t;
typedef short bf16x8 __attribute__((ext_vector_type(8)));
typedef short s16x4 __attribute__((ext_vector_type(4)));
typedef float f32x4 __attribute__((ext_vector_type(4)));
typedef float f32x2 __attribute__((ext_vector_type(2)));
typedef float f32x16 __attribute__((ext_vector_type(16)));
typedef unsigned u32x4 __attribute__((ext_vector_type(4)));
typedef unsigned u32x2 __attribute__((ext_vector_type(2)));

constexpr int T_ = 4096, NB_ = 16, M_ = NB_ * T_, DM = 1024;
constexpr int ZLD0 = 2560, ZLD1 = 2816, FF_ = 2816, ULD = 5632, LLD = 1536;
constexpr float NORM_EPS = 1e-6f, GN_EPS = 64e-5f;
constexpr size_t MiB = (size_t)1 << 20;
constexpr size_t WS_HYIN = 1 * MiB, WS_HYOUT = 6 * MiB, WS_NSAIN = 8 * MiB, WS_NSAOUT = 14 * MiB, WS_UP0 = 16 * MiB, WS_UP1 = 27 * MiB,
                 WS_DN0 = 38 * MiB, WS_DN1 = 44 * MiB, WS_LORA = 50 * MiB, WS_CW1K = 51 * MiB, WS_CW1V = 52 * MiB, WS_CBIAS = 53 * MiB;
constexpr size_t WS_H = 64 * MiB, WS_Z = 192 * MiB, WS_AP = 512 * MiB, WS_O = 544 * MiB, WS_L = 672 * MiB, WS_C = 864 * MiB, WS_MM = 896 * MiB;
constexpr size_t WS_HID = 672 * MiB, WS_KCMP = 688 * MiB, WS_VCMP = 690 * MiB, WS_U = 192 * MiB, WS_END = 1024 * MiB;
constexpr int LDS_BYTES = 147456;
constexpr int NPHASE = 23;

__device__ __forceinline__ float bf2f(unsigned u) { return __uint_as_float(u << 16); }
__device__ __forceinline__ unsigned pk2(float lo, float hi) { return pg8::cvt_pk_bf16(lo, hi); }
__device__ __forceinline__ float wave_sum(float v) {
#pragma unroll
    for (int o = 1; o < 64; o <<= 1) v += __shfl_xor(v, o);
    return v;
}
__device__ __forceinline__ float sigmoidf_(float x) { return 1.0f / (1.0f + __expf(-x)); }
#define LDS_WAIT() asm volatile("s_waitcnt lgkmcnt(0)" ::: "memory")

struct Args { const float* in[31]; float* out; unsigned char* ws; int ph_lo, ph_hi; };

__device__ __forceinline__ void transpose_item(const float* W, int N, bf16_t* WT, int ldt, LAS float* scr, int item, int nblk, int lane) {
    const int kb = item / nblk, nb = item % nblk, k0 = 64 * kb, n0 = 32 * nb;
    const int n = n0 + (lane & 31);
#pragma unroll 8
    for (int i = 0; i < 32; ++i) { const int kk = 2 * i + (lane >> 5); scr[kk * 33 + (lane & 31)] = (n < N) ? W[(size_t)(k0 + kk) * N + n] : 0.f; }
    LDS_WAIT(); asm volatile("" ::: "memory");
    const int c = lane & 7;
#pragma unroll
    for (int j = 0; j < 4; ++j) { const int nn = (lane >> 3) + 8 * j; const LAS float* s = scr + (8 * c) * 33 + nn;
        u32x4 o; o.x = pk2(s[0 * 33], s[1 * 33]); o.y = pk2(s[2 * 33], s[3 * 33]); o.z = pk2(s[4 * 33], s[5 * 33]); o.w = pk2(s[6 * 33], s[7 * 33]);
        *(u32x4*)(WT + (size_t)(n0 + nn) * ldt + k0 + 8 * c) = o; }
    LDS_WAIT(); asm volatile("" ::: "memory");
}

__device__ __forceinline__ void norm_phase(const float* xin, const bf16_t* mm, const float* gpost, float* xout, const float* gpre, bf16_t* hout, int gw, int NGW, int lane) {
    for (int m = gw; m < M_; m += NGW) {
        const f32x4* xr = (const f32x4*)(xin + (size_t)m * DM) + lane;
        f32x4 v[4];
#pragma unroll
        for (int j = 0; j < 4; ++j) v[j] = xr[64 * j];
        if (mm) {
            const u32x2* mr = (const u32x2*)(mm + (size_t)m * DM) + lane;
            f32x4 q[4]; float ss = 0.f;
#pragma unroll
            for (int j = 0; j < 4; ++j) { const u32x2 w = mr[64 * j]; q[j] = (f32x4){bf2f(w.x & 0xffffu), bf2f(w.x >> 16), bf2f(w.y & 0xffffu), bf2f(w.y >> 16)};
                ss += (q[j].x * q[j].x + q[j].y * q[j].y) + (q[j].z * q[j].z + q[j].w * q[j].w); }
            const float rs = rsqrtf(wave_sum(ss) * (1.f / DM) + NORM_EPS);
#pragma unroll
            for (int j = 0; j < 4; ++j) { const f32x4 g = *((const f32x4*)gpost + lane + 64 * j); v[j] = v[j] + q[j] * rs * g; }
        }
        if (xout) { f32x4* xo = (f32x4*)(xout + (size_t)m * DM) + lane;
#pragma unroll
            for (int j = 0; j < 4; ++j) xo[64 * j] = v[j]; }
        if (hout) {
            float s2 = 0.f;
#pragma unroll
            for (int j = 0; j < 4; ++j) s2 += (v[j].x * v[j].x + v[j].y * v[j].y) + (v[j].z * v[j].z + v[j].w * v[j].w);
            const float rs2 = rsqrtf(wave_sum(s2) * (1.f / DM) + NORM_EPS);
            u32x2* ho = (u32x2*)(hout + (size_t)m * DM) + lane;
#pragma unroll
            for (int j = 0; j < 4; ++j) { const f32x4 g = *((const f32x4*)gpre + lane + 64 * j); const f32x4 h = v[j] * rs2 * g;
                u32x2 w; w.x = pk2(h.x, h.y); w.y = pk2(h.z, h.w); ho[64 * j] = w; }
        }
    }
}

constexpr int KROW = 144, VROW = 152, KT_BYTES = 64 * KROW, VT_BYTES = 64 * VROW;
constexpr float NEGBIG = -1e30f;
__device__ __forceinline__ int crow(int r, int hi) { return (r & 3) + 8 * (r >> 2) + 4 * hi; }
struct TileRegs { u32x4 k, v; };
__device__ __forceinline__ void tile_gload(TileRegs& r, const bf16_t* Kg, const bf16_t* Vg, size_t ld, int tid) {
    r.k = *(const u32x4*)(Kg + (size_t)(tid >> 3) * ld + (tid & 7) * 8);
    r.v = *(const u32x4*)(Vg + (size_t)(tid & 63) * ld + (tid >> 6) * 8);
}
__device__ __forceinline__ void tile_lstore(const TileRegs& r, LAS unsigned char* Ks, LAS unsigned char* Vs, int tid) {
    *(LAS u32x4*)(Ks + (tid >> 3) * KROW + (tid & 7) * 16) = r.k;
    LAS unsigned char* vb = Vs + ((tid >> 6) * 8) * VROW + (tid & 63) * 2;
    *(LAS unsigned short*)(vb + 0 * VROW) = (unsigned short)(r.v.x & 0xffffu); *(LAS unsigned short*)(vb + 1 * VROW) = (unsigned short)(r.v.x >> 16);
    *(LAS unsigned short*)(vb + 2 * VROW) = (unsigned short)(r.v.y & 0xffffu); *(LAS unsigned short*)(vb + 3 * VROW) = (unsigned short)(r.v.y >> 16);
    *(LAS unsigned short*)(vb + 4 * VROW) = (unsigned short)(r.v.z & 0xffffu); *(LAS unsigned short*)(vb + 5 * VROW) = (unsigned short)(r.v.z >> 16);
    *(LAS unsigned short*)(vb + 6 * VROW) = (unsigned short)(r.v.w & 0xffffu); *(LAS unsigned short*)(vb + 7 * VROW) = (unsigned short)(r.v.w >> 16);
}
__device__ __forceinline__ void load_qfrag(bf16x8 (&qf)[4], const bf16_t* qrow, int hi) {
#pragma unroll
    for (int d0 = 0; d0 < 4; ++d0) { const u32x4 w = *(const u32x4*)(qrow + d0 * 16 + hi * 8);
        u32x4 o; o.x = pk2(bf2f(w.x & 0xffffu) * 0.125f, bf2f(w.x >> 16) * 0.125f); o.y = pk2(bf2f(w.y & 0xffffu) * 0.125f, bf2f(w.y >> 16) * 0.125f);
        o.z = pk2(bf2f(w.z & 0xffffu) * 0.125f, bf2f(w.z >> 16) * 0.125f); o.w = pk2(bf2f(w.w & 0xffffu) * 0.125f, bf2f(w.w >> 16) * 0.125f);
        qf[d0] = __builtin_bit_cast(bf16x8, o); }
}
__device__ __forceinline__ void tile_scores(f32x16& s0, f32x16& s1, const LAS unsigned char* Ks, const bf16x8 (&qf)[4], int r32, int hi) {
#pragma unroll
    for (int r = 0; r < 16; ++r) { s0[r] = 0.f; s1[r] = 0.f; }
#pragma unroll
    for (int d0 = 0; d0 < 4; ++d0) {
        const bf16x8 k0 = *(const LAS bf16x8*)(Ks + r32 * KROW + (d0 * 16 + hi * 8) * 2);
        const bf16x8 k1 = *(const LAS bf16x8*)(Ks + (32 + r32) * KROW + (d0 * 16 + hi * 8) * 2);
        s0 = __builtin_amdgcn_mfma_f32_32x32x16_bf16(k0, qf[d0], s0, 0, 0, 0);
        s1 = __builtin_amdgcn_mfma_f32_32x32x16_bf16(k1, qf[d0], s1, 0, 0, 0);
    }
}
__device__ __forceinline__ void tile_softmax_pv(f32x16& s0, f32x16& s1, const LAS unsigned char* Vs, f32x16 (&o)[2], float& m, float& l, int r32, int hi) {
    float mt = NEGBIG;
#pragma unroll
    for (int r = 0; r < 16; ++r) mt = fmaxf(mt, fmaxf(s0[r], s1[r]));
    mt = fmaxf(mt, __shfl_xor(mt, 32));
    const float mn = fmaxf(m, mt), alpha = __expf(m - mn); m = mn;
    float ps = 0.f;
#pragma unroll
    for (int r = 0; r < 16; ++r) { s0[r] = __expf(s0[r] - mn); s1[r] = __expf(s1[r] - mn); ps += s0[r] + s1[r]; }
    l = l * alpha + ps;
#pragma unroll
    for (int r = 0; r < 16; ++r) { o[0][r] *= alpha; o[1][r] *= alpha; }
    bf16x8 pb[4];
    { u32x4 w; w.x = pk2(s0[0], s0[1]); w.y = pk2(s0[2], s0[3]); w.z = pk2(s0[4], s0[5]); w.w = pk2(s0[6], s0[7]); pb[0] = __builtin_bit_cast(bf16x8, w); }
    { u32x4 w; w.x = pk2(s0[8], s0[9]); w.y = pk2(s0[10], s0[11]); w.z = pk2(s0[12], s0[13]); w.w = pk2(s0[14], s0[15]); pb[1] = __builtin_bit_cast(bf16x8, w); }
    { u32x4 w; w.x = pk2(s1[0], s1[1]); w.y = pk2(s1[2], s1[3]); w.z = pk2(s1[4], s1[5]); w.w = pk2(s1[6], s1[7]); pb[2] = __builtin_bit_cast(bf16x8, w); }
    { u32x4 w; w.x = pk2(s1[8], s1[9]); w.y = pk2(s1[10], s1[11]); w.z = pk2(s1[12], s1[13]); w.w = pk2(s1[14], s1[15]); pb[3] = __builtin_bit_cast(bf16x8, w); }
#pragma unroll
    for (int dh = 0; dh < 2; ++dh)
#pragma unroll
        for (int ks = 0; ks < 4; ++ks) {
            const LAS unsigned char* vp = Vs + (dh * 32 + r32) * VROW + (16 * ks + 4 * hi) * 2;
            const u32x2 lo = *(const LAS u32x2*)vp, hh = *(const LAS u32x2*)(vp + 16);
            const u32x4 a4 = (u32x4){lo.x, lo.y, hh.x, hh.y};
            o[dh] = __builtin_amdgcn_mfma_f32_32x32x16_bf16(__builtin_bit_cast(bf16x8, a4), pb[ks], o[dh], 0, 0, 0);
        }
}
__device__ __forceinline__ void store_o(const f32x16 (&o)[2], bf16_t* orow, int hi) {
#pragma unroll
    for (int dh = 0; dh < 2; ++dh)
#pragma unroll
        for (int r4 = 0; r4 < 4; ++r4) { u32x2 w; w.x = pk2(o[dh][4 * r4], o[dh][4 * r4 + 1]); w.y = pk2(o[dh][4 * r4 + 2], o[dh][4 * r4 + 3]);
            *(u32x2*)(orow + dh * 32 + 8 * r4 + 4 * hi) = w; }
}

__device__ __forceinline__ void swa_unit(int u, const bf16_t* Z, bf16_t* O, const float* sinks, LAS unsigned char* lds, int tid) {
    const int g = u & 1, sb = (u >> 1) & 63, b = u >> 7;
    const int lane = tid & 63, w = tid >> 6, r32 = lane & 31, hi = lane >> 5;
    const int h = g * 4 + (w >> 1), t0 = sb * 64, t = t0 + (w & 1) * 32 + r32;
    const size_t mrow = (size_t)b * T_ + t;
    LAS unsigned char* Ks = lds; LAS unsigned char* Vs = lds + KT_BYTES;
    bf16x8 qf[4]; load_qfrag(qf, Z + mrow * ZLD0 + h * 64, hi);
    const float slope = exp2f(-(float)(h + 1));
    float m = sinks[h], l = hi == 0 ? 1.f : 0.f;
    f32x16 o[2];
#pragma unroll
    for (int r = 0; r < 16; ++r) { o[0][r] = 0.f; o[1][r] = 0.f; }
    const int first = sb >= 2 ? 0 : 2 - sb;
    TileRegs tr;
    { const int kp0 = t0 - 128 + 64 * first; const bf16_t* base = Z + ((size_t)b * T_ + kp0) * ZLD0; tile_gload(tr, base + 512 + g * 64, base + 640 + g * 64, ZLD0, tid); }
    for (int ti = first; ti < 3; ++ti) {
        const int kp0 = t0 - 128 + 64 * ti;
        __syncthreads(); tile_lstore(tr, Ks, Vs, tid); __syncthreads();
        if (ti + 1 < 3) { const bf16_t* base = Z + ((size_t)b * T_ + kp0 + 64) * ZLD0; tile_gload(tr, base + 512 + g * 64, base + 640 + g * 64, ZLD0, tid); }
        f32x16 s0, s1; tile_scores(s0, s1, Ks, qf, r32, hi);
#pragma unroll
        for (int r = 0; r < 16; ++r) {
            const int d0 = t - (kp0 + crow(r, hi)), d1 = d0 - 32;
            s0[r] = (d0 >= 0 && d0 < 128) ? s0[r] - slope * (float)d0 : NEGBIG;
            s1[r] = (d1 >= 0 && d1 < 128) ? s1[r] - slope * (float)d1 : NEGBIG;
        }
        tile_softmax_pv(s0, s1, Vs, o, m, l, r32, hi);
    }
    l += __shfl_xor(l, 32);
    const float inv = 1.f / l;
#pragma unroll
    for (int r = 0; r < 16; ++r) { o[0][r] *= inv; o[1][r] *= inv; }
    store_o(o, O + mrow * DM + h * 64, hi);
}

constexpr int IMP_OFF = 19456, IMP_LD = 257, SELM_OFF = IMP_OFF + 64 * IMP_LD * 4  , UNI_OFF = SELM_OFF + 512;
__device__ __forceinline__ void nsa_unit(int u, const bf16_t* Z, const bf16_t* KC, const bf16_t* VC, bf16_t* O, LAS unsigned char* lds, int tid) {
    const int bg = u & 63, i = u >> 6, g = bg & 3, b = bg >> 2;
    const int lane = tid & 63, w = tid >> 6, r32 = lane & 31, hi = lane >> 5;
    const int hr = w >> 1, h = g * 4 + hr, t0 = i * 64, ql = (w & 1) * 32 + r32, t = t0 + ql;
    const size_t mrow = (size_t)b * T_ + t;
    LAS unsigned char* Ks = lds; LAS unsigned char* Vs = lds + KT_BYTES;
    LAS float* imp = (LAS float*)(lds + IMP_OFF);
    LAS unsigned* selm = (LAS unsigned*)(lds + SELM_OFF); LAS unsigned* uni = (LAS unsigned*)(lds + UNI_OFF);
    bf16x8 qf[4]; load_qfrag(qf, Z + mrow * ZLD1 + h * 64, hi);
    const float slope = exp2f(-0.5f * (float)(h + 1));
    const bf16_t* gatep = Z + mrow * ZLD1 + 2560 + h * 3;
    LAS float* park = (LAS float*)(lds + IMP_OFF) + tid;
    f32x16 o[2]; float m, l; TileRegs tr;
    const size_t cbase = ((size_t)(b * 4 + g) * 256) * 64;
    const int ncv = min(4 * i + 3, 255), nct = (ncv + 63) >> 6;
    m = NEGBIG; l = 0.f;
#pragma unroll
    for (int r = 0; r < 16; ++r) { o[0][r] = 0.f; o[1][r] = 0.f; }
    tile_gload(tr, KC + cbase, VC + cbase, 64, tid);
    for (int ti = 0; ti < nct; ++ti) {
        __syncthreads(); tile_lstore(tr, Ks, Vs, tid); __syncthreads();
        if (ti + 1 < nct) tile_gload(tr, KC + cbase + (size_t)(ti + 1) * 4096, VC + cbase + (size_t)(ti + 1) * 4096, 64, tid);
        f32x16 s0, s1; tile_scores(s0, s1, Ks, qf, r32, hi);
#pragma unroll
        for (int r = 0; r < 16; ++r) {
            const int d0 = t - (16 * (ti * 64 + crow(r, hi)) + 31), d1 = d0 - 512;
            s0[r] = d0 >= 0 ? s0[r] - slope * (float)d0 : NEGBIG;
            s1[r] = d1 >= 0 ? s1[r] - slope * (float)d1 : NEGBIG;
        }
        tile_softmax_pv(s0, s1, Vs, o, m, l, r32, hi);
    }
    l += __shfl_xor(l, 32);
    const bool rowok = t >= 31;
    const float invc = rowok ? 1.f / l : 0.f;
    { const float wg = sigmoidf_(bf2f(gatep[0])) * invc;
#pragma unroll
      for (int r = 0; r < 16; ++r) { o[0][r] *= wg; o[1][r] *= wg; } }
    if (i > 7) {
        const float mc = m;
        tile_gload(tr, KC + cbase, VC + cbase, 64, tid);
        for (int ti = 0; ti < nct; ++ti) {
            __syncthreads(); tile_lstore(tr, Ks, Vs, tid); __syncthreads();
            if (ti + 1 < nct) tile_gload(tr, KC + cbase + (size_t)(ti + 1) * 4096, VC + cbase + (size_t)(ti + 1) * 4096, 64, tid);
            f32x16 s0, s1; tile_scores(s0, s1, Ks, qf, r32, hi);
#pragma unroll
            for (int r = 0; r < 16; ++r) {
                const int d0 = t - (16 * (ti * 64 + crow(r, hi)) + 31), d1 = d0 - 512;
                s0[r] = d0 >= 0 ? __expf(s0[r] - slope * (float)d0 - mc) * invc : 0.f;
                s1[r] = d1 >= 0 ? __expf(s1[r] - slope * (float)d1 - mc) * invc : 0.f;
            }
            LAS float* ip = imp + ql * IMP_LD + ti * 64;
#pragma unroll
            for (int rr = 0; rr < 4; ++rr) {
                if (hr == rr) {
#pragma unroll
                    for (int r = 0; r < 16; ++r) { const int c = crow(r, hi);
                        if (rr == 0) { ip[c] = s0[r]; ip[32 + c] = s1[r]; } else { ip[c] += s0[r]; ip[32 + c] += s1[r]; } }
                }
                __syncthreads();
            }
        }
    }
    if (tid == 0) { uni[0] = 0u; uni[1] = 0u; }
    __syncthreads();
    if (tid < 64) {
        unsigned long long mask;
        if (i <= 7) mask = (2ull << i) - 1ull;
        else {
            float v0 = -1.f, v1 = -1.f, v2 = -1.f, v3 = -1.f, v4 = -1.f; int j0 = 0, j1 = 0, j2 = 0, j3 = 0, j4 = 0;
            const LAS float* ip = imp + tid * IMP_LD;
            for (int j = 1; j <= i - 2; ++j) {
                float v = ip[4 * j - 1] + 2.f * (ip[4 * j] + ip[4 * j + 1] + ip[4 * j + 2]) + ip[4 * j + 3]; int jj = j;
#define INS(vk, jk) if (v > vk) { const float tv = vk; const int tj = jk; vk = v; jk = jj; v = tv; jj = tj; }
                INS(v0, j0) INS(v1, j1) INS(v2, j2) INS(v3, j3) INS(v4, j4)
#undef INS
            }
            mask = 1ull | (1ull << i) | (1ull << (i - 1)) | (1ull << j0) | (1ull << j1) | (1ull << j2) | (1ull << j3) | (1ull << j4);
        }
        selm[2 * tid] = (unsigned)mask; selm[2 * tid + 1] = (unsigned)(mask >> 32);
        atomicOr((unsigned*)(uni), (unsigned)mask); atomicOr((unsigned*)(uni + 1), (unsigned)(mask >> 32));
    }
    __syncthreads();
#pragma unroll
    for (int r = 0; r < 16; ++r) { park[r * 512] = o[0][r]; park[(16 + r) * 512] = o[1][r]; }
    {
        unsigned long long um = (unsigned long long)uni[0] | ((unsigned long long)uni[1] << 32);
        const unsigned long long mym = (unsigned long long)selm[2 * ql] | ((unsigned long long)selm[2 * ql + 1] << 32);
        m = NEGBIG; l = 0.f;
#pragma unroll
        for (int r = 0; r < 16; ++r) { o[0][r] = 0.f; o[1][r] = 0.f; }
        int j = __builtin_ctzll(um); um &= um - 1;
        { const bf16_t* base = Z + ((size_t)b * T_ + 64 * j) * ZLD1; tile_gload(tr, base + 1536 + g * 64, base + 1792 + g * 64, ZLD1, tid); }
        for (;;) {
            __syncthreads(); tile_lstore(tr, Ks, Vs, tid); __syncthreads();
            const int jn = um ? __builtin_ctzll(um) : -1; um &= um - 1;
            if (jn >= 0) { const bf16_t* base = Z + ((size_t)b * T_ + 64 * jn) * ZLD1; tile_gload(tr, base + 1536 + g * 64, base + 1792 + g * 64, ZLD1, tid); }
            f32x16 s0, s1; tile_scores(s0, s1, Ks, qf, r32, hi);
            const bool sel = (mym >> j) & 1ull;
#pragma unroll
            for (int r = 0; r < 16; ++r) {
                const int d0 = t - (64 * j + crow(r, hi)), d1 = d0 - 32;
                s0[r] = (sel && d0 >= 0) ? s0[r] - slope * (float)d0 : NEGBIG;
                s1[r] = (sel && d1 >= 0) ? s1[r] - slope * (float)d1 : NEGBIG;
            }
            tile_softmax_pv(s0, s1, Vs, o, m, l, r32, hi);
            if (jn < 0) break;
            j = jn;
        }
        l += __shfl_xor(l, 32);
        const float wg = sigmoidf_(bf2f(gatep[1])) / l;
#pragma unroll
        for (int r = 0; r < 16; ++r) { park[r * 512] += wg * o[0][r]; park[(16 + r) * 512] += wg * o[1][r]; }
    }
    {
        m = NEGBIG; l = 0.f;
#pragma unroll
        for (int r = 0; r < 16; ++r) { o[0][r] = 0.f; o[1][r] = 0.f; }
        const int first = i >= 4 ? 0 : 4 - i;
        { const int kp0 = t0 - 256 + 64 * first; const bf16_t* base = Z + ((size_t)b * T_ + kp0) * ZLD1; tile_gload(tr, base + 2048 + g * 64, base + 2304 + g * 64, ZLD1, tid); }
        for (int ti = first; ti < 5; ++ti) {
            const int kp0 = t0 - 256 + 64 * ti;
            __syncthreads(); tile_lstore(tr, Ks, Vs, tid); __syncthreads();
            if (ti + 1 < 5) { const bf16_t* base = Z + ((size_t)b * T_ + kp0 + 64) * ZLD1; tile_gload(tr, base + 2048 + g * 64, base + 2304 + g * 64, ZLD1, tid); }
            f32x16 s0, s1; tile_scores(s0, s1, Ks, qf, r32, hi);
#pragma unroll
            for (int r = 0; r < 16; ++r) {
                const int d0 = t - (kp0 + crow(r, hi)), d1 = d0 - 32;
                s0[r] = (d0 >= 0 && d0 < 256) ? s0[r] - slope * (float)d0 : NEGBIG;
                s1[r] = (d1 >= 0 && d1 < 256) ? s1[r] - slope * (float)d1 : NEGBIG;
            }
            tile_softmax_pv(s0, s1, Vs, o, m, l, r32, hi);
        }
        l += __shfl_xor(l, 32);
        const float wg = sigmoidf_(bf2f(gatep[2])) / l;
#pragma unroll
        for (int r = 0; r < 16; ++r) { o[0][r] = park[r * 512] + wg * o[0][r]; o[1][r] = park[(16 + r) * 512] + wg * o[1][r]; }
    }
    store_o(o, O + mrow * DM + h * 64, hi);
    __syncthreads();
}

__device__ __forceinline__ float dpp_xadd(float x, int which) {
    int r;
    const int xi = __float_as_int(x);
    if (which == 0) r = __builtin_amdgcn_update_dpp(0, xi, 0xB1, 0xf, 0xf, false);
    else if (which == 1) r = __builtin_amdgcn_update_dpp(0, xi, 0x4E, 0xf, 0xf, false);
    else if (which == 2) r = __builtin_amdgcn_update_dpp(0, xi, 0x141, 0xf, 0xf, false);
    else r = __builtin_amdgcn_update_dpp(0, xi, 0x140, 0xf, 0xf, false);
    return x + __int_as_float(r);
}
__device__ __forceinline__ float row16_sum(float x) { x = dpp_xadd(x, 0); x = dpp_xadd(x, 1); x = dpp_xadd(x, 2); x = dpp_xadd(x, 3); return x; }

#define UNPK4(w) (f32x4){bf2f((w).x & 0xffffu), bf2f((w).x >> 16), bf2f((w).y & 0xffffu), bf2f((w).y >> 16)}
#define PK4(v) (u32x2){pk2((v).x, (v).y), pk2((v).z, (v).w)}
__device__ __forceinline__ f32x4 sig4(f32x4 v) { return (f32x4){sigmoidf_(v.x), sigmoidf_(v.y), sigmoidf_(v.z), sigmoidf_(v.w)}; }
__device__ __forceinline__ void rwkv_prep(const Args& a, const bf16_t* Z, const bf16_t* L, bf16_t* KK, bf16_t* WR, bf16_t* WE, bf16_t* KKA, bf16_t* KT, bf16_t* VS, float* C, int gw, int NGW, int lane) {
    const int h = gw & 7, col = h * 64 + (lane & 15) * 4, q = lane >> 4;
    const f32x4 mu_r = *(const f32x4*)(a.in[8] + col), mu_k = *(const f32x4*)(a.in[8] + 512 + col), mu_v = *(const f32x4*)(a.in[8] + 1024 + col);
    const f32x4 w0 = *(const f32x4*)(a.in[9] + col), a0 = *(const f32x4*)(a.in[11] + col), k_k = *(const f32x4*)(a.in[14] + col), k_a = *(const f32x4*)(a.in[15] + col), r_k = *(const f32x4*)(a.in[16] + col);
    for (int m4 = gw >> 3; m4 < M_ / 4; m4 += NGW >> 3) {
        const int m = m4 * 4 + q;
        const bf16_t* zr = Z + (size_t)m * ZLD0 + 768 + col;
        f32x4 r = UNPK4(*(const u32x2*)zr), k = UNPK4(*(const u32x2*)(zr + 512)), v = UNPK4(*(const u32x2*)(zr + 1024));
        f32x4 rp = (f32x4){0.f, 0.f, 0.f, 0.f}, kp = rp, vp = rp;
        if ((m & (T_ - 1)) != 0) { rp = UNPK4(*(const u32x2*)(zr - ZLD0)); kp = UNPK4(*(const u32x2*)(zr + 512 - ZLD0)); vp = UNPK4(*(const u32x2*)(zr + 1024 - ZLD0)); }
        r += (rp - r) * mu_r; k += (kp - k) * mu_k; v += (vp - v) * mu_v;
        const f32x4 lw = UNPK4(*(const u32x2*)(L + (size_t)m * LLD + col)), la = UNPK4(*(const u32x2*)(L + (size_t)m * LLD + 512 + col));
        const f32x4 e = sig4(w0 + lw) * 0.60653065971f;
        const u32x2 eb = PK4(e);
        const f32x4 er = UNPK4(eb);
        const f32x4 wdec = (f32x4){__expf(-er.x), __expf(-er.y), __expf(-er.z), __expf(-er.w)};
        const f32x4 av = sig4(a0 + la);
        f32x4 kk = k * k_k;
        const float nrm = sqrtf(row16_sum((kk.x * kk.x + kk.y * kk.y) + (kk.z * kk.z + kk.w * kk.w)));
        kk = kk * (1.f / fmaxf(nrm, 1e-12f));
        const f32x4 kt = k * (1.f + (av - 1.f) * k_a);
        const f32x4 kka = kk * av;
        const f32x4 t1 = kka * r, t2 = kt * r, t3 = t2 * r_k;
        const float c1 = row16_sum((t1.x + t1.y) + (t1.z + t1.w)), c2 = row16_sum((t2.x + t2.y) + (t2.z + t2.w)), c3 = row16_sum((t3.x + t3.y) + (t3.z + t3.w));
        const size_t o = (size_t)m * 512 + col;
        const f32x4 wr = wdec * r;
        *(u32x2*)(KK + o) = PK4(kk); *(u32x2*)(WR + o) = PK4(wr); *(u32x2*)(WE + o) = eb;
        *(u32x2*)(KKA + o) = PK4(kka); *(u32x2*)(KT + o) = PK4(kt); *(u32x2*)(VS + o) = PK4(v);
        if ((lane & 15) == 0) *(f32x4*)(C + (size_t)m * 32 + h * 4) = (f32x4){c1, c2, c3, 0.f};
    }
}

constexpr int SC_TS = 32, SC_BUF = 5 * SC_TS * 64 + SC_TS * 32 + SC_TS * 2;
__device__ __forceinline__ void scan_unit(int u, const bf16_t* KK, const bf16_t* WR, const bf16_t* WE, const bf16_t* KKA, const bf16_t* KT, const bf16_t* VS, const float* C, float* Y, LAS unsigned char* lds, int tid) {
    const int half = u & 1, h = (u >> 1) & 7, b = u >> 4;
    const int il = tid >> 4, jg = tid & 15;
    LAS float* buf0 = (LAS float*)lds; LAS float* buf1 = buf0 + SC_BUF; LAS float* ybuf = buf1 + SC_BUF;
    float S0 = 0.f, S1 = 0.f, S2 = 0.f, S3 = 0.f;
    const size_t rowbase = (size_t)b * T_;
    const size_t goff = (rowbase + il) * 512 + h * 64 + jg * 4;
    const size_t voff = (rowbase + il) * 512 + h * 64 + half * 32 + jg * 2;
    u32x2 rkk, rwr, rwe, rkka, rkt; unsigned rv; f32x2 rc;
#define SC_GLOAD(t0) do { const size_t d_ = (size_t)(t0) * 512; rkk = *(const u32x2*)(KK + goff + d_); rwr = *(const u32x2*)(WR + goff + d_); rwe = *(const u32x2*)(WE + goff + d_); \
        rkka = *(const u32x2*)(KKA + goff + d_); rkt = *(const u32x2*)(KT + goff + d_); rv = *(const unsigned*)(VS + voff + d_); \
        if (tid < SC_TS) rc = *(const f32x2*)(C + (rowbase + (t0) + tid) * 32 + h * 4); } while (0)
#define SC_EXP4(w) (f32x4){bf2f((w).x & 0xffffu), bf2f((w).x >> 16), bf2f((w).y & 0xffffu), bf2f((w).y >> 16)}
#define SC_LSTORE(bf) do { LAS float* p_ = (bf) + il * 64 + jg * 4; *(LAS f32x4*)(p_) = SC_EXP4(rkk); *(LAS f32x4*)(p_ + 2048) = SC_EXP4(rwr); \
        { f32x4 e_ = SC_EXP4(rwe); *(LAS f32x4*)(p_ + 4096) = (f32x4){__expf(-e_.x), __expf(-e_.y), __expf(-e_.z), __expf(-e_.w)}; } \
        *(LAS f32x4*)(p_ + 6144) = SC_EXP4(rkka); *(LAS f32x4*)(p_ + 8192) = SC_EXP4(rkt); \
        *(LAS f32x2*)((bf) + 10240 + il * 32 + jg * 2) = (f32x2){bf2f(rv & 0xffffu), bf2f(rv >> 16)}; \
        if (tid < SC_TS) *(LAS f32x2*)((bf) + 11264 + tid * 2) = rc; } while (0)
    __syncthreads();
    SC_GLOAD(0); SC_LSTORE(buf0);
    __syncthreads();
    for (int n = 0; n < T_ / SC_TS; ++n) {
        LAS float* cb = (n & 1) ? buf1 : buf0; LAS float* nb = (n & 1) ? buf0 : buf1;
        if (n + 1 < T_ / SC_TS) SC_GLOAD((n + 1) * SC_TS);
#pragma unroll 8
        for (int s = 0; s < SC_TS; ++s) {
            const LAS float* B = cb + s * 64 + jg * 4;
            const f32x4 kk = *(const LAS f32x4*)B, wr = *(const LAS f32x4*)(B + 2048), w = *(const LAS f32x4*)(B + 4096), kka = *(const LAS f32x4*)(B + 6144), kt = *(const LAS f32x4*)(B + 8192);
            const float v = cb[10240 + s * 32 + il]; const f32x2 c = *(const LAS f32x2*)(cb + 11264 + s * 2);
            float sa = (S0 * kk.x + S1 * kk.y) + (S2 * kk.z + S3 * kk.w);
            float uu = (S0 * wr.x + S1 * wr.y) + (S2 * wr.z + S3 * wr.w);
            sa = row16_sum(sa); uu = row16_sum(uu);
            const float y = uu - sa * c.x + v * c.y;
            if (jg == 0) ybuf[s * 32 + il] = y;
            S0 = S0 * w.x + (v * kt.x - sa * kka.x); S1 = S1 * w.y + (v * kt.y - sa * kka.y);
            S2 = S2 * w.z + (v * kt.z - sa * kka.z); S3 = S3 * w.w + (v * kt.w - sa * kka.w);
        }
        __syncthreads();
        if (n + 1 < T_ / SC_TS) SC_LSTORE(nb);
        { const f32x2 yv = *(const LAS f32x2*)(ybuf + il * 32 + jg * 2);
          *(f32x2*)(Y + (rowbase + (size_t)n * SC_TS + il) * 512 + h * 64 + half * 32 + jg * 2) = yv; }
        __syncthreads();
    }
#undef SC_GLOAD
#undef SC_EXP4
#undef SC_LSTORE
}

__device__ __forceinline__ void rwkv_post(const Args& a, const float* Y, const bf16_t* VS, const bf16_t* L, const float* C, bf16_t* O, int gw, int NGW, int lane) {
    const int h = gw & 7, col = h * 64 + (lane & 15) * 4, q = lane >> 4;
    const f32x4 lg = *(const f32x4*)(a.in[17] + col), lb = *(const f32x4*)(a.in[18] + col);
    for (int m4 = gw >> 3; m4 < M_ / 4; m4 += NGW >> 3) {
        const int m = m4 * 4 + q;
        const f32x4 y = *(const f32x4*)(Y + (size_t)m * 512 + col);
        const float mean = row16_sum((y.x + y.y) + (y.z + y.w)) * (1.f / 64.f); const f32x4 d = y - mean;
        const float var = row16_sum((d.x * d.x + d.y * d.y) + (d.z * d.z + d.w * d.w)) * (1.f / 64.f);
        const f32x4 yn = d * rsqrtf(var + GN_EPS) * lg + lb;
        const f32x4 v = UNPK4(*(const u32x2*)(VS + (size_t)m * 512 + col)), g = UNPK4(*(const u32x2*)(L + (size_t)m * LLD + 1024 + col));
        const float c3 = C[(size_t)m * 32 + h * 4 + 2];
        const f32x4 ov = (yn + v * c3) * g;
        *(u32x2*)(O + (size_t)m * DM + 512 + col) = PK4(ov);
    }
}

__device__ __forceinline__ void run_gemm0(LAS unsigned char* lds, const bf16_t* A, const bf16_t* Bt, int M, int N, int K, int lda, bf16_t* Oo, int ldc) {
    pg8::Gemm g{A, Bt, M, N, K, lda, (size_t)128, 0}; pg8::StaticOrder S; S.init(M, N, (int)gridDim.x, (int)blockIdx.x);
    pg8::EpiStore<0> E{Oo, ldc, nullptr};

#ifndef NO_GEMM
    pg8::gemm_phase<pg8::EpiStore<0>, pg8::StaticOrder, true, true>(lds, g, S, E);
#endif
}


#define Wt_hyin ((bf16_t*)(ws + WS_HYIN))
#define Wt_hyout ((bf16_t*)(ws + WS_HYOUT))
#define Wt_nsain ((bf16_t*)(ws + WS_NSAIN))
#define Wt_nsaout ((bf16_t*)(ws + WS_NSAOUT))
#define Wt_lora ((bf16_t*)(ws + WS_LORA))
#define Wt_cw1k ((bf16_t*)(ws + WS_CW1K))
#define Wt_cw1v ((bf16_t*)(ws + WS_CW1V))
#define cbias ((float*)(ws + WS_CBIAS))
#define W2T ((bf16_t*)(ws + WS_CBIAS + 4096))
#define H ((bf16_t*)(ws + WS_H))
#define Z ((bf16_t*)(ws + WS_Z))
#define AP ((bf16_t*)(ws + WS_AP))
#define O ((bf16_t*)(ws + WS_O))
#define L ((bf16_t*)(ws + WS_L))
#define C ((float*)(ws + WS_C))
#define MM ((bf16_t*)(ws + WS_MM))
#define Y ((float*)(ws + WS_MM))
#define HID ((bf16_t*)(ws + WS_HID))
#define KC ((bf16_t*)(ws + WS_KCMP))
#define VC ((bf16_t*)(ws + WS_VCMP))
#define U ((bf16_t*)(ws + WS_U))
#define KK ((bf16_t*)(ws + WS_H))
#define WR (KK + (size_t)M_ * 512)
#define WE ((bf16_t*)args.out)
#define KKA (WE + (size_t)M_ * 512)
#define KT (WE + (size_t)M_ * 1024)
#define VS (WE + (size_t)M_ * 1536)
#define XIN (args.in[0])
#define X (args.out)
#define PH_BEGIN unsigned char* ws = args.ws; asm volatile("" : "+s"(ws)); int tid_ = threadIdx.x; asm volatile("" : "+v"(tid_)); const int tid = tid_, lane = tid & 63, wave = __builtin_amdgcn_readfirstlane(tid >> 6); const int G = gridDim.x, gw = blockIdx.x * 8 + wave, NGW = G * 8; const int gtid = blockIdx.x * 512 + tid, NT = G * 512; (void)lane; (void)gw; (void)NGW; (void)gtid; (void)NT; (void)ws;
__global__ void __launch_bounds__(512, 2) mega_fwd(Args args) {
    extern __shared__ __attribute__((aligned(16))) unsigned char lds_raw[];
    LAS unsigned char* lds = (LAS unsigned char*)lds_raw;
    cg::grid_group grid = cg::this_grid();
    const int lo = args.ph_lo, hi = args.ph_hi;
#define IN(k) (lo <= (k) && (k) < hi)
#ifndef DUP_MASK
#define DUP_MASK 0u
#endif
#define REP(k) for (int rep_ = 0; rep_ < (((DUP_MASK >> (k)) & 1u) ? 2 : 1); ++rep_)
#define SEAM(k) do { if (IN(k) && IN((k) + 1)) grid.sync(); } while (0)

    if (IN(0)) REP(0) { PH_BEGIN
        LAS float* scr = (LAS float*)(lds + wave * 16384);
        constexpr int I0 = 16 * 80, I1 = 16 * 32, I2 = 16 * 88, I3 = 16 * 32, I4 = 16 * 176, I5 = 44 * 32, I6 = 32 * 8;
        constexpr int NIT = I0 + I1 + I2 + I3 + 2 * I4 + 2 * I5 + 2 * I6;
        for (int it = gw; it < NIT; it += NGW) {
            int r = it;
            if (r < I0) { transpose_item(args.in[5], 2560, Wt_hyin, 1024, scr, r, 80, lane); continue; } r -= I0;
            if (r < I1) { transpose_item(args.in[6], 1024, Wt_hyout, 1024, scr, r, 32, lane); continue; } r -= I1;
            if (r < I2) { transpose_item(args.in[19], 2608, Wt_nsain, 1024, scr, r, 88, lane); continue; } r -= I2;
            if (r < I3) { transpose_item(args.in[20], 1024, Wt_nsaout, 1024, scr, r, 32, lane); continue; } r -= I3;
            if (r < 2 * I4) { const int l = r / I4; transpose_item(args.in[27] + (size_t)l * 1024 * 5632, 5632, (bf16_t*)(ws + (l ? WS_UP1 : WS_UP0)), 1024, scr, r % I4, 176, lane); continue; } r -= 2 * I4;
            if (r < 2 * I5) { const int l = r / I5; transpose_item(args.in[30] + (size_t)l * 2816 * 1024, 1024, (bf16_t*)(ws + (l ? WS_DN1 : WS_DN0)), 2816, scr, r % I5, 32, lane); continue; } r -= 2 * I5;
            if (r < I6) { transpose_item(args.in[22], 256, Wt_cw1k, 2048, scr, r, 8, lane); continue; } r -= I6;
            transpose_item(args.in[25], 256, Wt_cw1v, 2048, scr, r, 8, lane);
        }
        for (int e = gtid; e < 1536 * 256; e += NT) {
            const int n = e >> 8, k = e & 255; float v = 0.f;
            if (n < 512) { if (k < 64) v = args.in[10][k * 512 + n]; }
            else if (n < 1024) { if (k >= 64 && k < 128) v = args.in[12][(k - 64) * 512 + (n - 512)]; }
            else { if (k >= 128) v = args.in[13][(k - 128) * 512 + (n - 1024)]; }
            Wt_lora[e] = (bf16_t)(pk2(v, 0.f) & 0xffffu);
        }
        for (int e = gtid; e < 2 * 16384; e += NT) { const int which = e >> 14, d = (e >> 8) & 63, f = e & 255; W2T[e] = (bf16_t)(pk2(args.in[which ? 26 : 23][f * 64 + d], 0.f) & 0xffffu); }
        for (int it = gw; it < 512; it += NGW) {
            const int which = it >> 8, f = it & 255; const float* pos = args.in[which ? 24 : 21]; const float* w1 = args.in[which ? 25 : 22];
            float s = 0.f;
            for (int e = lane; e < 2048; e += 64) s += pos[e] * w1[(size_t)e * 256 + f];
            s = wave_sum(s);
            if (lane == 0) cbias[it] = s;
        }
        norm_phase(XIN, nullptr, nullptr, nullptr, args.in[1], H, gw, NGW, lane);
    }
    SEAM(0);
    if (IN(1)) REP(1) { PH_BEGIN run_gemm0(lds, H, Wt_hyin, M_, ZLD0, 1024, 1024, Z, ZLD0); }
    SEAM(1);
    if (IN(2)) REP(2) { PH_BEGIN
        const float* mu = args.in[8];
        for (int it = gtid; it < M_ * 32; it += NT) {
            const int m = it >> 5, col = (it & 31) * 8;
            const bf16_t* zp = Z + (size_t)m * ZLD0 + 2304 + col;
            const u32x4 zc = *(const u32x4*)zp; u32x4 zq = (u32x4){0u, 0u, 0u, 0u};
            if ((m & (T_ - 1)) != 0) zq = *(const u32x4*)(zp - ZLD0);
            const unsigned cw[4] = {zc.x, zc.y, zc.z, zc.w}, pw[4] = {zq.x, zq.y, zq.z, zq.w}; unsigned ow[4];
#pragma unroll
            for (int e = 0; e < 4; ++e) {
                float a0 = bf2f(cw[e] & 0xffffu), a1 = bf2f(cw[e] >> 16); const float p0 = bf2f(pw[e] & 0xffffu), p1 = bf2f(pw[e] >> 16);
                a0 += (p0 - a0) * mu[1536 + col + 2 * e]; a1 += (p1 - a1) * mu[1536 + col + 2 * e + 1];
                if (col < 64) { a0 = tanhf(a0); a1 = tanhf(a1); } else if (col >= 128) { a0 = sigmoidf_(a0); a1 = sigmoidf_(a1); }
                ow[e] = pk2(a0, a1);
            }
            *(u32x4*)(AP + (size_t)m * 256 + col) = (u32x4){ow[0], ow[1], ow[2], ow[3]};
        }

#ifndef NO_SWA
for (int u = blockIdx.x; u < NB_ * 64 * 2; u += G) swa_unit(u, Z, O, args.in[7], lds, tid);
#endif

        __syncthreads();
    }
    SEAM(2);
    if (IN(3)) REP(3) { PH_BEGIN run_gemm0(lds, AP, Wt_lora, M_, LLD, 256, 256, L, LLD); }
    SEAM(3);
    if (IN(4)) REP(4) { PH_BEGIN rwkv_prep(args, Z, L, KK, WR, WE, KKA, KT, VS, C, gw, NGW, lane); }
    SEAM(4);
    if (IN(5)) REP(5) { PH_BEGIN
#ifndef NO_SCAN
for (int u = blockIdx.x; u < 256; u += G) scan_unit(u, KK, WR, WE, KKA, KT, VS, C, Y, lds, tid);
#endif
 }
    SEAM(5);
    if (IN(6)) REP(6) { PH_BEGIN rwkv_post(args, Y, VS, L, C, O, gw, NGW, lane); }
    SEAM(6);
    if (IN(7)) REP(7) { PH_BEGIN run_gemm0(lds, O, Wt_hyout, M_, 1024, 1024, 1024, MM, 1024); }
    SEAM(7);
    if (IN(8)) REP(8) { PH_BEGIN norm_phase(XIN, MM, args.in[2], X, args.in[3], H, gw, NGW, lane); }
    SEAM(8);
#pragma unroll
    for (int l = 0; l < 2; ++l) {
        const int pb = l ? 19 : 9;
        if (IN(pb)) REP(pb) { PH_BEGIN run_gemm0(lds, H, (const bf16_t*)(ws + (l ? WS_UP1 : WS_UP0)), M_, ULD, 1024, 1024, U, ULD); }
        SEAM(pb);
        if (IN(pb + 1)) REP(pb + 1) { PH_BEGIN
            const float* cw = args.in[28] + (size_t)l * 3 * FF_; const float* cbv = args.in[29] + (size_t)l * FF_;
            for (int it = gtid; it < (M_ / 16) * (FF_ / 8); it += NT) {
                const int run = it / (FF_ / 8), f = (it - run * (FF_ / 8)) * 8, m0 = run * 16;
                f32x4 w0a = *(const f32x4*)(cw + f), w0b = *(const f32x4*)(cw + f + 4), w1a = *(const f32x4*)(cw + FF_ + f), w1b = *(const f32x4*)(cw + FF_ + f + 4);
                f32x4 w2a = *(const f32x4*)(cw + 2 * FF_ + f), w2b = *(const f32x4*)(cw + 2 * FF_ + f + 4), cba = *(const f32x4*)(cbv + f), cbb = *(const f32x4*)(cbv + f + 4);
                bf16_t* up = U + (size_t)m0 * ULD + f;
                u32x4 g1 = (u32x4){0u, 0u, 0u, 0u}, g2 = g1;
                if ((m0 & (T_ - 1)) != 0) { g1 = *(const u32x4*)(up - ULD); g2 = *(const u32x4*)(up - 2 * ULD); }
                f32x4 p1a = UNPK4(((u32x2){g1.x, g1.y})), p1b = UNPK4(((u32x2){g1.z, g1.w})), p2a = UNPK4(((u32x2){g2.x, g2.y})), p2b = UNPK4(((u32x2){g2.z, g2.w}));
#pragma unroll 4
                for (int rr = 0; rr < 16; ++rr) {
                    const u32x4 g0 = *(const u32x4*)(up + (size_t)rr * ULD), vv = *(const u32x4*)(up + (size_t)rr * ULD + FF_);
                    const f32x4 ca = UNPK4(((u32x2){g0.x, g0.y})), cb4 = UNPK4(((u32x2){g0.z, g0.w}));
                    const f32x4 va = UNPK4(((u32x2){vv.x, vv.y})), vb = UNPK4(((u32x2){vv.z, vv.w}));
                    const f32x4 xa = cba + ca * w2a + p1a * w1a + p2a * w0a, xb = cbb + cb4 * w2b + p1b * w1b + p2b * w0b;
                    const f32x4 oa = (f32x4){pg8::gelu_tanh(xa.x), pg8::gelu_tanh(xa.y), pg8::gelu_tanh(xa.z), pg8::gelu_tanh(xa.w)} * va;
                    const f32x4 ob = (f32x4){pg8::gelu_tanh(xb.x), pg8::gelu_tanh(xb.y), pg8::gelu_tanh(xb.z), pg8::gelu_tanh(xb.w)} * vb;
                    const u32x2 oa2 = PK4(oa), ob2 = PK4(ob);
                    *(u32x4*)(up + (size_t)rr * ULD + FF_) = (u32x4){oa2.x, oa2.y, ob2.x, ob2.y};
                    p2a = p1a; p2b = p1b; p1a = ca; p1b = cb4;
                }
            }
        }
        SEAM(pb + 1);
        if (IN(pb + 2)) REP(pb + 2) { PH_BEGIN run_gemm0(lds, U + FF_, (const bf16_t*)(ws + (l ? WS_DN1 : WS_DN0)), M_, 1024, FF_, ULD, MM, 1024); }
        SEAM(pb + 2);
        if (IN(pb + 3)) REP(pb + 3) { PH_BEGIN
            if (l == 0) norm_phase(X, MM, args.in[4], X, args.in[1] + 1024, H, gw, NGW, lane);
            else norm_phase(X, MM, args.in[4] + 1024, X, nullptr, nullptr, gw, NGW, lane);
        }
        if (l == 0) {
            SEAM(12);
            if (IN(13)) REP(13) { PH_BEGIN run_gemm0(lds, H, Wt_nsain, M_, ZLD1, 1024, 1024, Z, ZLD1); }
            SEAM(13);
            if (IN(14)) REP(14) { PH_BEGIN
                const int G2 = G >> 1, which = (int)blockIdx.x >= G2 ? 1 : 0;
                pg8::Gemm g{Z + 1024 + which * 256, which ? Wt_cw1v : Wt_cw1k, 16384, 256, 2048, 16 * ZLD1, (size_t)ZLD1 * 2, 1};
                pg8::StaticOrder S; S.init(16384, 256, G2, (int)blockIdx.x - which * G2);
                pg8::EpiStore<2> E{HID + (size_t)which * 16384 * 256, 256, cbias + which * 256};

#ifndef NO_GEMM2
if ((int)blockIdx.x < 2 * G2) pg8::gemm_phase<pg8::EpiStore<2>, pg8::StaticOrder, true, true>(lds, g, S, E);
#endif

            }
            SEAM(14);
            if (IN(15)) REP(15) { PH_BEGIN
                for (int wt = gw; wt < 2 * 512; wt += NGW) {
                    const int which = wt >> 9, row0 = (wt & 511) * 32, r32 = lane & 31, hi5 = lane >> 5;
                    const bf16_t* hp = HID + ((size_t)which * 16384 + row0 + r32) * 256 + hi5 * 8;
                    const bf16_t* wp = W2T + (size_t)which * 16384 + (size_t)r32 * 256 + hi5 * 8;
                    f32x16 c0, c1;
#pragma unroll
                    for (int r = 0; r < 16; ++r) { c0[r] = 0.f; c1[r] = 0.f; }
#pragma unroll 4
                    for (int ks = 0; ks < 16; ++ks) {
                        const bf16x8 av = *(const bf16x8*)(hp + ks * 16), b0 = *(const bf16x8*)(wp + ks * 16), b1 = *(const bf16x8*)(wp + 32 * 256 + ks * 16);
                        c0 = __builtin_amdgcn_mfma_f32_32x32x16_bf16(av, b0, c0, 0, 0, 0);
                        c1 = __builtin_amdgcn_mfma_f32_32x32x16_bf16(av, b1, c1, 0, 0, 0);
                    }
                    bf16_t* op = (which ? VC : KC) + (size_t)row0 * 64 + r32;
#pragma unroll
                    for (int r = 0; r < 16; ++r) { const int rw = crow(r, hi5); op[(size_t)rw * 64] = (bf16_t)(pk2(c0[r], 0.f) & 0xffffu); op[(size_t)rw * 64 + 32] = (bf16_t)(pk2(c1[r], 0.f) & 0xffffu); }
                }
            }
            SEAM(15);
            if (IN(16)) REP(16) { PH_BEGIN
#ifndef NO_NSA
for (int u = blockIdx.x; u < 64 * 64; u += G) nsa_unit(u, Z, KC, VC, O, lds, tid);
#endif
 }
            SEAM(16);
            if (IN(17)) REP(17) { PH_BEGIN run_gemm0(lds, O, Wt_nsaout, M_, 1024, 1024, 1024, MM, 1024); }
            SEAM(17);
            if (IN(18)) REP(18) { PH_BEGIN norm_phase(X, MM, args.in[2] + 1024, X, args.in[3] + 1024, H, gw, NGW, lane); }
            SEAM(18);
        }
    }
#undef IN
#undef SEAM
}

#undef XIN
#undef X
#undef H
#undef Z
#undef O
#undef L
#undef C
#undef U
#undef Y
extern "C" void kernel_launch(void* const* d_in, const int* in_sizes, int n_in, void* d_out, int out_size, void* d_ws, size_t ws_size, hipStream_t stream) {
    static int grid = 0;
    if (grid == 0) {
        if (n_in != 31 || out_size != M_ * DM || ws_size < WS_END) { fprintf(stderr, "kernel_launch: unexpected shapes (n_in %d out %d ws %zu)\n", n_in, out_size, ws_size); grid = -1; return; }
        int dev = 0, cus = 0, per_cu = 0;
        hipGetDevice(&dev); hipDeviceGetAttribute(&cus, hipDeviceAttributeMultiprocessorCount, dev);
        hipFuncSetAttribute((const void*)mega_fwd, hipFuncAttributeMaxDynamicSharedMemorySize, LDS_BYTES);
        hipOccupancyMaxActiveBlocksPerMultiprocessor(&per_cu, (const void*)mega_fwd, 512, LDS_BYTES);
        if (per_cu < 1) { fprintf(stderr, "kernel_launch: occupancy query says %d blocks/CU\n", per_cu); per_cu = 1; }
        (void)hipGetLastError();
        grid = cus * 1;
    }
    if (grid < 0) return;
    Args a{};
    for (int i = 0; i < 31; ++i) a.in[i] = (const float*)d_in[i];
    a.out = (float*)d_out; a.ws = (unsigned char*)d_ws;
#if ONE_LAUNCH
    a.ph_lo = 0; a.ph_hi = NPHASE;
    void* kargs[] = {&a};
    hipError_t e = hipLaunchCooperativeKernel((const void*)mega_fwd, dim3(grid), dim3(512), kargs, LDS_BYTES, stream);
    if (e != hipSuccess) fprintf(stderr, "cooperative launch failed: %s (grid %d)\n", hipGetErrorString(e), grid);
#else
    for (int p = 0; p < NPHASE; ++p) { a.ph_lo = p; a.ph_hi = p + 1; hipLaunchKernelGGL(mega_fwd, dim3(grid), dim3(512), LDS_BYTES, stream, a); }
#endif
}
```

```cpp
#include <hip/hip_runtime.h>
#include <hip/hip_cooperative_groups.h>
#include <cstdio>
#include <cstdint>
namespace cg = cooperative_groups;

#ifndef ONE_LAUNCH
#define ONE_LAUNCH 1
#endif

namespace pg8 {
#define PG8_LAS __attribute__((address_space(3)))
typedef unsigned short bf16_t;
typedef short bf16x8 __attribute__((ext_vector_type(8)));
typedef float f32x4 __attribute__((ext_vector_type(4)));
typedef unsigned u32x4 __attribute__((ext_vector_type(4)));
constexpr int BM = 256, BK = 64, HALF = 128, HTB = HALF * BK * 2  , STAGE_BYTES = 8 * HTB, NXCD = 8, WGM = 8;

__host__ __device__ __forceinline__ int lds_byte(int r, int c) { const int st = (r >> 4) * 2 + (c >> 5), rr = r & 15, cc = c & 31, ob = rr * 64 + cc * 2; return st * 1024 + (ob ^ (((ob >> 9) & 1) << 5)); }
__host__ __device__ __forceinline__ void stage_rc(int b, int& R, int& C) { const int st = b / 1024, sb = b % 1024, swz = sb ^ (((sb >> 9) & 1) << 5); R = (st >> 1) * 16 + swz / 64; C = (st & 1) * 32 + (swz % 64) / 2; }
__host__ __device__ __forceinline__ int perm32(int rho) { const int n = rho >> 4, i = rho & 15; return 8 * (i >> 2) + 4 * n + (i & 3); }

struct Unit { int pm, pn; };
struct Gemm { const bf16_t* A; const bf16_t* Bt; int M, N, K; int lda; size_t a_kstep; int amode; };
__device__ __forceinline__ const char* a_base(const Gemm& g, int pm) { return g.amode == 0 ? (const char*)g.A + (size_t)pm * ((size_t)BM * g.lda * 2) : (const char*)g.A + (size_t)(pm >> 2) * ((size_t)4096 * 2816 * 2) + (size_t)(pm & 3) * 128; }

struct StaticOrder {
    int nM, nN, nwg, G, c;
    __host__ __device__ void init(int M, int N, int G_, int c_) { nM = M / BM; nN = N / BM; nwg = nM * nN; G = G_; c = c_; }
    __host__ __device__ bool next(int i, Unit& u) const {
        const long L = (long)i * G + c; if (L >= nwg) return false;
        int wgid = (int)L; { const int q = nwg / NXCD, r = nwg % NXCD, xcd = wgid % NXCD, off = wgid / NXCD; wgid = (xcd < r ? xcd * (q + 1) : r * (q + 1) + (xcd - r) * q) + off; }
        const int nig = WGM * nN, gid = wgid / nig, fm = gid * WGM, gsz = (nM - fm) < WGM ? (nM - fm) : WGM;
        u.pm = fm + ((wgid % nig) % gsz); u.pn = (wgid % nig) / gsz; return true;
    }
    __device__ __forceinline__ void a_ready(const Unit&) const {}
    __device__ __forceinline__ void done(const Unit&) const {}
};


__device__ __forceinline__ unsigned cvt_pk_bf16(float lo, float hi) { unsigned r; asm volatile("v_cvt_pk_bf16_f32 %0, %1, %2" : "=v"(r) : "v"(lo), "v"(hi)); return r; }
__device__ __forceinline__ float gelu_tanh(float x) { const float u = 1.5957691216f * (x + 0.044715f * x * x * x); return x / (1.0f + __expf(-u)); }
template <int ACT> struct EpiStore {
    static constexpr bool PERM = true, AFTER_DRAIN = false;
    bf16_t* O; int ldc; const float* bias;
    __device__ __forceinline__ void operator()(const f32x4 (&acc)[2][2][4][2], const Unit& u, int wr, int wc, int fr, int fq) const {
        const int row0 = u.pm * BM + wr * 64 + fr; const int col0 = u.pn * BM + wc * 32 + 8 * fq;
        f32x4 bv[2][2];
#pragma unroll
        for (int bj = 0; bj < 2; ++bj)
#pragma unroll
            for (int n = 0; n < 2; ++n) bv[bj][n] = bias ? *(const f32x4*)(bias + col0 + bj * HALF + 4 * n) : (f32x4){0.f, 0.f, 0.f, 0.f};
#pragma unroll
        for (int ai = 0; ai < 2; ++ai)
#pragma unroll
            for (int m = 0; m < 4; ++m) { bf16_t* rowp = O + (size_t)(row0 + ai * HALF + m * 16) * ldc + col0;
#pragma unroll
                for (int bj = 0; bj < 2; ++bj) { f32x4 v0 = acc[ai][bj][m][0] + bv[bj][0], v1 = acc[ai][bj][m][1] + bv[bj][1];
                    if (ACT == 2) { v0 = (f32x4){gelu_tanh(v0[0]), gelu_tanh(v0[1]), gelu_tanh(v0[2]), gelu_tanh(v0[3])}; v1 = (f32x4){gelu_tanh(v1[0]), gelu_tanh(v1[1]), gelu_tanh(v1[2]), gelu_tanh(v1[3])}; }
                    u32x4 w; w.x = cvt_pk_bf16(v0[0], v0[1]); w.y = cvt_pk_bf16(v0[2], v0[3]); w.z = cvt_pk_bf16(v1[0], v1[1]); w.w = cvt_pk_bf16(v1[2], v1[3]);
                    *(u32x4*)(rowp + bj * HALF) = w; } }
    }
};

template <class Epi, class Sched, bool ALIGN_EPI = false, bool SP2 = false>
__device__ __forceinline__ void gemm_phase(PG8_LAS unsigned char* lds, const Gemm g, const Sched& S, const Epi& E) {
    int tid = threadIdx.x; asm volatile("" : "+v"(tid)); const int wid = __builtin_amdgcn_readfirstlane(tid >> 6), lane = tid & 63, wr = wid >> 2, wc = wid & 3, fr = lane & 15, fq = lane >> 4;
    const int K = g.K, nt = K / BK;
    unsigned voffA[2], voffB[2];
#pragma unroll
    for (int i = 0; i < 2; ++i) { int R, C; stage_rc(tid * 16 + i * 8192, R, C); const int Rb = Epi::PERM ? ((R & ~31) + perm32(R & 31)) : R;
        voffA[i] = (unsigned)(R * g.lda + C) * 2u; voffB[i] = (unsigned)(Rb * K + C) * 2u; }
    const size_t kstep = (size_t)(BK * 2);
    const size_t hstepB = (size_t)HALF * K * 2, hstepA = (size_t)HALF * g.lda * 2, kstepA = g.a_kstep;
    const size_t tstep = 2 * hstepB;
    const unsigned ldsw = (unsigned)wid * 1024u;
    const int aoff = lds_byte(wr * 64 + fr, fq * 8), boff = lds_byte(wc * 32 + fr, fq * 8);
#define PG8_SA(b, h) (((b) * 2 + (h)) * HTB)
#define PG8_SB(b, h) ((4 + (b) * 2 + (h)) * HTB)
#define PG8_STAGE(bufoff, gbase, voff) do { _Pragma("unroll") for (int _i = 0; _i < 2; ++_i) \
        __builtin_amdgcn_global_load_lds((const unsigned*)((const char*)(gbase) + (voff)[_i]), (PG8_LAS unsigned*)(lds + (bufoff) + ldsw + _i * 8192), 16, 0, 0); } while (0)
#define PG8_LDA(dst, b, h) do { _Pragma("unroll") for (int m = 0; m < 4; ++m) _Pragma("unroll") for (int k = 0; k < 2; ++k) dst[m][k] = *(const PG8_LAS bf16x8*)(lds + PG8_SA(b, h) + aoff + m * 2048 + k * 1024); } while (0)
#define PG8_LDB(dst, b, h) do { _Pragma("unroll") for (int n = 0; n < 2; ++n) _Pragma("unroll") for (int k = 0; k < 2; ++k) dst[n][k] = *(const PG8_LAS bf16x8*)(lds + PG8_SB(b, h) + boff + n * 2048 + k * 1024); } while (0)
#define PG8_MMA(ai, bj, At, Bt) do { __builtin_amdgcn_s_setprio(1); _Pragma("unroll") for (int m = 0; m < 4; ++m) _Pragma("unroll") for (int n = 0; n < 2; ++n) _Pragma("unroll") for (int k = 0; k < 2; ++k) \
        acc[ai][bj][m][n] = __builtin_amdgcn_mfma_f32_16x16x32_bf16(Bt[n][k], At[m][k], acc[ai][bj][m][n], 0, 0, 0); __builtin_amdgcn_s_setprio(0); } while (0)
#define PG8_WAIT_V(n) asm volatile("s_waitcnt vmcnt(" #n ")" ::: "memory")
#define PG8_WAIT_L(n) asm volatile("s_waitcnt lgkmcnt(" #n ")" ::: "memory")
#define PG8_BAR __builtin_amdgcn_s_barrier()
#define PG8_SCHED __builtin_amdgcn_sched_barrier(0)
    Unit cur, nxt; int ui = 0;
    if (!S.next(0, cur)) return;
    f32x4 acc[2][2][4][2];
#pragma unroll
    for (int a = 0; a < 2; ++a)
#pragma unroll
        for (int b = 0; b < 2; ++b)
#pragma unroll
            for (int m = 0; m < 4; ++m)
#pragma unroll
                for (int n = 0; n < 2; ++n) acc[a][b][m][n] = (f32x4){0.f, 0.f, 0.f, 0.f};
    bf16x8 At[4][2], B0[2][2], B1[2][2];
    const char* cA = a_base(g, cur.pm); const char* cB = (const char*)g.Bt + (size_t)cur.pn * tstep;
    S.a_ready(cur);
    if constexpr (SP2) {
        PG8_STAGE(PG8_SB(0, 0), cB, voffB); PG8_STAGE(PG8_SB(0, 1), cB + hstepB, voffB); PG8_STAGE(PG8_SA(0, 0), cA, voffA); PG8_STAGE(PG8_SA(0, 1), cA + hstepA, voffA);
        if (wr == 1) PG8_BAR;
        PG8_WAIT_V(2); PG8_BAR;
        PG8_STAGE(PG8_SB(1, 0), cB + kstep, voffB); PG8_STAGE(PG8_SA(1, 0), cA + kstepA, voffA); PG8_STAGE(PG8_SB(1, 1), cB + hstepB + kstep, voffB);
        PG8_WAIT_V(6); PG8_BAR;
    } else {
        PG8_STAGE(PG8_SB(0, 0), cB, voffB); PG8_STAGE(PG8_SA(0, 0), cA, voffA); PG8_STAGE(PG8_SB(0, 1), cB + hstepB, voffB); PG8_STAGE(PG8_SA(0, 1), cA + hstepA, voffA);
        if (wr == 1) PG8_BAR;
        PG8_WAIT_V(4); PG8_BAR;
        PG8_STAGE(PG8_SB(1, 0), cB + kstep, voffB); PG8_STAGE(PG8_SA(1, 0), cA + kstepA, voffA); PG8_STAGE(PG8_SB(1, 1), cB + hstepB + kstep, voffB);
        PG8_WAIT_V(6); PG8_BAR;
    }
    for (;;) {
        const bool has_next = S.next(ui + 1, nxt);
        const char* nA = has_next ? a_base(g, nxt.pm) : cA; const char* nB = has_next ? (const char*)g.Bt + (size_t)nxt.pn * tstep : cB;
        for (int t = 0; t < nt; t += 2) {
            const bool last = (t == nt - 2);
            const char* a1 = cA + (size_t)(t + 1) * kstepA;
            const char* a2 = last ? nA : cA + (size_t)(t + 2) * kstepA; const char* b2 = last ? nB : cB + (size_t)(t + 2) * kstep;
            const char* a3 = a2 + kstepA; const char* b3 = b2 + kstep;
            if (last && has_next) S.a_ready(nxt);
            if constexpr (SP2) {
            PG8_LDB(B0, 0, 0); PG8_LDB(B1, 0, 1); PG8_SCHED; PG8_LDA(At, 0, 0); PG8_STAGE(PG8_SA(1, 1), a1 + hstepA, voffA);
            PG8_WAIT_V(8); PG8_WAIT_L(0); PG8_BAR; PG8_MMA(0, 0, At, B0); PG8_MMA(0, 1, At, B1); PG8_BAR; PG8_SCHED;
            PG8_LDA(At, 0, 1); PG8_STAGE(PG8_SB(0, 0), b2, voffB); PG8_STAGE(PG8_SB(0, 1), b2 + hstepB, voffB); PG8_STAGE(PG8_SA(0, 0), a2, voffA);
            PG8_WAIT_V(8); PG8_WAIT_L(0); PG8_BAR; PG8_MMA(1, 0, At, B0); PG8_MMA(1, 1, At, B1); PG8_BAR; PG8_SCHED;
            PG8_LDB(B0, 1, 0); PG8_LDB(B1, 1, 1); PG8_SCHED; PG8_LDA(At, 1, 0); PG8_STAGE(PG8_SA(0, 1), a2 + hstepA, voffA);
            PG8_WAIT_V(8); PG8_WAIT_L(0); PG8_BAR; PG8_MMA(0, 0, At, B0); PG8_MMA(0, 1, At, B1); PG8_BAR; PG8_SCHED;
            PG8_LDA(At, 1, 1); PG8_STAGE(PG8_SB(1, 0), b3, voffB); PG8_STAGE(PG8_SB(1, 1), b3 + hstepB, voffB); PG8_STAGE(PG8_SA(1, 0), a3, voffA);
            PG8_WAIT_V(8); PG8_WAIT_L(0); PG8_BAR; PG8_MMA(1, 0, At, B0); PG8_MMA(1, 1, At, B1); PG8_BAR; PG8_SCHED;
            } else {
            PG8_LDB(B0, 0, 0); PG8_SCHED; PG8_LDA(At, 0, 0); PG8_STAGE(PG8_SA(1, 1), a1 + hstepA, voffA);
            PG8_WAIT_L(8); PG8_BAR; PG8_WAIT_L(0); PG8_MMA(0, 0, At, B0); PG8_BAR; PG8_SCHED;
            PG8_LDB(B1, 0, 1); PG8_STAGE(PG8_SB(0, 0), b2, voffB);
            PG8_BAR; PG8_WAIT_L(0); PG8_MMA(0, 1, At, B1); PG8_BAR;
            PG8_LDA(At, 0, 1); PG8_STAGE(PG8_SA(0, 0), a2, voffA);
            PG8_BAR; PG8_WAIT_L(0); PG8_MMA(1, 0, At, B0); PG8_BAR; PG8_SCHED;
            PG8_STAGE(PG8_SB(0, 1), b2 + hstepB, voffB);
            PG8_WAIT_V(6); PG8_BAR; PG8_MMA(1, 1, At, B1); PG8_BAR;
            PG8_LDB(B0, 1, 0); PG8_SCHED; PG8_LDA(At, 1, 0); PG8_STAGE(PG8_SA(0, 1), a2 + hstepA, voffA);
            PG8_WAIT_L(8); PG8_BAR; PG8_WAIT_L(0); PG8_MMA(0, 0, At, B0); PG8_BAR; PG8_SCHED;
            PG8_LDB(B1, 1, 1); PG8_STAGE(PG8_SB(1, 0), b3, voffB);
            PG8_BAR; PG8_WAIT_L(0); PG8_MMA(0, 1, At, B1); PG8_BAR;
            PG8_LDA(At, 1, 1); PG8_STAGE(PG8_SA(1, 0), a3, voffA);
            PG8_BAR; PG8_WAIT_L(0); PG8_MMA(1, 0, At, B0); PG8_BAR; PG8_SCHED;
            PG8_STAGE(PG8_SB(1, 1), b3 + hstepB, voffB);
            PG8_WAIT_V(6); PG8_BAR; PG8_MMA(1, 1, At, B1); PG8_BAR;
            }
        }
        if constexpr (ALIGN_EPI) { if (wr == 0) PG8_BAR; }
        if constexpr (!Epi::AFTER_DRAIN) { E(acc, cur, wr, wc, fr, fq); S.done(cur); }
        if (!has_next) break;
#pragma unroll
        for (int a = 0; a < 2; ++a)
#pragma unroll
            for (int b = 0; b < 2; ++b)
#pragma unroll
                for (int m = 0; m < 4; ++m)
#pragma unroll
                    for (int n = 0; n < 2; ++n) acc[a][b][m][n] = (f32x4){0.f, 0.f, 0.f, 0.f};
        cur = nxt; cA = nA; cB = nB; ++ui;
        if constexpr (ALIGN_EPI) { if (wr == 1) PG8_BAR; }
    }
    PG8_WAIT_V(0);
    if constexpr (!ALIGN_EPI) { if (wr == 0) PG8_BAR; }
    PG8_BAR;
    if constexpr (Epi::AFTER_DRAIN) { E.fused(acc, cur, wr, wc, fr, fq, lds, wid, lane); S.done(cur); }
#undef PG8_SA
#undef PG8_SB
#undef PG8_STAGE
#undef PG8_LDA
#undef PG8_LDB
#undef PG8_MMA
#undef PG8_WAIT_V
#undef PG8_WAIT_L
#undef PG8_BAR
#undef PG8_SCHED
}
}


#define LAS __attribute__((address_space(3)))
typedef unsigned short bf16_t;
typedef short bf16x8 __attribute__((ext_vector_type(8)));
typedef short s16x4 __attribute__((ext_vector_type(4)));
typedef float f32x4 __attribute__((ext_vector_type(4)));
typedef float f32x2 __attribute__((ext_vector_type(2)));
typedef float f32x16 __attribute__((ext_vector_type(16)));
typedef unsigned u32x4 __attribute__((ext_vector_type(4)));
typedef unsigned u32x2 __attribute__((ext_vector_type(2)));

constexpr int T_ = 4096, NB_ = 16, M_ = NB_ * T_, DM = 1024;
constexpr int ZLD0 = 2560, ZLD1 = 2816, FF_ = 2816, ULD = 5632, LLD = 1536;
constexpr float NORM_EPS = 1e-6f, GN_EPS = 64e-5f;
constexpr size_t MiB = (size_t)1 << 20;
constexpr size_t WS_HYIN = 1 * MiB, WS_HYOUT = 6 * MiB, WS_NSAIN = 8 * MiB, WS_NSAOUT = 14 * MiB, WS_UP0 = 16 * MiB, WS_UP1 = 27 * MiB,
                 WS_DN0 = 38 * MiB, WS_DN1 = 44 * MiB, WS_LORA = 50 * MiB, WS_CW1K = 51 * MiB, WS_CW1V = 52 * MiB, WS_CBIAS = 53 * MiB;
constexpr size_t WS_H = 64 * MiB, WS_Z = 192 * MiB, WS_AP = 512 * MiB, WS_O = 544 * MiB, WS_L = 672 * MiB, WS_C = 864 * MiB, WS_MM = 896 * MiB;
constexpr size_t WS_HID = 672 * MiB, WS_KCMP = 688 * MiB, WS_VCMP = 690 * MiB, WS_U = 192 * MiB, WS_END = 1024 * MiB;
constexpr int LDS_BYTES = 147456;
constexpr int NPHASE = 23;

__device__ __forceinline__ float bf2f(unsigned u) { return __uint_as_float(u << 16); }
__device__ __forceinline__ unsigned pk2(float lo, float hi) { return pg8::cvt_pk_bf16(lo, hi); }
__device__ __forceinline__ float wave_sum(float v) {
#pragma unroll
    for (int o = 1; o < 64; o <<= 1) v += __shfl_xor(v, o);
    return v;
}
__device__ __forceinline__ float sigmoidf_(float x) { return 1.0f / (1.0f + __expf(-x)); }
#define LDS_WAIT() asm volatile("s_waitcnt lgkmcnt(0)" ::: "memory")

struct Args { const float* in[31]; float* out; unsigned char* ws; int ph_lo, ph_hi; };

__device__ __forceinline__ void transpose_item(const float* W, int N, bf16_t* WT, int ldt, LAS float* scr, int item, int nblk, int lane) {
    const int kb = item / nblk, nb = item % nblk, k0 = 64 * kb, n0 = 32 * nb;
    const int n = n0 + (lane & 31);
#pragma unroll 8
    for (int i = 0; i < 32; ++i) { const int kk = 2 * i + (lane >> 5); scr[kk * 33 + (lane & 31)] = (n < N) ? W[(size_t)(k0 + kk) * N + n] : 0.f; }
    LDS_WAIT(); asm volatile("" ::: "memory");
    const int c = lane & 7;
#pragma unroll
    for (int j = 0; j < 4; ++j) { const int nn = (lane >> 3) + 8 * j; const LAS float* s = scr + (8 * c) * 33 + nn;
        u32x4 o; o.x = pk2(s[0 * 33], s[1 * 33]); o.y = pk2(s[2 * 33], s[3 * 33]); o.z = pk2(s[4 * 33], s[5 * 33]); o.w = pk2(s[6 * 33], s[7 * 33]);
        *(u32x4*)(WT + (size_t)(n0 + nn) * ldt + k0 + 8 * c) = o; }
    LDS_WAIT(); asm volatile("" ::: "memory");
}

__device__ __forceinline__ void norm_phase(const float* xin, const bf16_t* mm, const float* gpost, float* xout, const float* gpre, bf16_t* hout, int gw, int NGW, int lane) {
    for (int m = gw; m < M_; m += NGW) {
        const f32x4* xr = (const f32x4*)(xin + (size_t)m * DM) + lane;
        f32x4 v[4];
#pragma unroll
        for (int j = 0; j < 4; ++j) v[j] = xr[64 * j];
        if (mm) {
            const u32x2* mr = (const u32x2*)(mm + (size_t)m * DM) + lane;
            f32x4 q[4]; float ss = 0.f;
#pragma unroll
            for (int j = 0; j < 4; ++j) { const u32x2 w = mr[64 * j]; q[j] = (f32x4){bf2f(w.x & 0xffffu), bf2f(w.x >> 16), bf2f(w.y & 0xffffu), bf2f(w.y >> 16)};
                ss += (q[j].x * q[j].x + q[j].y * q[j].y) + (q[j].z * q[j].z + q[j].w * q[j].w); }
            const float rs = rsqrtf(wave_sum(ss) * (1.f / DM) + NORM_EPS);
#pragma unroll
            for (int j = 0; j < 4; ++j) { const f32x4 g = *((const f32x4*)gpost + lane + 64 * j); v[j] = v[j] + q[j] * rs * g; }
        }
        if (xout) { f32x4* xo = (f32x4*)(xout + (size_t)m * DM) + lane;
#pragma unroll
            for (int j = 0; j < 4; ++j) xo[64 * j] = v[j]; }
        if (hout) {
            float s2 = 0.f;
#pragma unroll
            for (int j = 0; j < 4; ++j) s2 += (v[j].x * v[j].x + v[j].y * v[j].y) + (v[j].z * v[j].z + v[j].w * v[j].w);
            const float rs2 = rsqrtf(wave_sum(s2) * (1.f / DM) + NORM_EPS);
            u32x2* ho = (u32x2*)(hout + (size_t)m * DM) + lane;
#pragma unroll
            for (int j = 0; j < 4; ++j) { const f32x4 g = *((const f32x4*)gpre + lane + 64 * j); const f32x4 h = v[j] * rs2 * g;
                u32x2 w; w.x = pk2(h.x, h.y); w.y = pk2(h.z, h.w); ho[64 * j] = w; }
        }
    }
}

constexpr int KROW = 144, VROW = 152, KT_BYTES = 64 * KROW, VT_BYTES = 64 * VROW;
constexpr float NEGBIG = -1e30f;
__device__ __forceinline__ int crow(int r, int hi) { return (r & 3) + 8 * (r >> 2) + 4 * hi; }
struct TileRegs { u32x4 k, v; };
__device__ __forceinline__ void tile_gload(TileRegs& r, const bf16_t* Kg, const bf16_t* Vg, size_t ld, int tid) {
    r.k = *(const u32x4*)(Kg + (size_t)(tid >> 3) * ld + (tid & 7) * 8);
    r.v = *(const u32x4*)(Vg + (size_t)(tid & 63) * ld + (tid >> 6) * 8);
}
__device__ __forceinline__ void tile_lstore(const TileRegs& r, LAS unsigned char* Ks, LAS unsigned char* Vs, int tid) {
    *(LAS u32x4*)(Ks + (tid >> 3) * KROW + (tid & 7) * 16) = r.k;
    LAS unsigned char* vb = Vs + ((tid >> 6) * 8) * VROW + (tid & 63) * 2;
    *(LAS unsigned short*)(vb + 0 * VROW) = (unsigned short)(r.v.x & 0xffffu); *(LAS unsigned short*)(vb + 1 * VROW) = (unsigned short)(r.v.x >> 16);
    *(LAS unsigned short*)(vb + 2 * VROW) = (unsigned short)(r.v.y & 0xffffu); *(LAS unsigned short*)(vb + 3 * VROW) = (unsigned short)(r.v.y >> 16);
    *(LAS unsigned short*)(vb + 4 * VROW) = (unsigned short)(r.v.z & 0xffffu); *(LAS unsigned short*)(vb + 5 * VROW) = (unsigned short)(r.v.z >> 16);
    *(LAS unsigned short*)(vb + 6 * VROW) = (unsigned short)(r.v.w & 0xffffu); *(LAS unsigned short*)(vb + 7 * VROW) = (unsigned short)(r.v.w >> 16);
}
__device__ __forceinline__ void load_qfrag(bf16x8 (&qf)[4], const bf16_t* qrow, int hi) {
#pragma unroll
    for (int d0 = 0; d0 < 4; ++d0) { const u32x4 w = *(const u32x4*)(qrow + d0 * 16 + hi * 8);
        u32x4 o; o.x = pk2(bf2f(w.x & 0xffffu) * 0.125f, bf2f(w.x >> 16) * 0.125f); o.y = pk2(bf2f(w.y & 0xffffu) * 0.125f, bf2f(w.y >> 16) * 0.125f);
        o.z = pk2(bf2f(w.z & 0xffffu) * 0.125f, bf2f(w.z >> 16) * 0.125f); o.w = pk2(bf2f(w.w & 0xffffu) * 0.125f, bf2f(w.w >> 16) * 0.125f);
        qf[d0] = __builtin_bit_cast(bf16x8, o); }
}
__device__ __forceinline__ void tile_scores(f32x16& s0, f32x16& s1, const LAS unsigned char* Ks, const bf16x8 (&qf)[4], int r32, int hi) {
#pragma unroll
    for (int r = 0; r < 16; ++r) { s0[r] = 0.f; s1[r] = 0.f; }
#pragma unroll
    for (int d0 = 0; d0 < 4; ++d0) {
        const bf16x8 k0 = *(const LAS bf16x8*)(Ks + r32 * KROW + (d0 * 16 + hi * 8) * 2);
        const bf16x8 k1 = *(const LAS bf16x8*)(Ks + (32 + r32) * KROW + (d0 * 16 + hi * 8) * 2);
        s0 = __builtin_amdgcn_mfma_f32_32x32x16_bf16(k0, qf[d0], s0, 0, 0, 0);
        s1 = __builtin_amdgcn_mfma_f32_32x32x16_bf16(k1, qf[d0], s1, 0, 0, 0);
    }
}
__device__ __forceinline__ void tile_softmax_pv(f32x16& s0, f32x16& s1, const LAS unsigned char* Vs, f32x16 (&o)[2], float& m, float& l, int r32, int hi) {
    float mt = NEGBIG;
#pragma unroll
    for (int r = 0; r < 16; ++r) mt = fmaxf(mt, fmaxf(s0[r], s1[r]));
    mt = fmaxf(mt, __shfl_xor(mt, 32));
    const float mn = fmaxf(m, mt), alpha = __expf(m - mn); m = mn;
    float ps = 0.f;
#pragma unroll
    for (int r = 0; r < 16; ++r) { s0[r] = __expf(s0[r] - mn); s1[r] = __expf(s1[r] - mn); ps += s0[r] + s1[r]; }
    l = l * alpha + ps;
#pragma unroll
    for (int r = 0; r < 16; ++r) { o[0][r] *= alpha; o[1][r] *= alpha; }
    bf16x8 pb[4];
    { u32x4 w; w.x = pk2(s0[0], s0[1]); w.y = pk2(s0[2], s0[3]); w.z = pk2(s0[4], s0[5]); w.w = pk2(s0[6], s0[7]); pb[0] = __builtin_bit_cast(bf16x8, w); }
    { u32x4 w; w.x = pk2(s0[8], s0[9]); w.y = pk2(s0[10], s0[11]); w.z = pk2(s0[12], s0[13]); w.w = pk2(s0[14], s0[15]); pb[1] = __builtin_bit_cast(bf16x8, w); }
    { u32x4 w; w.x = pk2(s1[0], s1[1]); w.y = pk2(s1[2], s1[3]); w.z = pk2(s1[4], s1[5]); w.w = pk2(s1[6], s1[7]); pb[2] = __builtin_bit_cast(bf16x8, w); }
    { u32x4 w; w.x = pk2(s1[8], s1[9]); w.y = pk2(s1[10], s1[11]); w.z = pk2(s1[12], s1[13]); w.w = pk2(s1[14], s1[15]); pb[3] = __builtin_bit_cast(bf16x8, w); }
#pragma unroll
    for (int dh = 0; dh < 2; ++dh)
#pragma unroll
        for (int ks = 0; ks < 4; ++ks) {
            const LAS unsigned char* vp = Vs + (dh * 32 + r32) * VROW + (16 * ks + 4 * hi) * 2;
            const u32x2 lo = *(const LAS u32x2*)vp, hh = *(const LAS u32x2*)(vp + 16);
            const u32x4 a4 = (u32x4){lo.x, lo.y, hh.x, hh.y};
            o[dh] = __builtin_amdgcn_mfma_f32_32x32x16_bf16(__builtin_bit_cast(bf16x8, a4), pb[ks], o[dh], 0, 0, 0);
        }
}
__device__ __forceinline__ void store_o(const f32x16 (&o)[2], bf16_t* orow, int hi) {
#pragma unroll
    for (int dh = 0; dh < 2; ++dh)
#pragma unroll
        for (int r4 = 0; r4 < 4; ++r4) { u32x2 w; w.x = pk2(o[dh][4 * r4], o[dh][4 * r4 + 1]); w.y = pk2(o[dh][4 * r4 + 2], o[dh][4 * r4 + 3]);
            *(u32x2*)(orow + dh * 32 + 8 * r4 + 4 * hi) = w; }
}

__device__ __forceinline__ void swa_unit(int u, const bf16_t* Z, bf16_t* O, const float* sinks, LAS unsigned char* lds, int tid) {
    const int g = u & 1, sb = (u >> 1) & 63, b = u >> 7;
    const int lane = tid & 63, w = tid >> 6, r32 = lane & 31, hi = lane >> 5;
    const int h = g * 4 + (w >> 1), t0 = sb * 64, t = t0 + (w & 1) * 32 + r32;
    const size_t mrow = (size_t)b * T_ + t;
    LAS unsigned char* Ks = lds; LAS unsigned char* Vs = lds + KT_BYTES;
    bf16x8 qf[4]; load_qfrag(qf, Z + mrow * ZLD0 + h * 64, hi);
    const float slope = exp2f(-(float)(h + 1));
    float m = sinks[h], l = hi == 0 ? 1.f : 0.f;
    f32x16 o[2];
#pragma unroll
    for (int r = 0; r < 16; ++r) { o[0][r] = 0.f; o[1][r] = 0.f; }
    const int first = sb >= 2 ? 0 : 2 - sb;
    TileRegs tr;
    { const int kp0 = t0 - 128 + 64 * first; const bf16_t* base = Z + ((size_t)b * T_ + kp0) * ZLD0; tile_gload(tr, base + 512 + g * 64, base + 640 + g * 64, ZLD0, tid); }
    for (int ti = first; ti < 3; ++ti) {
        const int kp0 = t0 - 128 + 64 * ti;
        __syncthreads(); tile_lstore(tr, Ks, Vs, tid); __syncthreads();
        if (ti + 1 < 3) { const bf16_t* base = Z + ((size_t)b * T_ + kp0 + 64) * ZLD0; tile_gload(tr, base + 512 + g * 64, base + 640 + g * 64, ZLD0, tid); }
        f32x16 s0, s1; tile_scores(s0, s1, Ks, qf, r32, hi);
#pragma unroll
        for (int r = 0; r < 16; ++r) {
            const int d0 = t - (kp0 + crow(r, hi)), d1 = d0 - 32;
            s0[r] = (d0 >= 0 && d0 < 128) ? s0[r] - slope * (float)d0 : NEGBIG;
            s1[r] = (d1 >= 0 && d1 < 128) ? s1[r] - slope * (float)d1 : NEGBIG;
        }
        tile_softmax_pv(s0, s1, Vs, o, m, l, r32, hi);
    }
    l += __shfl_xor(l, 32);
    const float inv = 1.f / l;
#pragma unroll
    for (int r = 0; r < 16; ++r) { o[0][r] *= inv; o[1][r] *= inv; }
    store_o(o, O + mrow * DM + h * 64, hi);
}

constexpr int IMP_OFF = 19456, IMP_LD = 257, SELM_OFF = IMP_OFF + 64 * IMP_LD * 4  , UNI_OFF = SELM_OFF + 512;
__device__ __forceinline__ void nsa_unit(int u, const bf16_t* Z, const bf16_t* KC, const bf16_t* VC, bf16_t* O, LAS unsigned char* lds, int tid) {
    const int bg = u & 63, i = u >> 6, g = bg & 3, b = bg >> 2;
    const int lane = tid & 63, w = tid >> 6, r32 = lane & 31, hi = lane >> 5;
    const int hr = w >> 1, h = g * 4 + hr, t0 = i * 64, ql = (w & 1) * 32 + r32, t = t0 + ql;
    const size_t mrow = (size_t)b * T_ + t;
    LAS unsigned char* Ks = lds; LAS unsigned char* Vs = lds + KT_BYTES;
    LAS float* imp = (LAS float*)(lds + IMP_OFF);
    LAS unsigned* selm = (LAS unsigned*)(lds + SELM_OFF); LAS unsigned* uni = (LAS unsigned*)(lds + UNI_OFF);
    bf16x8 qf[4]; load_qfrag(qf, Z + mrow * ZLD1 + h * 64, hi);
    const float slope = exp2f(-0.5f * (float)(h + 1));
    const bf16_t* gatep = Z + mrow * ZLD1 + 2560 + h * 3;
    LAS float* park = (LAS float*)(lds + IMP_OFF) + tid;
    f32x16 o[2]; float m, l; TileRegs tr;
    const size_t cbase = ((size_t)(b * 4 + g) * 256) * 64;
    const int ncv = min(4 * i + 3, 255), nct = (ncv + 63) >> 6;
    m = NEGBIG; l = 0.f;
#pragma unroll
    for (int r = 0; r < 16; ++r) { o[0][r] = 0.f; o[1][r] = 0.f; }
    tile_gload(tr, KC + cbase, VC + cbase, 64, tid);
    for (int ti = 0; ti < nct; ++ti) {
        __syncthreads(); tile_lstore(tr, Ks, Vs, tid); __syncthreads();
        if (ti + 1 < nct) tile_gload(tr, KC + cbase + (size_t)(ti + 1) * 4096, VC + cbase + (size_t)(ti + 1) * 4096, 64, tid);
        f32x16 s0, s1; tile_scores(s0, s1, Ks, qf, r32, hi);
#pragma unroll
        for (int r = 0; r < 16; ++r) {
            const int d0 = t - (16 * (ti * 64 + crow(r, hi)) + 31), d1 = d0 - 512;
            s0[r] = d0 >= 0 ? s0[r] - slope * (float)d0 : NEGBIG;
            s1[r] = d1 >= 0 ? s1[r] - slope * (float)d1 : NEGBIG;
        }
        tile_softmax_pv(s0, s1, Vs, o, m, l, r32, hi);
    }
    l += __shfl_xor(l, 32);
    const bool rowok = t >= 31;
    const float invc = rowok ? 1.f / l : 0.f;
    { const float wg = sigmoidf_(bf2f(gatep[0])) * invc;
#pragma unroll
      for (int r = 0; r < 16; ++r) { o[0][r] *= wg; o[1][r] *= wg; } }
    if (i > 7) {
        const float mc = m;
        tile_gload(tr, KC + cbase, VC + cbase, 64, tid);
        for (int ti = 0; ti < nct; ++ti) {
            __syncthreads(); tile_lstore(tr, Ks, Vs, tid); __syncthreads();
            if (ti + 1 < nct) tile_gload(tr, KC + cbase + (size_t)(ti + 1) * 4096, VC + cbase + (size_t)(ti + 1) * 4096, 64, tid);
            f32x16 s0, s1; tile_scores(s0, s1, Ks, qf, r32, hi);
#pragma unroll
            for (int r = 0; r < 16; ++r) {
                const int d0 = t - (16 * (ti * 64 + crow(r, hi)) + 31), d1 = d0 - 512;
                s0[r] = d0 >= 0 ? __expf(s0[r] - slope * (float)d0 - mc) * invc : 0.f;
                s1[r] = d1 >= 0 ? __expf(s1[r] - slope * (float)d1 - mc) * invc : 0.f;
            }
            LAS float* ip = imp + ql * IMP_LD + ti * 64;
#pragma unroll
            for (int rr = 0; rr < 4; ++rr) {
                if (hr == rr) {
#pragma unroll
                    for (int r = 0; r < 16; ++r) { const int c = crow(r, hi);
                        if (rr == 0) { ip[c] = s0[r]; ip[32 + c] = s1[r]; } else { ip[c] += s0[r]; ip[32 + c] += s1[r]; } }
                }
                __syncthreads();
            }
        }
    }
    if (tid == 0) { uni[0] = 0u; uni[1] = 0u; }
    __syncthreads();
    if (tid < 64) {
        unsigned long long mask;
        if (i <= 7) mask = (2ull << i) - 1ull;
        else {
            float v0 = -1.f, v1 = -1.f, v2 = -1.f, v3 = -1.f, v4 = -1.f; int j0 = 0, j1 = 0, j2 = 0, j3 = 0, j4 = 0;
            const LAS float* ip = imp + tid * IMP_LD;
            for (int j = 1; j <= i - 2; ++j) {
                float v = ip[4 * j - 1] + 2.f * (ip[4 * j] + ip[4 * j + 1] + ip[4 * j + 2]) + ip[4 * j + 3]; int jj = j;
#define INS(vk, jk) if (v > vk) { const float tv = vk; const int tj = jk; vk = v; jk = jj; v = tv; jj = tj; }
                INS(v0, j0) INS(v1, j1) INS(v2, j2) INS(v3, j3) INS(v4, j4)
#undef INS
            }
            mask = 1ull | (1ull << i) | (1ull << (i - 1)) | (1ull << j0) | (1ull << j1) | (1ull << j2) | (1ull << j3) | (1ull << j4);
        }
        selm[2 * tid] = (unsigned)mask; selm[2 * tid + 1] = (unsigned)(mask >> 32);
        atomicOr((unsigned*)(uni), (unsigned)mask); atomicOr((unsigned*)(uni + 1), (unsigned)(mask >> 32));
    }
    __syncthreads();
#pragma unroll
    for (int r = 0; r < 16; ++r) { park[r * 512] = o[0][r]; park[(16 + r) * 512] = o[1][r]; }
    {
        unsigned long long um = (unsigned long long)uni[0] | ((unsigned long long)uni[1] << 32);
        const unsigned long long mym = (unsigned long long)selm[2 * ql] | ((unsigned long long)selm[2 * ql + 1] << 32);
        m = NEGBIG; l = 0.f;
#pragma unroll
        for (int r = 0; r < 16; ++r) { o[0][r] = 0.f; o[1][r] = 0.f; }
        int j = __builtin_ctzll(um); um &= um - 1;
        { const bf16_t* base = Z + ((size_t)b * T_ + 64 * j) * ZLD1; tile_gload(tr, base + 1536 + g * 64, base + 1792 + g * 64, ZLD1, tid); }
        for (;;) {
            __syncthreads(); tile_lstore(tr, Ks, Vs, tid); __syncthreads();
            const int jn = um ? __builtin_ctzll(um) : -1; um &= um - 1;
            if (jn >= 0) { const bf16_t* base = Z + ((size_t)b * T_ + 64 * jn) * ZLD1; tile_gload(tr, base + 1536 + g * 64, base + 1792 + g * 64, ZLD1, tid); }
            f32x16 s0, s1; tile_scores(s0, s1, Ks, qf, r32, hi);
            const bool sel = (mym >> j) & 1ull;
#pragma unroll
            for (int r = 0; r < 16; ++r) {
                const int d0 = t - (64 * j + crow(r, hi)), d1 = d0 - 32;
                s0[r] = (sel && d0 >= 0) ? s0[r] - slope * (float)d0 : NEGBIG;
                s1[r] = (sel && d1 >= 0) ? s1[r] - slope * (float)d1 : NEGBIG;
            }
            tile_softmax_pv(s0, s1, Vs, o, m, l, r32, hi);
            if (jn < 0) break;
            j = jn;
        }
        l += __shfl_xor(l, 32);
        const float wg = sigmoidf_(bf2f(gatep[1])) / l;
#pragma unroll
        for (int r = 0; r < 16; ++r) { park[r * 512] += wg * o[0][r]; park[(16 + r) * 512] += wg * o[1][r]; }
    }
    {
        m = NEGBIG; l = 0.f;
#pragma unroll
        for (int r = 0; r < 16; ++r) { o[0][r] = 0.f; o[1][r] = 0.f; }
        const int first = i >= 4 ? 0 : 4 - i;
        { const int kp0 = t0 - 256 + 64 * first; const bf16_t* base = Z + ((size_t)b * T_ + kp0) * ZLD1; tile_gload(tr, base + 2048 + g * 64, base + 2304 + g * 64, ZLD1, tid); }
        for (int ti = first; ti < 5; ++ti) {
            const int kp0 = t0 - 256 + 64 * ti;
            __syncthreads(); tile_lstore(tr, Ks, Vs, tid); __syncthreads();
            if (ti + 1 < 5) { const bf16_t* base = Z + ((size_t)b * T_ + kp0 + 64) * ZLD1; tile_gload(tr, base + 2048 + g * 64, base + 2304 + g * 64, ZLD1, tid); }
            f32x16 s0, s1; tile_scores(s0, s1, Ks, qf, r32, hi);
#pragma unroll
            for (int r = 0; r < 16; ++r) {
                const int d0 = t - (kp0 + crow(r, hi)), d1 = d0 - 32;
                s0[r] = (d0 >= 0 && d0 < 256) ? s0[r] - slope * (float)d0 : NEGBIG;
                s1[r] = (d1 >= 0 && d1 < 256) ? s1[r] - slope * (float)d1 : NEGBIG;
            }
            tile_softmax_pv(s0, s1, Vs, o, m, l, r32, hi);
        }
        l += __shfl_xor(l, 32);
        const float wg = sigmoidf_(bf2f(gatep[2])) / l;
#pragma unroll
        for (int r = 0; r < 16; ++r) { o[0][r] = park[r * 512] + wg * o[0][r]; o[1][r] = park[(16 + r) * 512] + wg * o[1][r]; }
    }
    store_o(o, O + mrow * DM + h * 64, hi);
    __syncthreads();
}

__device__ __forceinline__ float dpp_xadd(float x, int which) {
    int r;
    const int xi = __float_as_int(x);
    if (which == 0) r = __builtin_amdgcn_update_dpp(0, xi, 0xB1, 0xf, 0xf, false);
    else if (which == 1) r = __builtin_amdgcn_update_dpp(0, xi, 0x4E, 0xf, 0xf, false);
    else if (which == 2) r = __builtin_amdgcn_update_dpp(0, xi, 0x141, 0xf, 0xf, false);
    else r = __builtin_amdgcn_update_dpp(0, xi, 0x140, 0xf, 0xf, false);
    return x + __int_as_float(r);
}
__device__ __forceinline__ float row16_sum(float x) { x = dpp_xadd(x, 0); x = dpp_xadd(x, 1); x = dpp_xadd(x, 2); x = dpp_xadd(x, 3); return x; }

#define UNPK4(w) (f32x4){bf2f((w).x & 0xffffu), bf2f((w).x >> 16), bf2f((w).y & 0xffffu), bf2f((w).y >> 16)}
#define PK4(v) (u32x2){pk2((v).x, (v).y), pk2((v).z, (v).w)}
__device__ __forceinline__ f32x4 sig4(f32x4 v) { return (f32x4){sigmoidf_(v.x), sigmoidf_(v.y), sigmoidf_(v.z), sigmoidf_(v.w)}; }
__device__ __forceinline__ void rwkv_prep(const Args& a, const bf16_t* Z, const bf16_t* L, bf16_t* KK, bf16_t* WR, bf16_t* WE, bf16_t* KKA, bf16_t* KT, bf16_t* VS, float* C, int gw, int NGW, int lane) {
    const int h = gw & 7, col = h * 64 + (lane & 15) * 4, q = lane >> 4;
    const f32x4 mu_r = *(const f32x4*)(a.in[8] + col), mu_k = *(const f32x4*)(a.in[8] + 512 + col), mu_v = *(const f32x4*)(a.in[8] + 1024 + col);
    const f32x4 w0 = *(const f32x4*)(a.in[9] + col), a0 = *(const f32x4*)(a.in[11] + col), k_k = *(const f32x4*)(a.in[14] + col), k_a = *(const f32x4*)(a.in[15] + col), r_k = *(const f32x4*)(a.in[16] + col);
    for (int m4 = gw >> 3; m4 < M_ / 4; m4 += NGW >> 3) {
        const int m = m4 * 4 + q;
        const bf16_t* zr = Z + (size_t)m * ZLD0 + 768 + col;
        f32x4 r = UNPK4(*(const u32x2*)zr), k = UNPK4(*(const u32x2*)(zr + 512)), v = UNPK4(*(const u32x2*)(zr + 1024));
        f32x4 rp = (f32x4){0.f, 0.f, 0.f, 0.f}, kp = rp, vp = rp;
        if ((m & (T_ - 1)) != 0) { rp = UNPK4(*(const u32x2*)(zr - ZLD0)); kp = UNPK4(*(const u32x2*)(zr + 512 - ZLD0)); vp = UNPK4(*(const u32x2*)(zr + 1024 - ZLD0)); }
        r += (rp - r) * mu_r; k += (kp - k) * mu_k; v += (vp - v) * mu_v;
        const f32x4 lw = UNPK4(*(const u32x2*)(L + (size_t)m * LLD + col)), la = UNPK4(*(const u32x2*)(L + (size_t)m * LLD + 512 + col));
        const f32x4 e = sig4(w0 + lw) * 0.60653065971f;
        const u32x2 eb = PK4(e);
        const f32x4 er = UNPK4(eb);
        const f32x4 wdec = (f32x4){__expf(-er.x), __expf(-er.y), __expf(-er.z), __expf(-er.w)};
        const f32x4 av = sig4(a0 + la);
        f32x4 kk = k * k_k;
        const float nrm = sqrtf(row16_sum((kk.x * kk.x + kk.y * kk.y) + (kk.z * kk.z + kk.w * kk.w)));
        kk = kk * (1.f / fmaxf(nrm, 1e-12f));
        const f32x4 kt = k * (1.f + (av - 1.f) * k_a);
        const f32x4 kka = kk * av;
        const f32x4 t1 = kka * r, t2 = kt * r, t3 = t2 * r_k;
        const float c1 = row16_sum((t1.x + t1.y) + (t1.z + t1.w)), c2 = row16_sum((t2.x + t2.y) + (t2.z + t2.w)), c3 = row16_sum((t3.x + t3.y) + (t3.z + t3.w));
        const size_t o = (size_t)m * 512 + col;
        const f32x4 wr = wdec * r;
        *(u32x2*)(KK + o) = PK4(kk); *(u32x2*)(WR + o) = PK4(wr); *(u32x2*)(WE + o) = eb;
        *(u32x2*)(KKA + o) = PK4(kka); *(u32x2*)(KT + o) = PK4(kt); *(u32x2*)(VS + o) = PK4(v);
        if ((lane & 15) == 0) *(f32x4*)(C + (size_t)m * 32 + h * 4) = (f32x4){c1, c2, c3, 0.f};
    }
}

constexpr int SC_TS = 32, SC_BUF = 5 * SC_TS * 64 + SC_TS * 32 + SC_TS * 2;
__device__ __forceinline__ void scan_unit(int u, const bf16_t* KK, const bf16_t* WR, const bf16_t* WE, const bf16_t* KKA, const bf16_t* KT, const bf16_t* VS, const float* C, float* Y, LAS unsigned char* lds, int tid) {
    const int half = u & 1, h = (u >> 1) & 7, b = u >> 4;
    const int il = tid >> 4, jg = tid & 15;
    LAS float* buf0 = (LAS float*)lds; LAS float* buf1 = buf0 + SC_BUF; LAS float* ybuf = buf1 + SC_BUF;
    float S0 = 0.f, S1 = 0.f, S2 = 0.f, S3 = 0.f;
    const size_t rowbase = (size_t)b * T_;
    const size_t goff = (rowbase + il) * 512 + h * 64 + jg * 4;
    const size_t voff = (rowbase + il) * 512 + h * 64 + half * 32 + jg * 2;
    u32x2 rkk, rwr, rwe, rkka, rkt; unsigned rv; f32x2 rc;
#define SC_GLOAD(t0) do { const size_t d_ = (size_t)(t0) * 512; rkk = *(const u32x2*)(KK + goff + d_); rwr = *(const u32x2*)(WR + goff + d_); rwe = *(const u32x2*)(WE + goff + d_); \
        rkka = *(const u32x2*)(KKA + goff + d_); rkt = *(const u32x2*)(KT + goff + d_); rv = *(const unsigned*)(VS + voff + d_); \
        if (tid < SC_TS) rc = *(const f32x2*)(C + (rowbase + (t0) + tid) * 32 + h * 4); } while (0)
#define SC_EXP4(w) (f32x4){bf2f((w).x & 0xffffu), bf2f((w).x >> 16), bf2f((w).y & 0xffffu), bf2f((w).y >> 16)}
#define SC_LSTORE(bf) do { LAS float* p_ = (bf) + il * 64 + jg * 4; *(LAS f32x4*)(p_) = SC_EXP4(rkk); *(LAS f32x4*)(p_ + 2048) = SC_EXP4(rwr); \
        { f32x4 e_ = SC_EXP4(rwe); *(LAS f32x4*)(p_ + 4096) = (f32x4){__expf(-e_.x), __expf(-e_.y), __expf(-e_.z), __expf(-e_.w)}; } \
        *(LAS f32x4*)(p_ + 6144) = SC_EXP4(rkka); *(LAS f32x4*)(p_ + 8192) = SC_EXP4(rkt); \
        *(LAS f32x2*)((bf) + 10240 + il * 32 + jg * 2) = (f32x2){bf2f(rv & 0xffffu), bf2f(rv >> 16)}; \
        if (tid < SC_TS) *(LAS f32x2*)((bf) + 11264 + tid * 2) = rc; } while (0)
    __syncthreads();
    SC_GLOAD(0); SC_LSTORE(buf0);
    __syncthreads();
    for (int n = 0; n < T_ / SC_TS; ++n) {
        LAS float* cb = (n & 1) ? buf1 : buf0; LAS float* nb = (n & 1) ? buf0 : buf1;
        if (n + 1 < T_ / SC_TS) SC_GLOAD((n + 1) * SC_TS);
#pragma unroll 8
        for (int s = 0; s < SC_TS; ++s) {
            const LAS float* B = cb + s * 64 + jg * 4;
            const f32x4 kk = *(const LAS f32x4*)B, wr = *(const LAS f32x4*)(B + 2048), w = *(const LAS f32x4*)(B + 4096), kka = *(const LAS f32x4*)(B + 6144), kt = *(const LAS f32x4*)(B + 8192);
            const float v = cb[10240 + s * 32 + il]; const f32x2 c = *(const LAS f32x2*)(cb + 11264 + s * 2);
            float sa = (S0 * kk.x + S1 * kk.y) + (S2 * kk.z + S3 * kk.w);
            float uu = (S0 * wr.x + S1 * wr.y) + (S2 * wr.z + S3 * wr.w);
            sa = row16_sum(sa); uu = row16_sum(uu);
            const float y = uu - sa * c.x + v * c.y;
            if (jg == 0) ybuf[s * 32 + il] = y;
            S0 = S0 * w.x + (v * kt.x - sa * kka.x); S1 = S1 * w.y + (v * kt.y - sa * kka.y);
            S2 = S2 * w.z + (v * kt.z - sa * kka.z); S3 = S3 * w.w + (v * kt.w - sa * kka.w);
        }
        __syncthreads();
        if (n + 1 < T_ / SC_TS) SC_LSTORE(nb);
        { const f32x2 yv = *(const LAS f32x2*)(ybuf + il * 32 + jg * 2);
          *(f32x2*)(Y + (rowbase + (size_t)n * SC_TS + il) * 512 + h * 64 + half * 32 + jg * 2) = yv; }
        __syncthreads();
    }
#undef SC_GLOAD
#undef SC_EXP4
#undef SC_LSTORE
}

__device__ __forceinline__ void rwkv_post(const Args& a, const float* Y, const bf16_t* VS, const bf16_t* L, const float* C, bf16_t* O, int gw, int NGW, int lane) {
    const int h = gw & 7, col = h * 64 + (lane & 15) * 4, q = lane >> 4;
    const f32x4 lg = *(const f32x4*)(a.in[17] + col), lb = *(const f32x4*)(a.in[18] + col);
    for (int m4 = gw >> 3; m4 < M_ / 4; m4 += NGW >> 3) {
        const int m = m4 * 4 + q;
        const f32x4 y = *(const f32x4*)(Y + (size_t)m * 512 + col);
        const float mean = row16_sum((y.x + y.y) + (y.z + y.w)) * (1.f / 64.f); const f32x4 d = y - mean;
        const float var = row16_sum((d.x * d.x + d.y * d.y) + (d.z * d.z + d.w * d.w)) * (1.f / 64.f);
        const f32x4 yn = d * rsqrtf(var + GN_EPS) * lg + lb;
        const f32x4 v = UNPK4(*(const u32x2*)(VS + (size_t)m * 512 + col)), g = UNPK4(*(const u32x2*)(L + (size_t)m * LLD + 1024 + col));
        const float c3 = C[(size_t)m * 32 + h * 4 + 2];
        const f32x4 ov = (yn + v * c3) * g;
        *(u32x2*)(O + (size_t)m * DM + 512 + col) = PK4(ov);
    }
}

#define XB_TMO      128
#define XB_XCNT(j)  (256  + 64 * (j))
#define XB_XSUB(j)  (1280 + 64 * (j))
#define XB_XGEN(j)  (2304 + 64 * (j))
#define XB_TOP      3328
#define XB_TOPGEN   3392
#define XCD_BAR_WORDS 3456
#define XB_SPIN_CAP (1u << 18)

__device__ __forceinline__ unsigned xb_ld(unsigned* p)              { return __hip_atomic_load(p, __ATOMIC_RELAXED, __HIP_MEMORY_SCOPE_AGENT); }
__device__ __forceinline__ unsigned xb_add(unsigned* p, unsigned v) { return __hip_atomic_fetch_add(p, v, __ATOMIC_RELAXED, __HIP_MEMORY_SCOPE_AGENT); }
__device__ __forceinline__ unsigned xb_xcc_id() { return (unsigned)__builtin_amdgcn_s_getreg((3 << 11) | 20) & 0xFu; }
#define XB_SPIN(cond, bar) do { unsigned _sp = 0; while (cond) { __builtin_amdgcn_s_sleep(1); \
    if ((++_sp & 255u) == 0u) { if (xb_ld(&(bar)[XB_TMO])) break; if (_sp > XB_SPIN_CAP) { atomicAdd(&(bar)[XB_TMO], 1u); break; } } } } while (0)
struct XcdBarrier {
    unsigned* bar; unsigned x;
    volatile LAS unsigned* st;
};

__device__ __forceinline__ XcdBarrier xcd_barrier_post(unsigned* bar, volatile LAS unsigned* st) {
    XcdBarrier b; b.bar = bar; b.x = xb_xcc_id(); b.st = st;
    if (threadIdx.x == 0) (void)xb_add(&bar[XB_XCNT(b.x)], 1u);
    return b;
}
__device__ __forceinline__ void xcd_barrier_complete(unsigned* bar, unsigned x, unsigned& nloc, unsigned& nx) {
    const unsigned G = gridDim.x * gridDim.y * gridDim.z;
    unsigned sum, cnt, mine, sp = 0u;
    for (;;) {
        sum = 0u; cnt = 0u; mine = 0u;
#pragma unroll
        for (unsigned j = 0; j < 16; ++j) { const unsigned c = xb_ld(&bar[XB_XCNT(j)]); sum += c; cnt += (c > 0u) ? 1u : 0u; mine = (j == x) ? c : mine; }
        if (sum == G) break;
        __builtin_amdgcn_s_sleep(1);
        if ((++sp & 255u) == 0u) { if (xb_ld(&bar[XB_TMO])) break; if (sp > XB_SPIN_CAP) { atomicAdd(&bar[XB_TMO], 1u); break; } }
    }
    nloc = mine > 0u ? mine : 1u; nx = cnt > 0u ? cnt : 1u;
}

__device__ __forceinline__ void xcd_barrier(const XcdBarrier& b) {
    asm volatile("s_waitcnt vmcnt(0)" ::: "memory");
    __syncthreads();
    if (threadIdx.x == 0) {
        unsigned* bar = b.bar;
        __builtin_amdgcn_s_waitcnt(0);
        unsigned nloc = b.st[0], nx = b.st[1];
        if (nloc == 0u) { xcd_barrier_complete(bar, b.x, nloc, nx); b.st[0] = nloc; b.st[1] = nx; }
        const unsigned old = xb_add(&bar[XB_XSUB(b.x)], 1u);
        const unsigned gen = old / nloc;
        if (old + 1u == (gen + 1u) * nloc) {
            __builtin_amdgcn_fence(__ATOMIC_RELEASE, "agent");
            asm volatile("s_waitcnt vmcnt(0)" ::: "memory");
            const unsigned og = xb_add(&bar[XB_TOP], 1u);
            const unsigned tg = og / nx;
            if (og + 1u == (tg + 1u) * nx) xb_add(&bar[XB_TOPGEN], 1u);
            else XB_SPIN(xb_ld(&bar[XB_TOPGEN]) == tg, bar);
            __builtin_amdgcn_fence(__ATOMIC_ACQUIRE, "agent");
            xb_add(&bar[XB_XGEN(b.x)], 1u);
            asm volatile("s_waitcnt vmcnt(0)" ::: "memory");
        } else {
            XB_SPIN(xb_ld(&bar[XB_XGEN(b.x)]) == gen, bar);
            __builtin_amdgcn_fence(__ATOMIC_ACQUIRE, "agent");
            asm volatile("s_waitcnt vmcnt(0)" ::: "memory");
        }
    }
    __syncthreads();
}

__device__ __forceinline__ void run_gemm0(LAS unsigned char* lds, const bf16_t* A, const bf16_t* Bt, int M, int N, int K, int lda, bf16_t* Oo, int ldc) {
    pg8::Gemm g{A, Bt, M, N, K, lda, (size_t)128, 0}; pg8::StaticOrder S; S.init(M, N, (int)gridDim.x, (int)blockIdx.x);
    pg8::EpiStore<0> E{Oo, ldc, nullptr};

#ifndef NO_GEMM
    pg8::gemm_phase<pg8::EpiStore<0>, pg8::StaticOrder, true, true>(lds, g, S, E);
#endif
}


#define Wt_hyin ((bf16_t*)(ws + WS_HYIN))
#define Wt_hyout ((bf16_t*)(ws + WS_HYOUT))
#define Wt_nsain ((bf16_t*)(ws + WS_NSAIN))
#define Wt_nsaout ((bf16_t*)(ws + WS_NSAOUT))
#define Wt_lora ((bf16_t*)(ws + WS_LORA))
#define Wt_cw1k ((bf16_t*)(ws + WS_CW1K))
#define Wt_cw1v ((bf16_t*)(ws + WS_CW1V))
#define cbias ((float*)(ws + WS_CBIAS))
#define W2T ((bf16_t*)(ws + WS_CBIAS + 4096))
#define H ((bf16_t*)(ws + WS_H))
#define Z ((bf16_t*)(ws + WS_Z))
#define AP ((bf16_t*)(ws + WS_AP))
#define O ((bf16_t*)(ws + WS_O))
#define L ((bf16_t*)(ws + WS_L))
#define C ((float*)(ws + WS_C))
#define MM ((bf16_t*)(ws + WS_MM))
#define Y ((float*)(ws + WS_MM))
#define HID ((bf16_t*)(ws + WS_HID))
#define KC ((bf16_t*)(ws + WS_KCMP))
#define VC ((bf16_t*)(ws + WS_VCMP))
#define U ((bf16_t*)(ws + WS_U))
#define KK ((bf16_t*)(ws + WS_H))
#define WR (KK + (size_t)M_ * 512)
#define WE ((bf16_t*)args.out)
#define KKA (WE + (size_t)M_ * 512)
#define KT (WE + (size_t)M_ * 1024)
#define VS (WE + (size_t)M_ * 1536)
#define XIN (args.in[0])
#define X (args.out)
#define PH_BEGIN unsigned char* ws = args.ws; asm volatile("" : "+s"(ws)); int tid_ = threadIdx.x; asm volatile("" : "+v"(tid_)); const int tid = tid_, lane = tid & 63, wave = __builtin_amdgcn_readfirstlane(tid >> 6); const int G = gridDim.x, gw = blockIdx.x * 8 + wave, NGW = G * 8; const int gtid = blockIdx.x * 512 + tid, NT = G * 512; (void)lane; (void)gw; (void)NGW; (void)gtid; (void)NT; (void)ws;
__global__ void __launch_bounds__(512, 2) mega_fwd(Args args) {
    extern __shared__ __attribute__((aligned(16))) unsigned char lds_raw[];
    LAS unsigned char* lds = (LAS unsigned char*)lds_raw;
    cg::grid_group grid = cg::this_grid();
    volatile LAS unsigned* xst = (volatile LAS unsigned*)(lds + LDS_BYTES - 64);
    if (threadIdx.x < 2) xst[threadIdx.x] = 0u;
    __syncthreads();
    const XcdBarrier xbar = xcd_barrier_post((unsigned*)args.ws, xst);
    const int lo = args.ph_lo, hi = args.ph_hi;
#define IN(k) (lo <= (k) && (k) < hi)
#ifndef DUP_MASK
#define DUP_MASK 0u
#endif
#define REP(k) for (int rep_ = 0; rep_ < (((DUP_MASK >> (k)) & 1u) ? 2 : 1); ++rep_)
#define SEAM(k) do { if (IN(k) && IN((k) + 1)) { if ((k) == 0) grid.sync(); else xcd_barrier(xbar); } } while (0)

#ifdef EXTRA_SYNCS
    if (IN(0) && IN(1)) for (int es_ = 0; es_ < EXTRA_SYNCS; ++es_) grid.sync();
#endif
    if (IN(0)) REP(0) { PH_BEGIN
        LAS float* scr = (LAS float*)(lds + wave * 16384);
        constexpr int I0 = 16 * 80, I1 = 16 * 32, I2 = 16 * 88, I3 = 16 * 32, I4 = 16 * 176, I5 = 44 * 32, I6 = 32 * 8;
        constexpr int NIT = I0 + I1 + I2 + I3 + 2 * I4 + 2 * I5 + 2 * I6;
        for (int it = gw; it < NIT; it += NGW) {
            int r = it;
            if (r < I0) { transpose_item(args.in[5], 2560, Wt_hyin, 1024, scr, r, 80, lane); continue; } r -= I0;
            if (r < I1) { transpose_item(args.in[6], 1024, Wt_hyout, 1024, scr, r, 32, lane); continue; } r -= I1;
            if (r < I2) { transpose_item(args.in[19], 2608, Wt_nsain, 1024, scr, r, 88, lane); continue; } r -= I2;
            if (r < I3) { transpose_item(args.in[20], 1024, Wt_nsaout, 1024, scr, r, 32, lane); continue; } r -= I3;
            if (r < 2 * I4) { const int l = r / I4; transpose_item(args.in[27] + (size_t)l * 1024 * 5632, 5632, (bf16_t*)(ws + (l ? WS_UP1 : WS_UP0)), 1024, scr, r % I4, 176, lane); continue; } r -= 2 * I4;
            if (r < 2 * I5) { const int l = r / I5; transpose_item(args.in[30] + (size_t)l * 2816 * 1024, 1024, (bf16_t*)(ws + (l ? WS_DN1 : WS_DN0)), 2816, scr, r % I5, 32, lane); continue; } r -= 2 * I5;
            if (r < I6) { transpose_item(args.in[22], 256, Wt_cw1k, 2048, scr, r, 8, lane); continue; } r -= I6;
            transpose_item(args.in[25], 256, Wt_cw1v, 2048, scr, r, 8, lane);
        }
        for (int e = gtid; e < 1536 * 256; e += NT) {
            const int n = e >> 8, k = e & 255; float v = 0.f;
            if (n < 512) { if (k < 64) v = args.in[10][k * 512 + n]; }
            else if (n < 1024) { if (k >= 64 && k < 128) v = args.in[12][(k - 64) * 512 + (n - 512)]; }
            else { if (k >= 128) v = args.in[13][(k - 128) * 512 + (n - 1024)]; }
            Wt_lora[e] = (bf16_t)(pk2(v, 0.f) & 0xffffu);
        }
        for (int e = gtid; e < 2 * 16384; e += NT) { const int which = e >> 14, d = (e >> 8) & 63, f = e & 255; W2T[e] = (bf16_t)(pk2(args.in[which ? 26 : 23][f * 64 + d], 0.f) & 0xffffu); }
        for (int it = gw; it < 512; it += NGW) {
            const int which = it >> 8, f = it & 255; const float* pos = args.in[which ? 24 : 21]; const float* w1 = args.in[which ? 25 : 22];
            float s = 0.f;
            for (int e = lane; e < 2048; e += 64) s += pos[e] * w1[(size_t)e * 256 + f];
            s = wave_sum(s);
            if (lane == 0) cbias[it] = s;
        }
        norm_phase(XIN, nullptr, nullptr, nullptr, args.in[1], H, gw, NGW, lane);
    }
    SEAM(0);
    if (IN(1)) REP(1) { PH_BEGIN run_gemm0(lds, H, Wt_hyin, M_, ZLD0, 1024, 1024, Z, ZLD0); }
    SEAM(1);
    if (IN(2)) REP(2) { PH_BEGIN
        const float* mu = args.in[8];
        for (int it = gtid; it < M_ * 32; it += NT) {
            const int m = it >> 5, col = (it & 31) * 8;
            const bf16_t* zp = Z + (size_t)m * ZLD0 + 2304 + col;
            const u32x4 zc = *(const u32x4*)zp; u32x4 zq = (u32x4){0u, 0u, 0u, 0u};
            if ((m & (T_ - 1)) != 0) zq = *(const u32x4*)(zp - ZLD0);
            const unsigned cw[4] = {zc.x, zc.y, zc.z, zc.w}, pw[4] = {zq.x, zq.y, zq.z, zq.w}; unsigned ow[4];
#pragma unroll
            for (int e = 0; e < 4; ++e) {
                float a0 = bf2f(cw[e] & 0xffffu), a1 = bf2f(cw[e] >> 16); const float p0 = bf2f(pw[e] & 0xffffu), p1 = bf2f(pw[e] >> 16);
                a0 += (p0 - a0) * mu[1536 + col + 2 * e]; a1 += (p1 - a1) * mu[1536 + col + 2 * e + 1];
                if (col < 64) { a0 = tanhf(a0); a1 = tanhf(a1); } else if (col >= 128) { a0 = sigmoidf_(a0); a1 = sigmoidf_(a1); }
                ow[e] = pk2(a0, a1);
            }
            *(u32x4*)(AP + (size_t)m * 256 + col) = (u32x4){ow[0], ow[1], ow[2], ow[3]};
        }

#ifndef NO_SWA
for (int u = blockIdx.x; u < NB_ * 64 * 2; u += G) swa_unit(u, Z, O, args.in[7], lds, tid);
#endif

        __syncthreads();
    }
    SEAM(2);
    if (IN(3)) REP(3) { PH_BEGIN run_gemm0(lds, AP, Wt_lora, M_, LLD, 256, 256, L, LLD); }
    SEAM(3);
    if (IN(4)) REP(4) { PH_BEGIN rwkv_prep(args, Z, L, KK, WR, WE, KKA, KT, VS, C, gw, NGW, lane); }
    SEAM(4);
    if (IN(5)) REP(5) { PH_BEGIN
#ifndef NO_SCAN
for (int u = blockIdx.x; u < 256; u += G) scan_unit(u, KK, WR, WE, KKA, KT, VS, C, Y, lds, tid);
#endif
 }
    SEAM(5);
    if (IN(6)) REP(6) { PH_BEGIN rwkv_post(args, Y, VS, L, C, O, gw, NGW, lane); }
    SEAM(6);
    if (IN(7)) REP(7) { PH_BEGIN run_gemm0(lds, O, Wt_hyout, M_, 1024, 1024, 1024, MM, 1024); }
    SEAM(7);
    if (IN(8)) REP(8) { PH_BEGIN norm_phase(XIN, MM, args.in[2], X, args.in[3], H, gw, NGW, lane); }
    SEAM(8);
#pragma unroll
    for (int l = 0; l < 2; ++l) {
        const int pb = l ? 19 : 9;
        if (IN(pb)) REP(pb) { PH_BEGIN run_gemm0(lds, H, (const bf16_t*)(ws + (l ? WS_UP1 : WS_UP0)), M_, ULD, 1024, 1024, U, ULD); }
        SEAM(pb);
        if (IN(pb + 1)) REP(pb + 1) { PH_BEGIN
            const float* cw = args.in[28] + (size_t)l * 3 * FF_; const float* cbv = args.in[29] + (size_t)l * FF_;
            for (int it = gtid; it < (M_ / 16) * (FF_ / 8); it += NT) {
                const int run = it / (FF_ / 8), f = (it - run * (FF_ / 8)) * 8, m0 = run * 16;
                f32x4 w0a = *(const f32x4*)(cw + f), w0b = *(const f32x4*)(cw + f + 4), w1a = *(const f32x4*)(cw + FF_ + f), w1b = *(const f32x4*)(cw + FF_ + f + 4);
                f32x4 w2a = *(const f32x4*)(cw + 2 * FF_ + f), w2b = *(const f32x4*)(cw + 2 * FF_ + f + 4), cba = *(const f32x4*)(cbv + f), cbb = *(const f32x4*)(cbv + f + 4);
                bf16_t* up = U + (size_t)m0 * ULD + f;
                u32x4 g1 = (u32x4){0u, 0u, 0u, 0u}, g2 = g1;
                if ((m0 & (T_ - 1)) != 0) { g1 = *(const u32x4*)(up - ULD); g2 = *(const u32x4*)(up - 2 * ULD); }
                f32x4 p1a = UNPK4(((u32x2){g1.x, g1.y})), p1b = UNPK4(((u32x2){g1.z, g1.w})), p2a = UNPK4(((u32x2){g2.x, g2.y})), p2b = UNPK4(((u32x2){g2.z, g2.w}));
#pragma unroll 4
                for (int rr = 0; rr < 16; ++rr) {
                    const u32x4 g0 = *(const u32x4*)(up + (size_t)rr * ULD), vv = *(const u32x4*)(up + (size_t)rr * ULD + FF_);
                    const f32x4 ca = UNPK4(((u32x2){g0.x, g0.y})), cb4 = UNPK4(((u32x2){g0.z, g0.w}));
                    const f32x4 va = UNPK4(((u32x2){vv.x, vv.y})), vb = UNPK4(((u32x2){vv.z, vv.w}));
                    const f32x4 xa = cba + ca * w2a + p1a * w1a + p2a * w0a, xb = cbb + cb4 * w2b + p1b * w1b + p2b * w0b;
                    const f32x4 oa = (f32x4){pg8::gelu_tanh(xa.x), pg8::gelu_tanh(xa.y), pg8::gelu_tanh(xa.z), pg8::gelu_tanh(xa.w)} * va;
                    const f32x4 ob = (f32x4){pg8::gelu_tanh(xb.x), pg8::gelu_tanh(xb.y), pg8::gelu_tanh(xb.z), pg8::gelu_tanh(xb.w)} * vb;
                    const u32x2 oa2 = PK4(oa), ob2 = PK4(ob);
                    *(u32x4*)(up + (size_t)rr * ULD + FF_) = (u32x4){oa2.x, oa2.y, ob2.x, ob2.y};
                    p2a = p1a; p2b = p1b; p1a = ca; p1b = cb4;
                }
            }
        }
        SEAM(pb + 1);
        if (IN(pb + 2)) REP(pb + 2) { PH_BEGIN run_gemm0(lds, U + FF_, (const bf16_t*)(ws + (l ? WS_DN1 : WS_DN0)), M_, 1024, FF_, ULD, MM, 1024); }
        SEAM(pb + 2);
        if (IN(pb + 3)) REP(pb + 3) { PH_BEGIN
            if (l == 0) norm_phase(X, MM, args.in[4], X, args.in[1] + 1024, H, gw, NGW, lane);
            else norm_phase(X, MM, args.in[4] + 1024, X, nullptr, nullptr, gw, NGW, lane);
        }
        if (l == 0) {
            SEAM(12);
            if (IN(13)) REP(13) { PH_BEGIN run_gemm0(lds, H, Wt_nsain, M_, ZLD1, 1024, 1024, Z, ZLD1); }
            SEAM(13);
            if (IN(14)) REP(14) { PH_BEGIN
                const int G2 = G >> 1, which = (int)blockIdx.x >= G2 ? 1 : 0;
                pg8::Gemm g{Z + 1024 + which * 256, which ? Wt_cw1v : Wt_cw1k, 16384, 256, 2048, 16 * ZLD1, (size_t)ZLD1 * 2, 1};
                pg8::StaticOrder S; S.init(16384, 256, G2, (int)blockIdx.x - which * G2);
                pg8::EpiStore<2> E{HID + (size_t)which * 16384 * 256, 256, cbias + which * 256};

#ifndef NO_GEMM2
if ((int)blockIdx.x < 2 * G2) pg8::gemm_phase<pg8::EpiStore<2>, pg8::StaticOrder, true, true>(lds, g, S, E);
#endif

            }
            SEAM(14);
            if (IN(15)) REP(15) { PH_BEGIN
                for (int wt = gw; wt < 2 * 512; wt += NGW) {
                    const int which = wt >> 9, row0 = (wt & 511) * 32, r32 = lane & 31, hi5 = lane >> 5;
                    const bf16_t* hp = HID + ((size_t)which * 16384 + row0 + r32) * 256 + hi5 * 8;
                    const bf16_t* wp = W2T + (size_t)which * 16384 + (size_t)r32 * 256 + hi5 * 8;
                    f32x16 c0, c1;
#pragma unroll
                    for (int r = 0; r < 16; ++r) { c0[r] = 0.f; c1[r] = 0.f; }
#pragma unroll 4
                    for (int ks = 0; ks < 16; ++ks) {
                        const bf16x8 av = *(const bf16x8*)(hp + ks * 16), b0 = *(const bf16x8*)(wp + ks * 16), b1 = *(const bf16x8*)(wp + 32 * 256 + ks * 16);
                        c0 = __builtin_amdgcn_mfma_f32_32x32x16_bf16(av, b0, c0, 0, 0, 0);
                        c1 = __builtin_amdgcn_mfma_f32_32x32x16_bf16(av, b1, c1, 0, 0, 0);
                    }
                    bf16_t* op = (which ? VC : KC) + (size_t)row0 * 64 + r32;
#pragma unroll
                    for (int r = 0; r < 16; ++r) { const int rw = crow(r, hi5); op[(size_t)rw * 64] = (bf16_t)(pk2(c0[r], 0.f) & 0xffffu); op[(size_t)rw * 64 + 32] = (bf16_t)(pk2(c1[r], 0.f) & 0xffffu); }
                }
            }
            SEAM(15);
            if (IN(16)) REP(16) { PH_BEGIN
#ifndef NO_NSA
for (int u = blockIdx.x; u < 64 * 64; u += G) nsa_unit(u, Z, KC, VC, O, lds, tid);
#endif
 }
            SEAM(16);
            if (IN(17)) REP(17) { PH_BEGIN run_gemm0(lds, O, Wt_nsaout, M_, 1024, 1024, 1024, MM, 1024); }
            SEAM(17);
            if (IN(18)) REP(18) { PH_BEGIN norm_phase(X, MM, args.in[2] + 1024, X, args.in[3] + 1024, H, gw, NGW, lane); }
            SEAM(18);
        }
    }
#undef IN
#undef SEAM
}

#undef XIN
#undef X
#undef H
#undef Z
#undef O
#undef L
#undef C
#undef U
#undef Y
extern "C" void kernel_launch(void* const* d_in, const int* in_sizes, int n_in, void* d_out, int out_size, void* d_ws, size_t ws_size, hipStream_t stream) {
    static int grid = 0;
    if (grid == 0) {
        if (n_in != 31 || out_size != M_ * DM || ws_size < WS_END) { fprintf(stderr, "kernel_launch: unexpected shapes (n_in %d out %d ws %zu)\n", n_in, out_size, ws_size); grid = -1; return; }
        int dev = 0, cus = 0, per_cu = 0;
        hipGetDevice(&dev); hipDeviceGetAttribute(&cus, hipDeviceAttributeMultiprocessorCount, dev);
        hipFuncSetAttribute((const void*)mega_fwd, hipFuncAttributeMaxDynamicSharedMemorySize, LDS_BYTES);
        hipOccupancyMaxActiveBlocksPerMultiprocessor(&per_cu, (const void*)mega_fwd, 512, LDS_BYTES);
        if (per_cu < 1) { fprintf(stderr, "kernel_launch: occupancy query says %d blocks/CU\n", per_cu); per_cu = 1; }
        (void)hipGetLastError();
        grid = cus * 1;
    }
    if (grid < 0) return;
    hipMemsetAsync(d_ws, 0, 16384, stream);
    Args a{};
    for (int i = 0; i < 31; ++i) a.in[i] = (const float*)d_in[i];
    a.out = (float*)d_out; a.ws = (unsigned char*)d_ws;
#if ONE_LAUNCH
    a.ph_lo = 0; a.ph_hi = NPHASE;
    void* kargs[] = {&a};
    hipError_t e = hipLaunchCooperativeKernel((const void*)mega_fwd, dim3(grid), dim3(512), kargs, LDS_BYTES, stream);
    if (e != hipSuccess) fprintf(stderr, "cooperative launch failed: %s (grid %d)\n", hipGetErrorString(e), grid);
#else
    for (int p = 0; p < NPHASE; ++p) { a.ph_lo = p; a.ph_hi = p + 1; hipLaunchKernelGGL(mega_fwd, dim3(grid), dim3(512), LDS_BYTES, stream, a); }
#endif
}
```

```cpp
#include <hip/hip_runtime.h>
#include <hip/hip_cooperative_groups.h>
#include <cstdio>
#include <cstdint>
namespace cg = cooperative_groups;

#ifndef ONE_LAUNCH
#define ONE_LAUNCH 1
#endif

namespace pg8 {
#define PG8_LAS __attribute__((address_space(3)))
typedef unsigned short bf16_t;
typedef short bf16x8 __attribute__((ext_vector_type(8)));
typedef float f32x4 __attribute__((ext_vector_type(4)));
typedef unsigned u32x4 __attribute__((ext_vector_type(4)));
constexpr int BM = 256, BK = 64, HALF = 128, HTB = HALF * BK * 2  , STAGE_BYTES = 8 * HTB, NXCD = 8, WGM = 8;

__host__ __device__ __forceinline__ int lds_byte(int r, int c) { const int st = (r >> 4) * 2 + (c >> 5), rr = r & 15, cc = c & 31, ob = rr * 64 + cc * 2; return st * 1024 + (ob ^ (((ob >> 9) & 1) << 5)); }
__host__ __device__ __forceinline__ void stage_rc(int b, int& R, int& C) { const int st = b / 1024, sb = b % 1024, swz = sb ^ (((sb >> 9) & 1) << 5); R = (st >> 1) * 16 + swz / 64; C = (st & 1) * 32 + (swz % 64) / 2; }
__host__ __device__ __forceinline__ int perm32(int rho) { const int n = rho >> 4, i = rho & 15; return 8 * (i >> 2) + 4 * n + (i & 3); }

struct Unit { int pm, pn; };
struct Gemm { const bf16_t* A; const bf16_t* Bt; int M, N, K; int lda; size_t a_kstep; int amode; };
__device__ __forceinline__ const char* a_base(const Gemm& g, int pm) { return g.amode == 0 ? (const char*)g.A + (size_t)pm * ((size_t)BM * g.lda * 2) : (const char*)g.A + (size_t)(pm >> 2) * ((size_t)4096 * 2816 * 2) + (size_t)(pm & 3) * 128; }

struct StaticOrder {
    int nM, nN, nwg, G, c;
    __host__ __device__ void init(int M, int N, int G_, int c_) { nM = M / BM; nN = N / BM; nwg = nM * nN; G = G_; c = c_; }
    __host__ __device__ bool next(int i, Unit& u) const {
        const long L = (long)i * G + c; if (L >= nwg) return false;
        int wgid = (int)L; { const int q = nwg / NXCD, r = nwg % NXCD, xcd = wgid % NXCD, off = wgid / NXCD; wgid = (xcd < r ? xcd * (q + 1) : r * (q + 1) + (xcd - r) * q) + off; }
        const int nig = WGM * nN, gid = wgid / nig, fm = gid * WGM, gsz = (nM - fm) < WGM ? (nM - fm) : WGM;
        u.pm = fm + ((wgid % nig) % gsz); u.pn = (wgid % nig) / gsz; return true;
    }
    __device__ __forceinline__ void a_ready(const Unit&) const {}
    __device__ __forceinline__ void done(const Unit&) const {}
};


__device__ __forceinline__ unsigned cvt_pk_bf16(float lo, float hi) { unsigned r; asm volatile("v_cvt_pk_bf16_f32 %0, %1, %2" : "=v"(r) : "v"(lo), "v"(hi)); return r; }
__device__ __forceinline__ float gelu_tanh(float x) { const float u = 1.5957691216f * (x + 0.044715f * x * x * x); return x / (1.0f + __expf(-u)); }
template <int ACT> struct EpiStore {
    static constexpr bool PERM = true, AFTER_DRAIN = false;
    bf16_t* O; int ldc; const float* bias; const float* rscale;
    __device__ __forceinline__ void operator()(const f32x4 (&acc)[2][2][4][2], const Unit& u, int wr, int wc, int fr, int fq) const {
        const int row0 = u.pm * BM + wr * 64 + fr; const int col0 = u.pn * BM + wc * 32 + 8 * fq;
        f32x4 bv[2][2];
#pragma unroll
        for (int bj = 0; bj < 2; ++bj)
#pragma unroll
            for (int n = 0; n < 2; ++n) bv[bj][n] = bias ? *(const f32x4*)(bias + col0 + bj * HALF + 4 * n) : (f32x4){0.f, 0.f, 0.f, 0.f};
#pragma unroll
        for (int ai = 0; ai < 2; ++ai)
#pragma unroll
            for (int m = 0; m < 4; ++m) { bf16_t* rowp = O + (size_t)(row0 + ai * HALF + m * 16) * ldc + col0; const float rsc = rscale ? rscale[row0 + ai * HALF + m * 16] : 1.f;
#pragma unroll
                for (int bj = 0; bj < 2; ++bj) { f32x4 v0 = acc[ai][bj][m][0] * rsc + bv[bj][0], v1 = acc[ai][bj][m][1] * rsc + bv[bj][1];
                    if (ACT == 2) { v0 = (f32x4){gelu_tanh(v0[0]), gelu_tanh(v0[1]), gelu_tanh(v0[2]), gelu_tanh(v0[3])}; v1 = (f32x4){gelu_tanh(v1[0]), gelu_tanh(v1[1]), gelu_tanh(v1[2]), gelu_tanh(v1[3])}; }
                    u32x4 w; w.x = cvt_pk_bf16(v0[0], v0[1]); w.y = cvt_pk_bf16(v0[2], v0[3]); w.z = cvt_pk_bf16(v1[0], v1[1]); w.w = cvt_pk_bf16(v1[2], v1[3]);
                    *(u32x4*)(rowp + bj * HALF) = w; } }
    }
};

template <class Epi, class Sched, bool ALIGN_EPI = false, bool SP2 = false>
__device__ __forceinline__ void gemm_phase(PG8_LAS unsigned char* lds, const Gemm g, const Sched& S, const Epi& E) {
    int tid = threadIdx.x; asm volatile("" : "+v"(tid)); const int wid = __builtin_amdgcn_readfirstlane(tid >> 6), lane = tid & 63, wr = wid >> 2, wc = wid & 3, fr = lane & 15, fq = lane >> 4;
    const int K = g.K, nt = K / BK;
    unsigned voffA[2], voffB[2];
#pragma unroll
    for (int i = 0; i < 2; ++i) { int R, C; stage_rc(tid * 16 + i * 8192, R, C); const int Rb = Epi::PERM ? ((R & ~31) + perm32(R & 31)) : R;
        voffA[i] = (unsigned)(R * g.lda + C) * 2u; voffB[i] = (unsigned)(Rb * K + C) * 2u; }
    const size_t kstep = (size_t)(BK * 2);
    const size_t hstepB = (size_t)HALF * K * 2, hstepA = (size_t)HALF * g.lda * 2, kstepA = g.a_kstep;
    const size_t tstep = 2 * hstepB;
    const unsigned ldsw = (unsigned)wid * 1024u;
    const int aoff = lds_byte(wr * 64 + fr, fq * 8), boff = lds_byte(wc * 32 + fr, fq * 8);
#define PG8_SA(b, h) (((b) * 2 + (h)) * HTB)
#define PG8_SB(b, h) ((4 + (b) * 2 + (h)) * HTB)
#define PG8_STAGE(bufoff, gbase, voff) do { _Pragma("unroll") for (int _i = 0; _i < 2; ++_i) \
        __builtin_amdgcn_global_load_lds((const unsigned*)((const char*)(gbase) + (voff)[_i]), (PG8_LAS unsigned*)(lds + (bufoff) + ldsw + _i * 8192), 16, 0, 0); } while (0)
#define PG8_LDA(dst, b, h) do { _Pragma("unroll") for (int m = 0; m < 4; ++m) _Pragma("unroll") for (int k = 0; k < 2; ++k) dst[m][k] = *(const PG8_LAS bf16x8*)(lds + PG8_SA(b, h) + aoff + m * 2048 + k * 1024); } while (0)
#define PG8_LDB(dst, b, h) do { _Pragma("unroll") for (int n = 0; n < 2; ++n) _Pragma("unroll") for (int k = 0; k < 2; ++k) dst[n][k] = *(const PG8_LAS bf16x8*)(lds + PG8_SB(b, h) + boff + n * 2048 + k * 1024); } while (0)
#define PG8_MMA(ai, bj, At, Bt) do { __builtin_amdgcn_s_setprio(1); _Pragma("unroll") for (int m = 0; m < 4; ++m) _Pragma("unroll") for (int n = 0; n < 2; ++n) _Pragma("unroll") for (int k = 0; k < 2; ++k) \
        acc[ai][bj][m][n] = __builtin_amdgcn_mfma_f32_16x16x32_bf16(Bt[n][k], At[m][k], acc[ai][bj][m][n], 0, 0, 0); __builtin_amdgcn_s_setprio(0); } while (0)
#define PG8_WAIT_V(n) asm volatile("s_waitcnt vmcnt(" #n ")" ::: "memory")
#define PG8_WAIT_L(n) asm volatile("s_waitcnt lgkmcnt(" #n ")" ::: "memory")
#define PG8_BAR __builtin_amdgcn_s_barrier()
#define PG8_SCHED __builtin_amdgcn_sched_barrier(0)
    Unit cur, nxt; int ui = 0;
    if (!S.next(0, cur)) return;
    f32x4 acc[2][2][4][2];
#pragma unroll
    for (int a = 0; a < 2; ++a)
#pragma unroll
        for (int b = 0; b < 2; ++b)
#pragma unroll
            for (int m = 0; m < 4; ++m)
#pragma unroll
                for (int n = 0; n < 2; ++n) acc[a][b][m][n] = (f32x4){0.f, 0.f, 0.f, 0.f};
    bf16x8 At[4][2], B0[2][2], B1[2][2];
    const char* cA = a_base(g, cur.pm); const char* cB = (const char*)g.Bt + (size_t)cur.pn * tstep;
    S.a_ready(cur);
    if constexpr (SP2) {
        PG8_STAGE(PG8_SB(0, 0), cB, voffB); PG8_STAGE(PG8_SB(0, 1), cB + hstepB, voffB); PG8_STAGE(PG8_SA(0, 0), cA, voffA); PG8_STAGE(PG8_SA(0, 1), cA + hstepA, voffA);
        if (wr == 1) PG8_BAR;
        PG8_WAIT_V(2); PG8_BAR;
        PG8_STAGE(PG8_SB(1, 0), cB + kstep, voffB); PG8_STAGE(PG8_SA(1, 0), cA + kstepA, voffA); PG8_STAGE(PG8_SB(1, 1), cB + hstepB + kstep, voffB);
        PG8_WAIT_V(6); PG8_BAR;
    } else {
        PG8_STAGE(PG8_SB(0, 0), cB, voffB); PG8_STAGE(PG8_SA(0, 0), cA, voffA); PG8_STAGE(PG8_SB(0, 1), cB + hstepB, voffB); PG8_STAGE(PG8_SA(0, 1), cA + hstepA, voffA);
        if (wr == 1) PG8_BAR;
        PG8_WAIT_V(4); PG8_BAR;
        PG8_STAGE(PG8_SB(1, 0), cB + kstep, voffB); PG8_STAGE(PG8_SA(1, 0), cA + kstepA, voffA); PG8_STAGE(PG8_SB(1, 1), cB + hstepB + kstep, voffB);
        PG8_WAIT_V(6); PG8_BAR;
    }
    for (;;) {
        const bool has_next = S.next(ui + 1, nxt);
        const char* nA = has_next ? a_base(g, nxt.pm) : cA; const char* nB = has_next ? (const char*)g.Bt + (size_t)nxt.pn * tstep : cB;
        for (int t = 0; t < nt; t += 2) {
            const bool last = (t == nt - 2);
            const char* a1 = cA + (size_t)(t + 1) * kstepA;
            const char* a2 = last ? nA : cA + (size_t)(t + 2) * kstepA; const char* b2 = last ? nB : cB + (size_t)(t + 2) * kstep;
            const char* a3 = a2 + kstepA; const char* b3 = b2 + kstep;
            if (last && has_next) S.a_ready(nxt);
            if constexpr (SP2) {
            PG8_LDB(B0, 0, 0); PG8_LDB(B1, 0, 1); PG8_SCHED; PG8_LDA(At, 0, 0); PG8_STAGE(PG8_SA(1, 1), a1 + hstepA, voffA);
            PG8_WAIT_V(8); PG8_WAIT_L(0); PG8_BAR; PG8_MMA(0, 0, At, B0); PG8_MMA(0, 1, At, B1); PG8_BAR; PG8_SCHED;
            PG8_LDA(At, 0, 1); PG8_STAGE(PG8_SB(0, 0), b2, voffB); PG8_STAGE(PG8_SB(0, 1), b2 + hstepB, voffB); PG8_STAGE(PG8_SA(0, 0), a2, voffA);
            PG8_WAIT_V(8); PG8_WAIT_L(0); PG8_BAR; PG8_MMA(1, 0, At, B0); PG8_MMA(1, 1, At, B1); PG8_BAR; PG8_SCHED;
            PG8_LDB(B0, 1, 0); PG8_LDB(B1, 1, 1); PG8_SCHED; PG8_LDA(At, 1, 0); PG8_STAGE(PG8_SA(0, 1), a2 + hstepA, voffA);
            PG8_WAIT_V(8); PG8_WAIT_L(0); PG8_BAR; PG8_MMA(0, 0, At, B0); PG8_MMA(0, 1, At, B1); PG8_BAR; PG8_SCHED;
            PG8_LDA(At, 1, 1); PG8_STAGE(PG8_SB(1, 0), b3, voffB); PG8_STAGE(PG8_SB(1, 1), b3 + hstepB, voffB); PG8_STAGE(PG8_SA(1, 0), a3, voffA);
            PG8_WAIT_V(8); PG8_WAIT_L(0); PG8_BAR; PG8_MMA(1, 0, At, B0); PG8_MMA(1, 1, At, B1); PG8_BAR; PG8_SCHED;
            } else {
            PG8_LDB(B0, 0, 0); PG8_SCHED; PG8_LDA(At, 0, 0); PG8_STAGE(PG8_SA(1, 1), a1 + hstepA, voffA);
            PG8_WAIT_L(8); PG8_BAR; PG8_WAIT_L(0); PG8_MMA(0, 0, At, B0); PG8_BAR; PG8_SCHED;
            PG8_LDB(B1, 0, 1); PG8_STAGE(PG8_SB(0, 0), b2, voffB);
            PG8_BAR; PG8_WAIT_L(0); PG8_MMA(0, 1, At, B1); PG8_BAR;
            PG8_LDA(At, 0, 1); PG8_STAGE(PG8_SA(0, 0), a2, voffA);
            PG8_BAR; PG8_WAIT_L(0); PG8_MMA(1, 0, At, B0); PG8_BAR; PG8_SCHED;
            PG8_STAGE(PG8_SB(0, 1), b2 + hstepB, voffB);
            PG8_WAIT_V(6); PG8_BAR; PG8_MMA(1, 1, At, B1); PG8_BAR;
            PG8_LDB(B0, 1, 0); PG8_SCHED; PG8_LDA(At, 1, 0); PG8_STAGE(PG8_SA(0, 1), a2 + hstepA, voffA);
            PG8_WAIT_L(8); PG8_BAR; PG8_WAIT_L(0); PG8_MMA(0, 0, At, B0); PG8_BAR; PG8_SCHED;
            PG8_LDB(B1, 1, 1); PG8_STAGE(PG8_SB(1, 0), b3, voffB);
            PG8_BAR; PG8_WAIT_L(0); PG8_MMA(0, 1, At, B1); PG8_BAR;
            PG8_LDA(At, 1, 1); PG8_STAGE(PG8_SA(1, 0), a3, voffA);
            PG8_BAR; PG8_WAIT_L(0); PG8_MMA(1, 0, At, B0); PG8_BAR; PG8_SCHED;
            PG8_STAGE(PG8_SB(1, 1), b3 + hstepB, voffB);
            PG8_WAIT_V(6); PG8_BAR; PG8_MMA(1, 1, At, B1); PG8_BAR;
            }
        }
        if constexpr (ALIGN_EPI) { if (wr == 0) PG8_BAR; }
        if constexpr (!Epi::AFTER_DRAIN) { E(acc, cur, wr, wc, fr, fq); S.done(cur); }
        if (!has_next) break;
#pragma unroll
        for (int a = 0; a < 2; ++a)
#pragma unroll
            for (int b = 0; b < 2; ++b)
#pragma unroll
                for (int m = 0; m < 4; ++m)
#pragma unroll
                    for (int n = 0; n < 2; ++n) acc[a][b][m][n] = (f32x4){0.f, 0.f, 0.f, 0.f};
        cur = nxt; cA = nA; cB = nB; ++ui;
        if constexpr (ALIGN_EPI) { if (wr == 1) PG8_BAR; }
    }
    PG8_WAIT_V(0);
    if constexpr (!ALIGN_EPI) { if (wr == 0) PG8_BAR; }
    PG8_BAR;
    if constexpr (Epi::AFTER_DRAIN) { E.fused(acc, cur, wr, wc, fr, fq, lds, wid, lane); S.done(cur); }
#undef PG8_SA
#undef PG8_SB
#undef PG8_STAGE
#undef PG8_LDA
#undef PG8_LDB
#undef PG8_MMA
#undef PG8_WAIT_V
#undef PG8_WAIT_L
#undef PG8_BAR
#undef PG8_SCHED
}
}


#define LAS __attribute__((address_space(3)))
typedef unsigned short bf16_t;
typedef short bf16x8 __attribute__((ext_vector_type(8)));
typedef short s16x4 __attribute__((ext_vector_type(4)));
typedef float f32x4 __attribute__((ext_vector_type(4)));
typedef float f32x2 __attribute__((ext_vector_type(2)));
typedef float f32x16 __attribute__((ext_vector_type(16)));
typedef unsigned u32x4 __attribute__((ext_vector_type(4)));
typedef unsigned u32x2 __attribute__((ext_vector_type(2)));

constexpr int T_ = 4096, NB_ = 16, M_ = NB_ * T_, DM = 1024;
constexpr int ZLD0 = 2560, ZLD1 = 2816, FF_ = 2816, ULD = 5632, LLD = 1536;
constexpr float NORM_EPS = 1e-6f, GN_EPS = 64e-5f;
constexpr size_t MiB = (size_t)1 << 20;
constexpr size_t WS_HYIN = 1 * MiB, WS_HYOUT = 6 * MiB, WS_NSAIN = 8 * MiB, WS_NSAOUT = 14 * MiB, WS_UP0 = 16 * MiB, WS_UP1 = 27 * MiB,
                 WS_DN0 = 38 * MiB, WS_DN1 = 44 * MiB, WS_LORA = 50 * MiB, WS_CW1K = 51 * MiB, WS_CW1V = 52 * MiB, WS_CBIAS = 53 * MiB;
constexpr size_t WS_H = 64 * MiB, WS_Z = 192 * MiB, WS_AP = 512 * MiB, WS_O = 544 * MiB, WS_L = 672 * MiB, WS_C = 864 * MiB, WS_MM = 896 * MiB;
constexpr size_t WS_HID = 672 * MiB, WS_KCMP = 688 * MiB, WS_VCMP = 690 * MiB, WS_U = 192 * MiB, WS_END = 1024 * MiB;
constexpr int LDS_BYTES = 147456;
constexpr int NPHASE = 23;

__device__ __forceinline__ float bf2f(unsigned u) { return __uint_as_float(u << 16); }
__device__ __forceinline__ unsigned pk2(float lo, float hi) { return pg8::cvt_pk_bf16(lo, hi); }
__device__ __forceinline__ float wave_sum(float v) {
#pragma unroll
    for (int o = 1; o < 64; o <<= 1) v += __shfl_xor(v, o);
    return v;
}
__device__ __forceinline__ float sigmoidf_(float x) { return 1.0f / (1.0f + __expf(-x)); }
#define LDS_WAIT() asm volatile("s_waitcnt lgkmcnt(0)" ::: "memory")

struct Args { const float* in[31]; float* out; unsigned char* ws; int ph_lo, ph_hi; };

__device__ __forceinline__ void transpose_item(const float* W, int N, bf16_t* WT, int ldt, LAS float* scr, int item, int nblk, int lane, const float* gk = nullptr) {
    const int kb = item / nblk, nb = item % nblk, k0 = 64 * kb, n0 = 32 * nb;
    const int n = n0 + (lane & 31);
#pragma unroll 8
    for (int i = 0; i < 32; ++i) { const int kk = 2 * i + (lane >> 5); scr[kk * 33 + (lane & 31)] = (n < N) ? W[(size_t)(k0 + kk) * N + n] * (gk ? gk[k0 + kk] : 1.f) : 0.f; }
    LDS_WAIT(); asm volatile("" ::: "memory");
    const int c = lane & 7;
#pragma unroll
    for (int j = 0; j < 4; ++j) { const int nn = (lane >> 3) + 8 * j; const LAS float* s = scr + (8 * c) * 33 + nn;
        u32x4 o; o.x = pk2(s[0 * 33], s[1 * 33]); o.y = pk2(s[2 * 33], s[3 * 33]); o.z = pk2(s[4 * 33], s[5 * 33]); o.w = pk2(s[6 * 33], s[7 * 33]);
        *(u32x4*)(WT + (size_t)(n0 + nn) * ldt + k0 + 8 * c) = o; }
    LDS_WAIT(); asm volatile("" ::: "memory");
}

__device__ __forceinline__ void norm_phase(const float* xf, const bf16_t* xb, const bf16_t* mm, const float* gpost, float* outf, bf16_t* outb, float* rs_out, int gw, int NGW, int lane) {
    for (int m = gw; m < M_; m += NGW) {
        f32x4 v[4];
        if (xf) { const f32x4* xr = (const f32x4*)(xf + (size_t)m * DM) + lane;
#pragma unroll
            for (int j = 0; j < 4; ++j) v[j] = xr[64 * j]; }
        else { const u32x2* xr = (const u32x2*)(xb + (size_t)m * DM) + lane;
#pragma unroll
            for (int j = 0; j < 4; ++j) { const u32x2 w = xr[64 * j]; v[j] = (f32x4){bf2f(w.x & 0xffffu), bf2f(w.x >> 16), bf2f(w.y & 0xffffu), bf2f(w.y >> 16)}; } }
        if (mm) {
            const u32x2* mr = (const u32x2*)(mm + (size_t)m * DM) + lane;
            f32x4 q[4]; float ss = 0.f;
#pragma unroll
            for (int j = 0; j < 4; ++j) { const u32x2 w = mr[64 * j]; q[j] = (f32x4){bf2f(w.x & 0xffffu), bf2f(w.x >> 16), bf2f(w.y & 0xffffu), bf2f(w.y >> 16)};
                ss += (q[j].x * q[j].x + q[j].y * q[j].y) + (q[j].z * q[j].z + q[j].w * q[j].w); }
            const float rs = rsqrtf(wave_sum(ss) * (1.f / DM) + NORM_EPS);
#pragma unroll
            for (int j = 0; j < 4; ++j) { const f32x4 g = *((const f32x4*)gpost + lane + 64 * j); v[j] = v[j] + q[j] * rs * g; }
        }
        if (outf) { f32x4* xo = (f32x4*)(outf + (size_t)m * DM) + lane;
#pragma unroll
            for (int j = 0; j < 4; ++j) xo[64 * j] = v[j]; }
        if (outb) { u32x2* xo = (u32x2*)(outb + (size_t)m * DM) + lane;
#pragma unroll
            for (int j = 0; j < 4; ++j) { u32x2 w; w.x = pk2(v[j].x, v[j].y); w.y = pk2(v[j].z, v[j].w); xo[64 * j] = w; } }
        if (rs_out) {
            float s2 = 0.f;
#pragma unroll
            for (int j = 0; j < 4; ++j) s2 += (v[j].x * v[j].x + v[j].y * v[j].y) + (v[j].z * v[j].z + v[j].w * v[j].w);
            const float rs2 = rsqrtf(wave_sum(s2) * (1.f / DM) + NORM_EPS);
            if (lane == 0) rs_out[m] = rs2;
        }
    }
}

constexpr int KROW = 144, VROW = 152, KT_BYTES = 64 * KROW, VT_BYTES = 64 * VROW;
constexpr float NEGBIG = -1e30f;
__device__ __forceinline__ int crow(int r, int hi) { return (r & 3) + 8 * (r >> 2) + 4 * hi; }
struct TileRegs { u32x4 k, v; };
__device__ __forceinline__ void tile_gload(TileRegs& r, const bf16_t* Kg, const bf16_t* Vg, size_t ld, int tid) {
    r.k = *(const u32x4*)(Kg + (size_t)(tid >> 3) * ld + (tid & 7) * 8);
    r.v = *(const u32x4*)(Vg + (size_t)(tid & 63) * ld + (tid >> 6) * 8);
}
__device__ __forceinline__ void tile_lstore(const TileRegs& r, LAS unsigned char* Ks, LAS unsigned char* Vs, int tid) {
    *(LAS u32x4*)(Ks + (tid >> 3) * KROW + (tid & 7) * 16) = r.k;
    LAS unsigned char* vb = Vs + ((tid >> 6) * 8) * VROW + (tid & 63) * 2;
    *(LAS unsigned short*)(vb + 0 * VROW) = (unsigned short)(r.v.x & 0xffffu); *(LAS unsigned short*)(vb + 1 * VROW) = (unsigned short)(r.v.x >> 16);
    *(LAS unsigned short*)(vb + 2 * VROW) = (unsigned short)(r.v.y & 0xffffu); *(LAS unsigned short*)(vb + 3 * VROW) = (unsigned short)(r.v.y >> 16);
    *(LAS unsigned short*)(vb + 4 * VROW) = (unsigned short)(r.v.z & 0xffffu); *(LAS unsigned short*)(vb + 5 * VROW) = (unsigned short)(r.v.z >> 16);
    *(LAS unsigned short*)(vb + 6 * VROW) = (unsigned short)(r.v.w & 0xffffu); *(LAS unsigned short*)(vb + 7 * VROW) = (unsigned short)(r.v.w >> 16);
}
__device__ __forceinline__ void load_qfrag(bf16x8 (&qf)[4], const bf16_t* qrow, int hi) {
#pragma unroll
    for (int d0 = 0; d0 < 4; ++d0) { const u32x4 w = *(const u32x4*)(qrow + d0 * 16 + hi * 8);
        u32x4 o; o.x = pk2(bf2f(w.x & 0xffffu) * 0.125f, bf2f(w.x >> 16) * 0.125f); o.y = pk2(bf2f(w.y & 0xffffu) * 0.125f, bf2f(w.y >> 16) * 0.125f);
        o.z = pk2(bf2f(w.z & 0xffffu) * 0.125f, bf2f(w.z >> 16) * 0.125f); o.w = pk2(bf2f(w.w & 0xffffu) * 0.125f, bf2f(w.w >> 16) * 0.125f);
        qf[d0] = __builtin_bit_cast(bf16x8, o); }
}
__device__ __forceinline__ void tile_scores(f32x16& s0, f32x16& s1, const LAS unsigned char* Ks, const bf16x8 (&qf)[4], int r32, int hi) {
#pragma unroll
    for (int r = 0; r < 16; ++r) { s0[r] = 0.f; s1[r] = 0.f; }
#pragma unroll
    for (int d0 = 0; d0 < 4; ++d0) {
        const bf16x8 k0 = *(const LAS bf16x8*)(Ks + r32 * KROW + (d0 * 16 + hi * 8) * 2);
        const bf16x8 k1 = *(const LAS bf16x8*)(Ks + (32 + r32) * KROW + (d0 * 16 + hi * 8) * 2);
        s0 = __builtin_amdgcn_mfma_f32_32x32x16_bf16(k0, qf[d0], s0, 0, 0, 0);
        s1 = __builtin_amdgcn_mfma_f32_32x32x16_bf16(k1, qf[d0], s1, 0, 0, 0);
    }
}
__device__ __forceinline__ void tile_softmax_pv(f32x16& s0, f32x16& s1, const LAS unsigned char* Vs, f32x16 (&o)[2], float& m, float& l, int r32, int hi) {
    float mt = NEGBIG;
#pragma unroll
    for (int r = 0; r < 16; ++r) mt = fmaxf(mt, fmaxf(s0[r], s1[r]));
    mt = fmaxf(mt, __shfl_xor(mt, 32));
    const float mn = fmaxf(m, mt), alpha = __expf(m - mn); m = mn;
    float ps = 0.f;
#pragma unroll
    for (int r = 0; r < 16; ++r) { s0[r] = __expf(s0[r] - mn); s1[r] = __expf(s1[r] - mn); ps += s0[r] + s1[r]; }
    l = l * alpha + ps;
#pragma unroll
    for (int r = 0; r < 16; ++r) { o[0][r] *= alpha; o[1][r] *= alpha; }
    bf16x8 pb[4];
    { u32x4 w; w.x = pk2(s0[0], s0[1]); w.y = pk2(s0[2], s0[3]); w.z = pk2(s0[4], s0[5]); w.w = pk2(s0[6], s0[7]); pb[0] = __builtin_bit_cast(bf16x8, w); }
    { u32x4 w; w.x = pk2(s0[8], s0[9]); w.y = pk2(s0[10], s0[11]); w.z = pk2(s0[12], s0[13]); w.w = pk2(s0[14], s0[15]); pb[1] = __builtin_bit_cast(bf16x8, w); }
    { u32x4 w; w.x = pk2(s1[0], s1[1]); w.y = pk2(s1[2], s1[3]); w.z = pk2(s1[4], s1[5]); w.w = pk2(s1[6], s1[7]); pb[2] = __builtin_bit_cast(bf16x8, w); }
    { u32x4 w; w.x = pk2(s1[8], s1[9]); w.y = pk2(s1[10], s1[11]); w.z = pk2(s1[12], s1[13]); w.w = pk2(s1[14], s1[15]); pb[3] = __builtin_bit_cast(bf16x8, w); }
#pragma unroll
    for (int dh = 0; dh < 2; ++dh)
#pragma unroll
        for (int ks = 0; ks < 4; ++ks) {
            const LAS unsigned char* vp = Vs + (dh * 32 + r32) * VROW + (16 * ks + 4 * hi) * 2;
            const u32x2 lo = *(const LAS u32x2*)vp, hh = *(const LAS u32x2*)(vp + 16);
            const u32x4 a4 = (u32x4){lo.x, lo.y, hh.x, hh.y};
            o[dh] = __builtin_amdgcn_mfma_f32_32x32x16_bf16(__builtin_bit_cast(bf16x8, a4), pb[ks], o[dh], 0, 0, 0);
        }
}
__device__ __forceinline__ void store_o(const f32x16 (&o)[2], bf16_t* orow, int hi) {
#pragma unroll
    for (int dh = 0; dh < 2; ++dh)
#pragma unroll
        for (int r4 = 0; r4 < 4; ++r4) { u32x2 w; w.x = pk2(o[dh][4 * r4], o[dh][4 * r4 + 1]); w.y = pk2(o[dh][4 * r4 + 2], o[dh][4 * r4 + 3]);
            *(u32x2*)(orow + dh * 32 + 8 * r4 + 4 * hi) = w; }
}

__device__ __forceinline__ void swa_unit(int u, const bf16_t* Z, bf16_t* O, const float* sinks, LAS unsigned char* lds, int tid) {
    const int g = u & 1, sb = (u >> 1) & 63, b = u >> 7;
    const int lane = tid & 63, w = tid >> 6, r32 = lane & 31, hi = lane >> 5;
    const int h = g * 4 + (w >> 1), t0 = sb * 64, t = t0 + (w & 1) * 32 + r32;
    const size_t mrow = (size_t)b * T_ + t;
    LAS unsigned char* Ks = lds; LAS unsigned char* Vs = lds + KT_BYTES;
    bf16x8 qf[4]; load_qfrag(qf, Z + mrow * ZLD0 + h * 64, hi);
    const float slope = exp2f(-(float)(h + 1));
    float m = sinks[h], l = hi == 0 ? 1.f : 0.f;
    f32x16 o[2];
#pragma unroll
    for (int r = 0; r < 16; ++r) { o[0][r] = 0.f; o[1][r] = 0.f; }
    const int first = sb >= 2 ? 0 : 2 - sb;
    TileRegs tr;
    { const int kp0 = t0 - 128 + 64 * first; const bf16_t* base = Z + ((size_t)b * T_ + kp0) * ZLD0; tile_gload(tr, base + 512 + g * 64, base + 640 + g * 64, ZLD0, tid); }
    for (int ti = first; ti < 3; ++ti) {
        const int kp0 = t0 - 128 + 64 * ti;
        __syncthreads(); tile_lstore(tr, Ks, Vs, tid); __syncthreads();
        if (ti + 1 < 3) { const bf16_t* base = Z + ((size_t)b * T_ + kp0 + 64) * ZLD0; tile_gload(tr, base + 512 + g * 64, base + 640 + g * 64, ZLD0, tid); }
        f32x16 s0, s1; tile_scores(s0, s1, Ks, qf, r32, hi);
#pragma unroll
        for (int r = 0; r < 16; ++r) {
            const int d0 = t - (kp0 + crow(r, hi)), d1 = d0 - 32;
            s0[r] = (d0 >= 0 && d0 < 128) ? s0[r] - slope * (float)d0 : NEGBIG;
            s1[r] = (d1 >= 0 && d1 < 128) ? s1[r] - slope * (float)d1 : NEGBIG;
        }
        tile_softmax_pv(s0, s1, Vs, o, m, l, r32, hi);
    }
    l += __shfl_xor(l, 32);
    const float inv = 1.f / l;
#pragma unroll
    for (int r = 0; r < 16; ++r) { o[0][r] *= inv; o[1][r] *= inv; }
    store_o(o, O + mrow * DM + h * 64, hi);
}

constexpr int IMP_OFF = 19456, IMP_LD = 257, SELM_OFF = IMP_OFF + 64 * IMP_LD * 4  , UNI_OFF = SELM_OFF + 512;
__device__ __forceinline__ void nsa_unit(int u, const bf16_t* Z, const bf16_t* KC, const bf16_t* VC, bf16_t* O, LAS unsigned char* lds, int tid) {
    const int bg = u & 63, i = u >> 6, g = bg & 3, b = bg >> 2;
    const int lane = tid & 63, w = tid >> 6, r32 = lane & 31, hi = lane >> 5;
    const int hr = w >> 1, h = g * 4 + hr, t0 = i * 64, ql = (w & 1) * 32 + r32, t = t0 + ql;
    const size_t mrow = (size_t)b * T_ + t;
    LAS unsigned char* Ks = lds; LAS unsigned char* Vs = lds + KT_BYTES;
    LAS float* imp = (LAS float*)(lds + IMP_OFF);
    LAS unsigned* selm = (LAS unsigned*)(lds + SELM_OFF); LAS unsigned* uni = (LAS unsigned*)(lds + UNI_OFF);
    bf16x8 qf[4]; load_qfrag(qf, Z + mrow * ZLD1 + h * 64, hi);
    const float slope = exp2f(-0.5f * (float)(h + 1));
    const bf16_t* gatep = Z + mrow * ZLD1 + 2560 + h * 3;
    LAS float* park = (LAS float*)(lds + IMP_OFF) + tid;
    f32x16 o[2]; float m, l; TileRegs tr;
    const size_t cbase = ((size_t)(b * 4 + g) * 256) * 64;
    const int ncv = min(4 * i + 3, 255), nct = (ncv + 63) >> 6;
    m = NEGBIG; l = 0.f;
#pragma unroll
    for (int r = 0; r < 16; ++r) { o[0][r] = 0.f; o[1][r] = 0.f; }
    tile_gload(tr, KC + cbase, VC + cbase, 64, tid);
    for (int ti = 0; ti < nct; ++ti) {
        __syncthreads(); tile_lstore(tr, Ks, Vs, tid); __syncthreads();
        if (ti + 1 < nct) tile_gload(tr, KC + cbase + (size_t)(ti + 1) * 4096, VC + cbase + (size_t)(ti + 1) * 4096, 64, tid);
        f32x16 s0, s1; tile_scores(s0, s1, Ks, qf, r32, hi);
#pragma unroll
        for (int r = 0; r < 16; ++r) {
            const int d0 = t - (16 * (ti * 64 + crow(r, hi)) + 31), d1 = d0 - 512;
            s0[r] = d0 >= 0 ? s0[r] - slope * (float)d0 : NEGBIG;
            s1[r] = d1 >= 0 ? s1[r] - slope * (float)d1 : NEGBIG;
        }
        tile_softmax_pv(s0, s1, Vs, o, m, l, r32, hi);
    }
    l += __shfl_xor(l, 32);
    const bool rowok = t >= 31;
    const float invc = rowok ? 1.f / l : 0.f;
    { const float wg = sigmoidf_(bf2f(gatep[0])) * invc;
#pragma unroll
      for (int r = 0; r < 16; ++r) { o[0][r] *= wg; o[1][r] *= wg; } }
    if (i > 7) {
        const float mc = m;
        tile_gload(tr, KC + cbase, VC + cbase, 64, tid);
        for (int ti = 0; ti < nct; ++ti) {
            __syncthreads(); tile_lstore(tr, Ks, Vs, tid); __syncthreads();
            if (ti + 1 < nct) tile_gload(tr, KC + cbase + (size_t)(ti + 1) * 4096, VC + cbase + (size_t)(ti + 1) * 4096, 64, tid);
            f32x16 s0, s1; tile_scores(s0, s1, Ks, qf, r32, hi);
#pragma unroll
            for (int r = 0; r < 16; ++r) {
                const int d0 = t - (16 * (ti * 64 + crow(r, hi)) + 31), d1 = d0 - 512;
                s0[r] = d0 >= 0 ? __expf(s0[r] - slope * (float)d0 - mc) * invc : 0.f;
                s1[r] = d1 >= 0 ? __expf(s1[r] - slope * (float)d1 - mc) * invc : 0.f;
            }
            LAS float* ip = imp + ql * IMP_LD + ti * 64;
#pragma unroll
            for (int rr = 0; rr < 4; ++rr) {
                if (hr == rr) {
#pragma unroll
                    for (int r = 0; r < 16; ++r) { const int c = crow(r, hi);
                        if (rr == 0) { ip[c] = s0[r]; ip[32 + c] = s1[r]; } else { ip[c] += s0[r]; ip[32 + c] += s1[r]; } }
                }
                __syncthreads();
            }
        }
    }
    if (tid == 0) { uni[0] = 0u; uni[1] = 0u; }
    __syncthreads();
    if (tid < 64) {
        unsigned long long mask;
        if (i <= 7) mask = (2ull << i) - 1ull;
        else {
            float v0 = -1.f, v1 = -1.f, v2 = -1.f, v3 = -1.f, v4 = -1.f; int j0 = 0, j1 = 0, j2 = 0, j3 = 0, j4 = 0;
            const LAS float* ip = imp + tid * IMP_LD;
            for (int j = 1; j <= i - 2; ++j) {
                float v = ip[4 * j - 1] + 2.f * (ip[4 * j] + ip[4 * j + 1] + ip[4 * j + 2]) + ip[4 * j + 3]; int jj = j;
#define INS(vk, jk) if (v > vk) { const float tv = vk; const int tj = jk; vk = v; jk = jj; v = tv; jj = tj; }
                INS(v0, j0) INS(v1, j1) INS(v2, j2) INS(v3, j3) INS(v4, j4)
#undef INS
            }
            mask = 1ull | (1ull << i) | (1ull << (i - 1)) | (1ull << j0) | (1ull << j1) | (1ull << j2) | (1ull << j3) | (1ull << j4);
        }
        selm[2 * tid] = (unsigned)mask; selm[2 * tid + 1] = (unsigned)(mask >> 32);
        atomicOr((unsigned*)(uni), (unsigned)mask); atomicOr((unsigned*)(uni + 1), (unsigned)(mask >> 32));
    }
    __syncthreads();
#pragma unroll
    for (int r = 0; r < 16; ++r) { park[r * 512] = o[0][r]; park[(16 + r) * 512] = o[1][r]; }
    {
        unsigned long long um = (unsigned long long)uni[0] | ((unsigned long long)uni[1] << 32);
        const unsigned long long mym = (unsigned long long)selm[2 * ql] | ((unsigned long long)selm[2 * ql + 1] << 32);
        m = NEGBIG; l = 0.f;
#pragma unroll
        for (int r = 0; r < 16; ++r) { o[0][r] = 0.f; o[1][r] = 0.f; }
        int j = __builtin_ctzll(um); um &= um - 1;
        { const bf16_t* base = Z + ((size_t)b * T_ + 64 * j) * ZLD1; tile_gload(tr, base + 1536 + g * 64, base + 1792 + g * 64, ZLD1, tid); }
        for (;;) {
            __syncthreads(); tile_lstore(tr, Ks, Vs, tid); __syncthreads();
            const int jn = um ? __builtin_ctzll(um) : -1; um &= um - 1;
            if (jn >= 0) { const bf16_t* base = Z + ((size_t)b * T_ + 64 * jn) * ZLD1; tile_gload(tr, base + 1536 + g * 64, base + 1792 + g * 64, ZLD1, tid); }
            f32x16 s0, s1; tile_scores(s0, s1, Ks, qf, r32, hi);
            const bool sel = (mym >> j) & 1ull;
#pragma unroll
            for (int r = 0; r < 16; ++r) {
                const int d0 = t - (64 * j + crow(r, hi)), d1 = d0 - 32;
                s0[r] = (sel && d0 >= 0) ? s0[r] - slope * (float)d0 : NEGBIG;
                s1[r] = (sel && d1 >= 0) ? s1[r] - slope * (float)d1 : NEGBIG;
            }
            tile_softmax_pv(s0, s1, Vs, o, m, l, r32, hi);
            if (jn < 0) break;
            j = jn;
        }
        l += __shfl_xor(l, 32);
        const float wg = sigmoidf_(bf2f(gatep[1])) / l;
#pragma unroll
        for (int r = 0; r < 16; ++r) { park[r * 512] += wg * o[0][r]; park[(16 + r) * 512] += wg * o[1][r]; }
    }
    {
        m = NEGBIG; l = 0.f;
#pragma unroll
        for (int r = 0; r < 16; ++r) { o[0][r] = 0.f; o[1][r] = 0.f; }
        const int first = i >= 4 ? 0 : 4 - i;
        { const int kp0 = t0 - 256 + 64 * first; const bf16_t* base = Z + ((size_t)b * T_ + kp0) * ZLD1; tile_gload(tr, base + 2048 + g * 64, base + 2304 + g * 64, ZLD1, tid); }
        for (int ti = first; ti < 5; ++ti) {
            const int kp0 = t0 - 256 + 64 * ti;
            __syncthreads(); tile_lstore(tr, Ks, Vs, tid); __syncthreads();
            if (ti + 1 < 5) { const bf16_t* base = Z + ((size_t)b * T_ + kp0 + 64) * ZLD1; tile_gload(tr, base + 2048 + g * 64, base + 2304 + g * 64, ZLD1, tid); }
            f32x16 s0, s1; tile_scores(s0, s1, Ks, qf, r32, hi);
#pragma unroll
            for (int r = 0; r < 16; ++r) {
                const int d0 = t - (kp0 + crow(r, hi)), d1 = d0 - 32;
                s0[r] = (d0 >= 0 && d0 < 256) ? s0[r] - slope * (float)d0 : NEGBIG;
                s1[r] = (d1 >= 0 && d1 < 256) ? s1[r] - slope * (float)d1 : NEGBIG;
            }
            tile_softmax_pv(s0, s1, Vs, o, m, l, r32, hi);
        }
        l += __shfl_xor(l, 32);
        const float wg = sigmoidf_(bf2f(gatep[2])) / l;
#pragma unroll
        for (int r = 0; r < 16; ++r) { o[0][r] = park[r * 512] + wg * o[0][r]; o[1][r] = park[(16 + r) * 512] + wg * o[1][r]; }
    }
    store_o(o, O + mrow * DM + h * 64, hi);
    __syncthreads();
}

__device__ __forceinline__ float dpp_xadd(float x, int which) {
    int r;
    const int xi = __float_as_int(x);
    if (which == 0) r = __builtin_amdgcn_update_dpp(0, xi, 0xB1, 0xf, 0xf, false);
    else if (which == 1) r = __builtin_amdgcn_update_dpp(0, xi, 0x4E, 0xf, 0xf, false);
    else if (which == 2) r = __builtin_amdgcn_update_dpp(0, xi, 0x141, 0xf, 0xf, false);
    else r = __builtin_amdgcn_update_dpp(0, xi, 0x140, 0xf, 0xf, false);
    return x + __int_as_float(r);
}
__device__ __forceinline__ float row16_sum(float x) { x = dpp_xadd(x, 0); x = dpp_xadd(x, 1); x = dpp_xadd(x, 2); x = dpp_xadd(x, 3); return x; }

#define UNPK4(w) (f32x4){bf2f((w).x & 0xffffu), bf2f((w).x >> 16), bf2f((w).y & 0xffffu), bf2f((w).y >> 16)}
#define PK4(v) (u32x2){pk2((v).x, (v).y), pk2((v).z, (v).w)}
__device__ __forceinline__ f32x4 sig4(f32x4 v) { return (f32x4){sigmoidf_(v.x), sigmoidf_(v.y), sigmoidf_(v.z), sigmoidf_(v.w)}; }
__device__ __forceinline__ void rwkv_prep(const Args& a, const bf16_t* Z, const bf16_t* L, bf16_t* KK, bf16_t* WR, bf16_t* WE, bf16_t* KKA, bf16_t* KT, bf16_t* VS, float* C, int gw, int NGW, int lane) {
    const int h = gw & 7, col = h * 64 + (lane & 15) * 4, q = lane >> 4;
    const f32x4 mu_r = *(const f32x4*)(a.in[8] + col), mu_k = *(const f32x4*)(a.in[8] + 512 + col), mu_v = *(const f32x4*)(a.in[8] + 1024 + col);
    const f32x4 w0 = *(const f32x4*)(a.in[9] + col), a0 = *(const f32x4*)(a.in[11] + col), k_k = *(const f32x4*)(a.in[14] + col), k_a = *(const f32x4*)(a.in[15] + col), r_k = *(const f32x4*)(a.in[16] + col);
    for (int m4 = gw >> 3; m4 < M_ / 4; m4 += NGW >> 3) {
        const int m = m4 * 4 + q;
        const bf16_t* zr = Z + (size_t)m * ZLD0 + 768 + col;
        f32x4 r = UNPK4(*(const u32x2*)zr), k = UNPK4(*(const u32x2*)(zr + 512)), v = UNPK4(*(const u32x2*)(zr + 1024));
        f32x4 rp = (f32x4){0.f, 0.f, 0.f, 0.f}, kp = rp, vp = rp;
        if ((m & (T_ - 1)) != 0) { rp = UNPK4(*(const u32x2*)(zr - ZLD0)); kp = UNPK4(*(const u32x2*)(zr + 512 - ZLD0)); vp = UNPK4(*(const u32x2*)(zr + 1024 - ZLD0)); }
        r += (rp - r) * mu_r; k += (kp - k) * mu_k; v += (vp - v) * mu_v;
        const f32x4 lw = UNPK4(*(const u32x2*)(L + (size_t)m * LLD + col)), la = UNPK4(*(const u32x2*)(L + (size_t)m * LLD + 512 + col));
        const f32x4 e = sig4(w0 + lw) * 0.60653065971f;
        const u32x2 eb = PK4(e);
        const f32x4 er = UNPK4(eb);
        const f32x4 wdec = (f32x4){__expf(-er.x), __expf(-er.y), __expf(-er.z), __expf(-er.w)};
        const f32x4 av = sig4(a0 + la);
        f32x4 kk = k * k_k;
        const float nrm = sqrtf(row16_sum((kk.x * kk.x + kk.y * kk.y) + (kk.z * kk.z + kk.w * kk.w)));
        kk = kk * (1.f / fmaxf(nrm, 1e-12f));
        const f32x4 kt = k * (1.f + (av - 1.f) * k_a);
        const f32x4 kka = kk * av;
        const f32x4 t1 = kka * r, t2 = kt * r, t3 = t2 * r_k;
        const float c1 = row16_sum((t1.x + t1.y) + (t1.z + t1.w)), c2 = row16_sum((t2.x + t2.y) + (t2.z + t2.w)), c3 = row16_sum((t3.x + t3.y) + (t3.z + t3.w));
        const size_t o = (size_t)m * 512 + col;
        const f32x4 wr = wdec * r;
        *(u32x2*)(KK + o) = PK4(kk); *(u32x2*)(WR + o) = PK4(wr); *(u32x2*)(WE + o) = eb;
        *(u32x2*)(KKA + o) = PK4(kka); *(u32x2*)(KT + o) = PK4(kt); *(u32x2*)(VS + o) = PK4(v);
        if ((lane & 15) == 0) *(f32x4*)(C + (size_t)m * 32 + h * 4) = (f32x4){c1, c2, c3, 0.f};
    }
}

constexpr int SC_TS = 32, SC_BUF = 5 * SC_TS * 64 + SC_TS * 32 + SC_TS * 2;
__device__ __forceinline__ void scan_unit(int u, const bf16_t* KK, const bf16_t* WR, const bf16_t* WE, const bf16_t* KKA, const bf16_t* KT, const bf16_t* VS, const float* C, float* Y, LAS unsigned char* lds, int tid) {
    const int half = u & 1, h = (u >> 1) & 7, b = u >> 4;
    const int il = tid >> 4, jg = tid & 15;
    LAS float* buf0 = (LAS float*)lds; LAS float* buf1 = buf0 + SC_BUF; LAS float* ybuf = buf1 + SC_BUF;
    float S0 = 0.f, S1 = 0.f, S2 = 0.f, S3 = 0.f;
    const size_t rowbase = (size_t)b * T_;
    const size_t goff = (rowbase + il) * 512 + h * 64 + jg * 4;
    const size_t voff = (rowbase + il) * 512 + h * 64 + half * 32 + jg * 2;
    u32x2 rkk, rwr, rwe, rkka, rkt; unsigned rv; f32x2 rc;
#define SC_GLOAD(t0) do { const size_t d_ = (size_t)(t0) * 512; rkk = *(const u32x2*)(KK + goff + d_); rwr = *(const u32x2*)(WR + goff + d_); rwe = *(const u32x2*)(WE + goff + d_); \
        rkka = *(const u32x2*)(KKA + goff + d_); rkt = *(const u32x2*)(KT + goff + d_); rv = *(const unsigned*)(VS + voff + d_); \
        if (tid < SC_TS) rc = *(const f32x2*)(C + (rowbase + (t0) + tid) * 32 + h * 4); } while (0)
#define SC_EXP4(w) (f32x4){bf2f((w).x & 0xffffu), bf2f((w).x >> 16), bf2f((w).y & 0xffffu), bf2f((w).y >> 16)}
#define SC_LSTORE(bf) do { LAS float* p_ = (bf) + il * 64 + jg * 4; *(LAS f32x4*)(p_) = SC_EXP4(rkk); *(LAS f32x4*)(p_ + 2048) = SC_EXP4(rwr); \
        { f32x4 e_ = SC_EXP4(rwe); *(LAS f32x4*)(p_ + 4096) = (f32x4){__expf(-e_.x), __expf(-e_.y), __expf(-e_.z), __expf(-e_.w)}; } \
        *(LAS f32x4*)(p_ + 6144) = SC_EXP4(rkka); *(LAS f32x4*)(p_ + 8192) = SC_EXP4(rkt); \
        *(LAS f32x2*)((bf) + 10240 + il * 32 + jg * 2) = (f32x2){bf2f(rv & 0xffffu), bf2f(rv >> 16)}; \
        if (tid < SC_TS) *(LAS f32x2*)((bf) + 11264 + tid * 2) = rc; } while (0)
    __syncthreads();
    SC_GLOAD(0); SC_LSTORE(buf0);
    __syncthreads();
    for (int n = 0; n < T_ / SC_TS; ++n) {
        LAS float* cb = (n & 1) ? buf1 : buf0; LAS float* nb = (n & 1) ? buf0 : buf1;
        if (n + 1 < T_ / SC_TS) SC_GLOAD((n + 1) * SC_TS);
#pragma unroll 8
        for (int s = 0; s < SC_TS; ++s) {
            const LAS float* B = cb + s * 64 + jg * 4;
            const f32x4 kk = *(const LAS f32x4*)B, wr = *(const LAS f32x4*)(B + 2048), w = *(const LAS f32x4*)(B + 4096), kka = *(const LAS f32x4*)(B + 6144), kt = *(const LAS f32x4*)(B + 8192);
            const float v = cb[10240 + s * 32 + il]; const f32x2 c = *(const LAS f32x2*)(cb + 11264 + s * 2);
            float sa = (S0 * kk.x + S1 * kk.y) + (S2 * kk.z + S3 * kk.w);
            float uu = (S0 * wr.x + S1 * wr.y) + (S2 * wr.z + S3 * wr.w);
            sa = row16_sum(sa); uu = row16_sum(uu);
            const float y = uu - sa * c.x + v * c.y;
            if (jg == 0) ybuf[s * 32 + il] = y;
            S0 = S0 * w.x + (v * kt.x - sa * kka.x); S1 = S1 * w.y + (v * kt.y - sa * kka.y);
            S2 = S2 * w.z + (v * kt.z - sa * kka.z); S3 = S3 * w.w + (v * kt.w - sa * kka.w);
        }
        __syncthreads();
        if (n + 1 < T_ / SC_TS) SC_LSTORE(nb);
        { const f32x2 yv = *(const LAS f32x2*)(ybuf + il * 32 + jg * 2);
          *(f32x2*)(Y + (rowbase + (size_t)n * SC_TS + il) * 512 + h * 64 + half * 32 + jg * 2) = yv; }
        __syncthreads();
    }
#undef SC_GLOAD
#undef SC_EXP4
#undef SC_LSTORE
}

__device__ __forceinline__ void rwkv_post(const Args& a, const float* Y, const bf16_t* VS, const bf16_t* L, const float* C, bf16_t* O, int gw, int NGW, int lane) {
    const int h = gw & 7, col = h * 64 + (lane & 15) * 4, q = lane >> 4;
    const f32x4 lg = *(const f32x4*)(a.in[17] + col), lb = *(const f32x4*)(a.in[18] + col);
    for (int m4 = gw >> 3; m4 < M_ / 4; m4 += NGW >> 3) {
        const int m = m4 * 4 + q;
        const f32x4 y = *(const f32x4*)(Y + (size_t)m * 512 + col);
        const float mean = row16_sum((y.x + y.y) + (y.z + y.w)) * (1.f / 64.f); const f32x4 d = y - mean;
        const float var = row16_sum((d.x * d.x + d.y * d.y) + (d.z * d.z + d.w * d.w)) * (1.f / 64.f);
        const f32x4 yn = d * rsqrtf(var + GN_EPS) * lg + lb;
        const f32x4 v = UNPK4(*(const u32x2*)(VS + (size_t)m * 512 + col)), g = UNPK4(*(const u32x2*)(L + (size_t)m * LLD + 1024 + col));
        const float c3 = C[(size_t)m * 32 + h * 4 + 2];
        const f32x4 ov = (yn + v * c3) * g;
        *(u32x2*)(O + (size_t)m * DM + 512 + col) = PK4(ov);
    }
}

#define XB_TMO      128
#define XB_XCNT(j)  (256  + 64 * (j))
#define XB_XSUB(j)  (1280 + 64 * (j))
#define XB_XGEN(j)  (2304 + 64 * (j))
#define XB_TOP      3328
#define XB_TOPGEN   3392
#define XCD_BAR_WORDS 3456
#define XB_SPIN_CAP (1u << 18)

__device__ __forceinline__ unsigned xb_ld(unsigned* p)              { return __hip_atomic_load(p, __ATOMIC_RELAXED, __HIP_MEMORY_SCOPE_AGENT); }
__device__ __forceinline__ unsigned xb_add(unsigned* p, unsigned v) { return __hip_atomic_fetch_add(p, v, __ATOMIC_RELAXED, __HIP_MEMORY_SCOPE_AGENT); }
__device__ __forceinline__ unsigned xb_xcc_id() { return (unsigned)__builtin_amdgcn_s_getreg((3 << 11) | 20) & 0xFu; }
#define XB_SPIN(cond, bar) do { unsigned _sp = 0; while (cond) { __builtin_amdgcn_s_sleep(1); \
    if ((++_sp & 255u) == 0u) { if (xb_ld(&(bar)[XB_TMO])) break; if (_sp > XB_SPIN_CAP) { atomicAdd(&(bar)[XB_TMO], 1u); break; } } } } while (0)
struct XcdBarrier {
    unsigned* bar; unsigned x;
    volatile LAS unsigned* st;
};

__device__ __forceinline__ XcdBarrier xcd_barrier_post(unsigned* bar, volatile LAS unsigned* st) {
    XcdBarrier b; b.bar = bar; b.x = xb_xcc_id(); b.st = st;
    if (threadIdx.x == 0) (void)xb_add(&bar[XB_XCNT(b.x)], 1u);
    return b;
}
__device__ __forceinline__ void xcd_barrier_complete(unsigned* bar, unsigned x, unsigned& nloc, unsigned& nx) {
    const unsigned G = gridDim.x * gridDim.y * gridDim.z;
    unsigned sum, cnt, mine, sp = 0u;
    for (;;) {
        sum = 0u; cnt = 0u; mine = 0u;
#pragma unroll
        for (unsigned j = 0; j < 16; ++j) { const unsigned c = xb_ld(&bar[XB_XCNT(j)]); sum += c; cnt += (c > 0u) ? 1u : 0u; mine = (j == x) ? c : mine; }
        if (sum == G) break;
        __builtin_amdgcn_s_sleep(1);
        if ((++sp & 255u) == 0u) { if (xb_ld(&bar[XB_TMO])) break; if (sp > XB_SPIN_CAP) { atomicAdd(&bar[XB_TMO], 1u); break; } }
    }
    nloc = mine > 0u ? mine : 1u; nx = cnt > 0u ? cnt : 1u;
}

__device__ __forceinline__ void xcd_barrier(const XcdBarrier& b) {
    asm volatile("s_waitcnt vmcnt(0)" ::: "memory");
    __syncthreads();
    if (threadIdx.x == 0) {
        unsigned* bar = b.bar;
        __builtin_amdgcn_s_waitcnt(0);
        unsigned nloc = b.st[0], nx = b.st[1];
        if (nloc == 0u) { xcd_barrier_complete(bar, b.x, nloc, nx); b.st[0] = nloc; b.st[1] = nx; }
        const unsigned old = xb_add(&bar[XB_XSUB(b.x)], 1u);
        const unsigned gen = old / nloc;
        if (old + 1u == (gen + 1u) * nloc) {
            __builtin_amdgcn_fence(__ATOMIC_RELEASE, "agent");
            asm volatile("s_waitcnt vmcnt(0)" ::: "memory");
            const unsigned og = xb_add(&bar[XB_TOP], 1u);
            const unsigned tg = og / nx;
            if (og + 1u == (tg + 1u) * nx) xb_add(&bar[XB_TOPGEN], 1u);
            else XB_SPIN(xb_ld(&bar[XB_TOPGEN]) == tg, bar);
            __builtin_amdgcn_fence(__ATOMIC_ACQUIRE, "agent");
            xb_add(&bar[XB_XGEN(b.x)], 1u);
            asm volatile("s_waitcnt vmcnt(0)" ::: "memory");
        } else {
            XB_SPIN(xb_ld(&bar[XB_XGEN(b.x)]) == gen, bar);
            __builtin_amdgcn_fence(__ATOMIC_ACQUIRE, "agent");
            asm volatile("s_waitcnt vmcnt(0)" ::: "memory");
        }
    }
    __syncthreads();
}

__device__ __forceinline__ void run_gemm0(LAS unsigned char* lds, const bf16_t* A, const bf16_t* Bt, int M, int N, int K, int lda, bf16_t* Oo, int ldc, const float* rscale = nullptr) {
    pg8::Gemm g{A, Bt, M, N, K, lda, (size_t)128, 0}; pg8::StaticOrder S; S.init(M, N, (int)gridDim.x, (int)blockIdx.x);
    pg8::EpiStore<0> E{Oo, ldc, nullptr, rscale};

#ifndef NO_GEMM
    pg8::gemm_phase<pg8::EpiStore<0>, pg8::StaticOrder, true, true>(lds, g, S, E);
#endif
}


#define Wt_hyin ((bf16_t*)(ws + WS_HYIN))
#define Wt_hyout ((bf16_t*)(ws + WS_HYOUT))
#define Wt_nsain ((bf16_t*)(ws + WS_NSAIN))
#define Wt_nsaout ((bf16_t*)(ws + WS_NSAOUT))
#define Wt_lora ((bf16_t*)(ws + WS_LORA))
#define Wt_cw1k ((bf16_t*)(ws + WS_CW1K))
#define Wt_cw1v ((bf16_t*)(ws + WS_CW1V))
#define cbias ((float*)(ws + WS_CBIAS))
#define W2T ((bf16_t*)(ws + WS_CBIAS + 4096))
#define RS ((float*)(ws + WS_CBIAS + 131072))
#define H ((bf16_t*)(ws + WS_H))
#define Z ((bf16_t*)(ws + WS_Z))
#define AP ((bf16_t*)(ws + WS_AP))
#define O ((bf16_t*)(ws + WS_O))
#define L ((bf16_t*)(ws + WS_L))
#define C ((float*)(ws + WS_C))
#define MM ((bf16_t*)(ws + WS_MM))
#define Y ((float*)(ws + WS_MM))
#define HID ((bf16_t*)(ws + WS_HID))
#define KC ((bf16_t*)(ws + WS_KCMP))
#define VC ((bf16_t*)(ws + WS_VCMP))
#define U ((bf16_t*)(ws + WS_U))
#define KK ((bf16_t*)(ws + WS_H))
#define WR (KK + (size_t)M_ * 512)
#define WE ((bf16_t*)args.out)
#define KKA (WE + (size_t)M_ * 512)
#define KT (WE + (size_t)M_ * 1024)
#define VS (WE + (size_t)M_ * 1536)
#define XIN (args.in[0])
#define X (args.out)
#define PH_BEGIN unsigned char* ws = args.ws; asm volatile("" : "+s"(ws)); int tid_ = threadIdx.x; asm volatile("" : "+v"(tid_)); const int tid = tid_, lane = tid & 63, wave = __builtin_amdgcn_readfirstlane(tid >> 6); const int G = gridDim.x, gw = blockIdx.x * 8 + wave, NGW = G * 8; const int gtid = blockIdx.x * 512 + tid, NT = G * 512; (void)lane; (void)gw; (void)NGW; (void)gtid; (void)NT; (void)ws;
__global__ void __launch_bounds__(512, 2) mega_fwd(Args args) {
    extern __shared__ __attribute__((aligned(16))) unsigned char lds_raw[];
    LAS unsigned char* lds = (LAS unsigned char*)lds_raw;
    cg::grid_group grid = cg::this_grid();
    volatile LAS unsigned* xst = (volatile LAS unsigned*)(lds + LDS_BYTES - 64);
    if (threadIdx.x < 2) xst[threadIdx.x] = 0u;
    __syncthreads();
    const XcdBarrier xbar = xcd_barrier_post((unsigned*)args.ws, xst);
    const int lo = args.ph_lo, hi = args.ph_hi;
#define IN(k) (lo <= (k) && (k) < hi)
#ifndef DUP_MASK
#define DUP_MASK 0u
#endif
#define REP(k) for (int rep_ = 0; rep_ < (((DUP_MASK >> (k)) & 1u) ? 2 : 1); ++rep_)
#define SEAM(k) do { if (IN(k) && IN((k) + 1)) { if ((k) == 0) grid.sync(); else xcd_barrier(xbar); } } while (0)

#ifdef EXTRA_SYNCS
    if (IN(0) && IN(1)) for (int es_ = 0; es_ < EXTRA_SYNCS; ++es_) grid.sync();
#endif
    if (IN(0)) REP(0) { PH_BEGIN
        LAS float* scr = (LAS float*)(lds + wave * 16384);
        constexpr int I0 = 16 * 80, I1 = 16 * 32, I2 = 16 * 88, I3 = 16 * 32, I4 = 16 * 176, I5 = 44 * 32, I6 = 32 * 8;
        constexpr int NIT = I0 + I1 + I2 + I3 + 2 * I4 + 2 * I5 + 2 * I6;
        for (int it = gw; it < NIT; it += NGW) {
            int r = it;
            if (r < I0) { transpose_item(args.in[5], 2560, Wt_hyin, 1024, scr, r, 80, lane, args.in[1]); continue; } r -= I0;
            if (r < I1) { transpose_item(args.in[6], 1024, Wt_hyout, 1024, scr, r, 32, lane); continue; } r -= I1;
            if (r < I2) { transpose_item(args.in[19], 2608, Wt_nsain, 1024, scr, r, 88, lane, args.in[1] + 1024); continue; } r -= I2;
            if (r < I3) { transpose_item(args.in[20], 1024, Wt_nsaout, 1024, scr, r, 32, lane); continue; } r -= I3;
            if (r < 2 * I4) { const int l = r / I4; transpose_item(args.in[27] + (size_t)l * 1024 * 5632, 5632, (bf16_t*)(ws + (l ? WS_UP1 : WS_UP0)), 1024, scr, r % I4, 176, lane, args.in[3] + l * 1024); continue; } r -= 2 * I4;
            if (r < 2 * I5) { const int l = r / I5; transpose_item(args.in[30] + (size_t)l * 2816 * 1024, 1024, (bf16_t*)(ws + (l ? WS_DN1 : WS_DN0)), 2816, scr, r % I5, 32, lane); continue; } r -= 2 * I5;
            if (r < I6) { transpose_item(args.in[22], 256, Wt_cw1k, 2048, scr, r, 8, lane); continue; } r -= I6;
            transpose_item(args.in[25], 256, Wt_cw1v, 2048, scr, r, 8, lane);
        }
        for (int e = gtid; e < 1536 * 256; e += NT) {
            const int n = e >> 8, k = e & 255; float v = 0.f;
            if (n < 512) { if (k < 64) v = args.in[10][k * 512 + n]; }
            else if (n < 1024) { if (k >= 64 && k < 128) v = args.in[12][(k - 64) * 512 + (n - 512)]; }
            else { if (k >= 128) v = args.in[13][(k - 128) * 512 + (n - 1024)]; }
            Wt_lora[e] = (bf16_t)(pk2(v, 0.f) & 0xffffu);
        }
        for (int e = gtid; e < 2 * 16384; e += NT) { const int which = e >> 14, d = (e >> 8) & 63, f = e & 255; W2T[e] = (bf16_t)(pk2(args.in[which ? 26 : 23][f * 64 + d], 0.f) & 0xffffu); }
        for (int it = gw; it < 512; it += NGW) {
            const int which = it >> 8, f = it & 255; const float* pos = args.in[which ? 24 : 21]; const float* w1 = args.in[which ? 25 : 22];
            float s = 0.f;
            for (int e = lane; e < 2048; e += 64) s += pos[e] * w1[(size_t)e * 256 + f];
            s = wave_sum(s);
            if (lane == 0) cbias[it] = s;
        }
        norm_phase(XIN, nullptr, nullptr, nullptr, nullptr, H, RS, gw, NGW, lane);
    }
    SEAM(0);
    if (IN(1)) REP(1) { PH_BEGIN run_gemm0(lds, H, Wt_hyin, M_, ZLD0, 1024, 1024, Z, ZLD0, RS); }
    SEAM(1);
    if (IN(2)) REP(2) { PH_BEGIN
        const float* mu = args.in[8];
        for (int it = gtid; it < M_ * 32; it += NT) {
            const int m = it >> 5, col = (it & 31) * 8;
            const bf16_t* zp = Z + (size_t)m * ZLD0 + 2304 + col;
            const u32x4 zc = *(const u32x4*)zp; u32x4 zq = (u32x4){0u, 0u, 0u, 0u};
            if ((m & (T_ - 1)) != 0) zq = *(const u32x4*)(zp - ZLD0);
            const unsigned cw[4] = {zc.x, zc.y, zc.z, zc.w}, pw[4] = {zq.x, zq.y, zq.z, zq.w}; unsigned ow[4];
#pragma unroll
            for (int e = 0; e < 4; ++e) {
                float a0 = bf2f(cw[e] & 0xffffu), a1 = bf2f(cw[e] >> 16); const float p0 = bf2f(pw[e] & 0xffffu), p1 = bf2f(pw[e] >> 16);
                a0 += (p0 - a0) * mu[1536 + col + 2 * e]; a1 += (p1 - a1) * mu[1536 + col + 2 * e + 1];
                if (col < 64) { a0 = tanhf(a0); a1 = tanhf(a1); } else if (col >= 128) { a0 = sigmoidf_(a0); a1 = sigmoidf_(a1); }
                ow[e] = pk2(a0, a1);
            }
            *(u32x4*)(AP + (size_t)m * 256 + col) = (u32x4){ow[0], ow[1], ow[2], ow[3]};
        }

#ifndef NO_SWA
for (int u = blockIdx.x; u < NB_ * 64 * 2; u += G) swa_unit(u, Z, O, args.in[7], lds, tid);
#endif

        __syncthreads();
    }
    SEAM(2);
    if (IN(3)) REP(3) { PH_BEGIN run_gemm0(lds, AP, Wt_lora, M_, LLD, 256, 256, L, LLD); }
    SEAM(3);
    if (IN(4)) REP(4) { PH_BEGIN rwkv_prep(args, Z, L, KK, WR, WE, KKA, KT, VS, C, gw, NGW, lane); }
    SEAM(4);
    if (IN(5)) REP(5) { PH_BEGIN
#ifndef NO_SCAN
for (int u = blockIdx.x; u < 256; u += G) scan_unit(u, KK, WR, WE, KKA, KT, VS, C, Y, lds, tid);
#endif
 }
    SEAM(5);
    if (IN(6)) REP(6) { PH_BEGIN rwkv_post(args, Y, VS, L, C, O, gw, NGW, lane); }
    SEAM(6);
    if (IN(7)) REP(7) { PH_BEGIN run_gemm0(lds, O, Wt_hyout, M_, 1024, 1024, 1024, MM, 1024); }
    SEAM(7);
    if (IN(8)) REP(8) { PH_BEGIN norm_phase(XIN, nullptr, MM, args.in[2], nullptr, H, RS, gw, NGW, lane); }
    SEAM(8);
#pragma unroll
    for (int l = 0; l < 2; ++l) {
        const int pb = l ? 19 : 9;
        if (IN(pb)) REP(pb) { PH_BEGIN run_gemm0(lds, H, (const bf16_t*)(ws + (l ? WS_UP1 : WS_UP0)), M_, ULD, 1024, 1024, U, ULD, RS); }
        SEAM(pb);
        if (IN(pb + 1)) REP(pb + 1) { PH_BEGIN
            const float* cw = args.in[28] + (size_t)l * 3 * FF_; const float* cbv = args.in[29] + (size_t)l * FF_;
            for (int it = gtid; it < (M_ / 16) * (FF_ / 8); it += NT) {
                const int run = it / (FF_ / 8), f = (it - run * (FF_ / 8)) * 8, m0 = run * 16;
                f32x4 w0a = *(const f32x4*)(cw + f), w0b = *(const f32x4*)(cw + f + 4), w1a = *(const f32x4*)(cw + FF_ + f), w1b = *(const f32x4*)(cw + FF_ + f + 4);
                f32x4 w2a = *(const f32x4*)(cw + 2 * FF_ + f), w2b = *(const f32x4*)(cw + 2 * FF_ + f + 4), cba = *(const f32x4*)(cbv + f), cbb = *(const f32x4*)(cbv + f + 4);
                bf16_t* up = U + (size_t)m0 * ULD + f;
                u32x4 g1 = (u32x4){0u, 0u, 0u, 0u}, g2 = g1;
                if ((m0 & (T_ - 1)) != 0) { g1 = *(const u32x4*)(up - ULD); g2 = *(const u32x4*)(up - 2 * ULD); }
                f32x4 p1a = UNPK4(((u32x2){g1.x, g1.y})), p1b = UNPK4(((u32x2){g1.z, g1.w})), p2a = UNPK4(((u32x2){g2.x, g2.y})), p2b = UNPK4(((u32x2){g2.z, g2.w}));
#pragma unroll 4
                for (int rr = 0; rr < 16; ++rr) {
                    const u32x4 g0 = *(const u32x4*)(up + (size_t)rr * ULD), vv = *(const u32x4*)(up + (size_t)rr * ULD + FF_);
                    const f32x4 ca = UNPK4(((u32x2){g0.x, g0.y})), cb4 = UNPK4(((u32x2){g0.z, g0.w}));
                    const f32x4 va = UNPK4(((u32x2){vv.x, vv.y})), vb = UNPK4(((u32x2){vv.z, vv.w}));
                    const f32x4 xa = cba + ca * w2a + p1a * w1a + p2a * w0a, xb = cbb + cb4 * w2b + p1b * w1b + p2b * w0b;
                    const f32x4 oa = (f32x4){pg8::gelu_tanh(xa.x), pg8::gelu_tanh(xa.y), pg8::gelu_tanh(xa.z), pg8::gelu_tanh(xa.w)} * va;
                    const f32x4 ob = (f32x4){pg8::gelu_tanh(xb.x), pg8::gelu_tanh(xb.y), pg8::gelu_tanh(xb.z), pg8::gelu_tanh(xb.w)} * vb;
                    const u32x2 oa2 = PK4(oa), ob2 = PK4(ob);
                    *(u32x4*)(up + (size_t)rr * ULD + FF_) = (u32x4){oa2.x, oa2.y, ob2.x, ob2.y};
                    p2a = p1a; p2b = p1b; p1a = ca; p1b = cb4;
                }
            }
        }
        SEAM(pb + 1);
        if (IN(pb + 2)) REP(pb + 2) { PH_BEGIN run_gemm0(lds, U + FF_, (const bf16_t*)(ws + (l ? WS_DN1 : WS_DN0)), M_, 1024, FF_, ULD, MM, 1024); }
        SEAM(pb + 2);
        if (IN(pb + 3)) REP(pb + 3) { PH_BEGIN
            if (l == 0) norm_phase(nullptr, H, MM, args.in[4], nullptr, H, RS, gw, NGW, lane);
            else norm_phase(nullptr, H, MM, args.in[4] + 1024, X, nullptr, nullptr, gw, NGW, lane);
        }
        if (l == 0) {
            SEAM(12);
            if (IN(13)) REP(13) { PH_BEGIN run_gemm0(lds, H, Wt_nsain, M_, ZLD1, 1024, 1024, Z, ZLD1, RS); }
            SEAM(13);
            if (IN(14)) REP(14) { PH_BEGIN
                const int G2 = G >> 1, which = (int)blockIdx.x >= G2 ? 1 : 0;
                pg8::Gemm g{Z + 1024 + which * 256, which ? Wt_cw1v : Wt_cw1k, 16384, 256, 2048, 16 * ZLD1, (size_t)ZLD1 * 2, 1};
                pg8::StaticOrder S; S.init(16384, 256, G2, (int)blockIdx.x - which * G2);
                pg8::EpiStore<2> E{HID + (size_t)which * 16384 * 256, 256, cbias + which * 256, nullptr};

#ifndef NO_GEMM2
if ((int)blockIdx.x < 2 * G2) pg8::gemm_phase<pg8::EpiStore<2>, pg8::StaticOrder, true, true>(lds, g, S, E);
#endif

            }
            SEAM(14);
            if (IN(15)) REP(15) { PH_BEGIN
                for (int wt = gw; wt < 2 * 512; wt += NGW) {
                    const int which = wt >> 9, row0 = (wt & 511) * 32, r32 = lane & 31, hi5 = lane >> 5;
                    const bf16_t* hp = HID + ((size_t)which * 16384 + row0 + r32) * 256 + hi5 * 8;
                    const bf16_t* wp = W2T + (size_t)which * 16384 + (size_t)r32 * 256 + hi5 * 8;
                    f32x16 c0, c1;
#pragma unroll
                    for (int r = 0; r < 16; ++r) { c0[r] = 0.f; c1[r] = 0.f; }
#pragma unroll 4
                    for (int ks = 0; ks < 16; ++ks) {
                        const bf16x8 av = *(const bf16x8*)(hp + ks * 16), b0 = *(const bf16x8*)(wp + ks * 16), b1 = *(const bf16x8*)(wp + 32 * 256 + ks * 16);
                        c0 = __builtin_amdgcn_mfma_f32_32x32x16_bf16(av, b0, c0, 0, 0, 0);
                        c1 = __builtin_amdgcn_mfma_f32_32x32x16_bf16(av, b1, c1, 0, 0, 0);
                    }
                    bf16_t* op = (which ? VC : KC) + (size_t)row0 * 64 + r32;
#pragma unroll
                    for (int r = 0; r < 16; ++r) { const int rw = crow(r, hi5); op[(size_t)rw * 64] = (bf16_t)(pk2(c0[r], 0.f) & 0xffffu); op[(size_t)rw * 64 + 32] = (bf16_t)(pk2(c1[r], 0.f) & 0xffffu); }
                }
            }
            SEAM(15);
            if (IN(16)) REP(16) { PH_BEGIN
#ifndef NO_NSA
for (int u = blockIdx.x; u < 64 * 64; u += G) nsa_unit(u, Z, KC, VC, O, lds, tid);
#endif
 }
            SEAM(16);
            if (IN(17)) REP(17) { PH_BEGIN run_gemm0(lds, O, Wt_nsaout, M_, 1024, 1024, 1024, MM, 1024); }
            SEAM(17);
            if (IN(18)) REP(18) { PH_BEGIN norm_phase(nullptr, H, MM, args.in[2] + 1024, nullptr, H, RS, gw, NGW, lane); }
            SEAM(18);
        }
    }
#undef IN
#undef SEAM
}

#undef XIN
#undef X
#undef H
#undef Z
#undef O
#undef L
#undef C
#undef U
#undef Y
extern "C" void kernel_launch(void* const* d_in, const int* in_sizes, int n_in, void* d_out, int out_size, void* d_ws, size_t ws_size, hipStream_t stream) {
    static int grid = 0;
    if (grid == 0) {
        if (n_in != 31 || out_size != M_ * DM || ws_size < WS_END) { fprintf(stderr, "kernel_launch: unexpected shapes (n_in %d out %d ws %zu)\n", n_in, out_size, ws_size); grid = -1; return; }
        int dev = 0, cus = 0, per_cu = 0;
        hipGetDevice(&dev); hipDeviceGetAttribute(&cus, hipDeviceAttributeMultiprocessorCount, dev);
        hipFuncSetAttribute((const void*)mega_fwd, hipFuncAttributeMaxDynamicSharedMemorySize, LDS_BYTES);
        hipOccupancyMaxActiveBlocksPerMultiprocessor(&per_cu, (const void*)mega_fwd, 512, LDS_BYTES);
        if (per_cu < 1) { fprintf(stderr, "kernel_launch: occupancy query says %d blocks/CU\n", per_cu); per_cu = 1; }
        (void)hipGetLastError();
        grid = cus * 1;
    }
    if (grid < 0) return;
    hipMemsetAsync(d_ws, 0, 16384, stream);
    Args a{};
    for (int i = 0; i < 31; ++i) a.in[i] = (const float*)d_in[i];
    a.out = (float*)d_out; a.ws = (unsigned char*)d_ws;
#if ONE_LAUNCH
    a.ph_lo = 0; a.ph_hi = NPHASE;
    void* kargs[] = {&a};
    hipError_t e = hipLaunchCooperativeKernel((const void*)mega_fwd, dim3(grid), dim3(512), kargs, LDS_BYTES, stream);
    if (e != hipSuccess) fprintf(stderr, "cooperative launch failed: %s (grid %d)\n", hipGetErrorString(e), grid);
#else
    for (int p = 0; p < NPHASE; ++p) { a.ph_lo = p; a.ph_hi = p + 1; hipLaunchKernelGGL(mega_fwd, dim3(grid), dim3(512), LDS_BYTES, stream, a); }
#endif
}
```

```cpp
#include <hip/hip_runtime.h>
#include <hip/hip_cooperative_groups.h>
#include <cstdio>
#include <cstdint>
namespace cg = cooperative_groups;

#ifndef ONE_LAUNCH
#define ONE_LAUNCH 1
#endif

namespace pg8 {
#define PG8_LAS __attribute__((address_space(3)))
typedef unsigned short bf16_t;
typedef short bf16x8 __attribute__((ext_vector_type(8)));
typedef float f32x4 __attribute__((ext_vector_type(4)));
typedef unsigned u32x4 __attribute__((ext_vector_type(4)));
constexpr int BM = 256, BK = 64, HALF = 128, HTB = HALF * BK * 2  , STAGE_BYTES = 8 * HTB, NXCD = 8, WGM = 8;

__host__ __device__ __forceinline__ int lds_byte(int r, int c) { const int st = (r >> 4) * 2 + (c >> 5), rr = r & 15, cc = c & 31, ob = rr * 64 + cc * 2; return st * 1024 + (ob ^ (((ob >> 9) & 1) << 5)); }
__host__ __device__ __forceinline__ void stage_rc(int b, int& R, int& C) { const int st = b / 1024, sb = b % 1024, swz = sb ^ (((sb >> 9) & 1) << 5); R = (st >> 1) * 16 + swz / 64; C = (st & 1) * 32 + (swz % 64) / 2; }
__host__ __device__ __forceinline__ int perm32(int rho) { const int n = rho >> 4, i = rho & 15; return 8 * (i >> 2) + 4 * n + (i & 3); }

struct Unit { int pm, pn; };
struct Gemm { const bf16_t* A; const bf16_t* Bt; int M, N, K; int lda; size_t a_kstep; int amode; };
__device__ __forceinline__ const char* a_base(const Gemm& g, int pm) { return g.amode == 0 ? (const char*)g.A + (size_t)pm * ((size_t)BM * g.lda * 2) : (const char*)g.A + (size_t)(pm >> 2) * ((size_t)4096 * 2816 * 2) + (size_t)(pm & 3) * 128; }

struct StaticOrder {
    int nM, nN, nwg, G, c;
    __host__ __device__ void init(int M, int N, int G_, int c_) { nM = M / BM; nN = N / BM; nwg = nM * nN; G = G_; c = c_; }
    __host__ __device__ bool next(int i, Unit& u) const {
        const long L = (long)i * G + c; if (L >= nwg) return false;
        int wgid = (int)L; { const int q = nwg / NXCD, r = nwg % NXCD, xcd = wgid % NXCD, off = wgid / NXCD; wgid = (xcd < r ? xcd * (q + 1) : r * (q + 1) + (xcd - r) * q) + off; }
        const int nig = WGM * nN, gid = wgid / nig, fm = gid * WGM, gsz = (nM - fm) < WGM ? (nM - fm) : WGM;
        u.pm = fm + ((wgid % nig) % gsz); u.pn = (wgid % nig) / gsz; return true;
    }
    __device__ __forceinline__ void a_ready(const Unit&) const {}
    __device__ __forceinline__ void done(const Unit&) const {}
};


__device__ __forceinline__ unsigned cvt_pk_bf16(float lo, float hi) { unsigned r; asm volatile("v_cvt_pk_bf16_f32 %0, %1, %2" : "=v"(r) : "v"(lo), "v"(hi)); return r; }
__device__ __forceinline__ float gelu_tanh(float x) { const float u = 1.5957691216f * (x + 0.044715f * x * x * x); return x / (1.0f + __expf(-u)); }
template <int ACT> struct EpiStore {
    static constexpr bool PERM = true, AFTER_DRAIN = false;
    bf16_t* O; int ldc; const float* bias; const float* rscale;
    __device__ __forceinline__ void operator()(const f32x4 (&acc)[2][2][4][2], const Unit& u, int wr, int wc, int fr, int fq) const {
        const int row0 = u.pm * BM + wr * 64 + fr; const int col0 = u.pn * BM + wc * 32 + 8 * fq;
        f32x4 bv[2][2];
#pragma unroll
        for (int bj = 0; bj < 2; ++bj)
#pragma unroll
            for (int n = 0; n < 2; ++n) bv[bj][n] = bias ? *(const f32x4*)(bias + col0 + bj * HALF + 4 * n) : (f32x4){0.f, 0.f, 0.f, 0.f};
#pragma unroll
        for (int ai = 0; ai < 2; ++ai)
#pragma unroll
            for (int m = 0; m < 4; ++m) { bf16_t* rowp = O + (size_t)(row0 + ai * HALF + m * 16) * ldc + col0; const float rsc = rscale ? rscale[row0 + ai * HALF + m * 16] : 1.f;
#pragma unroll
                for (int bj = 0; bj < 2; ++bj) { f32x4 v0 = acc[ai][bj][m][0] * rsc + bv[bj][0], v1 = acc[ai][bj][m][1] * rsc + bv[bj][1];
                    if (ACT == 2) { v0 = (f32x4){gelu_tanh(v0[0]), gelu_tanh(v0[1]), gelu_tanh(v0[2]), gelu_tanh(v0[3])}; v1 = (f32x4){gelu_tanh(v1[0]), gelu_tanh(v1[1]), gelu_tanh(v1[2]), gelu_tanh(v1[3])}; }
                    u32x4 w; w.x = cvt_pk_bf16(v0[0], v0[1]); w.y = cvt_pk_bf16(v0[2], v0[3]); w.z = cvt_pk_bf16(v1[0], v1[1]); w.w = cvt_pk_bf16(v1[2], v1[3]);
                    *(u32x4*)(rowp + bj * HALF) = w; } }
    }
};

template <class Epi, class Sched, bool ALIGN_EPI = false, bool SP2 = false>
__device__ __forceinline__ void gemm_phase(PG8_LAS unsigned char* lds, const Gemm g, const Sched& S, const Epi& E) {
    int tid = threadIdx.x; asm volatile("" : "+v"(tid)); const int wid = __builtin_amdgcn_readfirstlane(tid >> 6), lane = tid & 63, wr = wid >> 2, wc = wid & 3, fr = lane & 15, fq = lane >> 4;
    const int K = g.K, nt = K / BK;
    unsigned voffA[2], voffB[2];
#pragma unroll
    for (int i = 0; i < 2; ++i) { int R, C; stage_rc(tid * 16 + i * 8192, R, C); const int Rb = Epi::PERM ? ((R & ~31) + perm32(R & 31)) : R;
        voffA[i] = (unsigned)(R * g.lda + C) * 2u; voffB[i] = (unsigned)(Rb * K + C) * 2u; }
    const size_t kstep = (size_t)(BK * 2);
    const size_t hstepB = (size_t)HALF * K * 2, hstepA = (size_t)HALF * g.lda * 2, kstepA = g.a_kstep;
    const size_t tstep = 2 * hstepB;
    const unsigned ldsw = (unsigned)wid * 1024u;
    const int aoff = lds_byte(wr * 64 + fr, fq * 8), boff = lds_byte(wc * 32 + fr, fq * 8);
#define PG8_SA(b, h) (((b) * 2 + (h)) * HTB)
#define PG8_SB(b, h) ((4 + (b) * 2 + (h)) * HTB)
#define PG8_STAGE(bufoff, gbase, voff) do { _Pragma("unroll") for (int _i = 0; _i < 2; ++_i) \
        __builtin_amdgcn_global_load_lds((const unsigned*)((const char*)(gbase) + (voff)[_i]), (PG8_LAS unsigned*)(lds + (bufoff) + ldsw + _i * 8192), 16, 0, 0); } while (0)
#define PG8_LDA(dst, b, h) do { _Pragma("unroll") for (int m = 0; m < 4; ++m) _Pragma("unroll") for (int k = 0; k < 2; ++k) dst[m][k] = *(const PG8_LAS bf16x8*)(lds + PG8_SA(b, h) + aoff + m * 2048 + k * 1024); } while (0)
#define PG8_LDB(dst, b, h) do { _Pragma("unroll") for (int n = 0; n < 2; ++n) _Pragma("unroll") for (int k = 0; k < 2; ++k) dst[n][k] = *(const PG8_LAS bf16x8*)(lds + PG8_SB(b, h) + boff + n * 2048 + k * 1024); } while (0)
#define PG8_MMA(ai, bj, At, Bt) do { __builtin_amdgcn_s_setprio(1); _Pragma("unroll") for (int m = 0; m < 4; ++m) _Pragma("unroll") for (int n = 0; n < 2; ++n) _Pragma("unroll") for (int k = 0; k < 2; ++k) \
        acc[ai][bj][m][n] = __builtin_amdgcn_mfma_f32_16x16x32_bf16(Bt[n][k], At[m][k], acc[ai][bj][m][n], 0, 0, 0); __builtin_amdgcn_s_setprio(0); } while (0)
#define PG8_WAIT_V(n) asm volatile("s_waitcnt vmcnt(" #n ")" ::: "memory")
#define PG8_WAIT_L(n) asm volatile("s_waitcnt lgkmcnt(" #n ")" ::: "memory")
#define PG8_BAR __builtin_amdgcn_s_barrier()
#define PG8_SCHED __builtin_amdgcn_sched_barrier(0)
    Unit cur, nxt; int ui = 0;
    if (!S.next(0, cur)) return;
    f32x4 acc[2][2][4][2];
#pragma unroll
    for (int a = 0; a < 2; ++a)
#pragma unroll
        for (int b = 0; b < 2; ++b)
#pragma unroll
            for (int m = 0; m < 4; ++m)
#pragma unroll
                for (int n = 0; n < 2; ++n) acc[a][b][m][n] = (f32x4){0.f, 0.f, 0.f, 0.f};
    bf16x8 At[4][2], B0[2][2], B1[2][2];
    const char* cA = a_base(g, cur.pm); const char* cB = (const char*)g.Bt + (size_t)cur.pn * tstep;
    S.a_ready(cur);
    if constexpr (SP2) {
        PG8_STAGE(PG8_SB(0, 0), cB, voffB); PG8_STAGE(PG8_SB(0, 1), cB + hstepB, voffB); PG8_STAGE(PG8_SA(0, 0), cA, voffA); PG8_STAGE(PG8_SA(0, 1), cA + hstepA, voffA);
        if (wr == 1) PG8_BAR;
        PG8_WAIT_V(2); PG8_BAR;
        PG8_STAGE(PG8_SB(1, 0), cB + kstep, voffB); PG8_STAGE(PG8_SA(1, 0), cA + kstepA, voffA); PG8_STAGE(PG8_SB(1, 1), cB + hstepB + kstep, voffB);
        PG8_WAIT_V(6); PG8_BAR;
    } else {
        PG8_STAGE(PG8_SB(0, 0), cB, voffB); PG8_STAGE(PG8_SA(0, 0), cA, voffA); PG8_STAGE(PG8_SB(0, 1), cB + hstepB, voffB); PG8_STAGE(PG8_SA(0, 1), cA + hstepA, voffA);
        if (wr == 1) PG8_BAR;
        PG8_WAIT_V(4); PG8_BAR;
        PG8_STAGE(PG8_SB(1, 0), cB + kstep, voffB); PG8_STAGE(PG8_SA(1, 0), cA + kstepA, voffA); PG8_STAGE(PG8_SB(1, 1), cB + hstepB + kstep, voffB);
        PG8_WAIT_V(6); PG8_BAR;
    }
    for (;;) {
        const bool has_next = S.next(ui + 1, nxt);
        const char* nA = has_next ? a_base(g, nxt.pm) : cA; const char* nB = has_next ? (const char*)g.Bt + (size_t)nxt.pn * tstep : cB;
        for (int t = 0; t < nt; t += 2) {
            const bool last = (t == nt - 2);
            const char* a1 = cA + (size_t)(t + 1) * kstepA;
            const char* a2 = last ? nA : cA + (size_t)(t + 2) * kstepA; const char* b2 = last ? nB : cB + (size_t)(t + 2) * kstep;
            const char* a3 = a2 + kstepA; const char* b3 = b2 + kstep;
            if (last && has_next) S.a_ready(nxt);
            if constexpr (SP2) {
            PG8_LDB(B0, 0, 0); PG8_LDB(B1, 0, 1); PG8_SCHED; PG8_LDA(At, 0, 0); PG8_STAGE(PG8_SA(1, 1), a1 + hstepA, voffA);
            PG8_WAIT_V(8); PG8_WAIT_L(0); PG8_BAR; PG8_MMA(0, 0, At, B0); PG8_MMA(0, 1, At, B1); PG8_BAR; PG8_SCHED;
            PG8_LDA(At, 0, 1); PG8_STAGE(PG8_SB(0, 0), b2, voffB); PG8_STAGE(PG8_SB(0, 1), b2 + hstepB, voffB); PG8_STAGE(PG8_SA(0, 0), a2, voffA);
            PG8_WAIT_V(8); PG8_WAIT_L(0); PG8_BAR; PG8_MMA(1, 0, At, B0); PG8_MMA(1, 1, At, B1); PG8_BAR; PG8_SCHED;
            PG8_LDB(B0, 1, 0); PG8_LDB(B1, 1, 1); PG8_SCHED; PG8_LDA(At, 1, 0); PG8_STAGE(PG8_SA(0, 1), a2 + hstepA, voffA);
            PG8_WAIT_V(8); PG8_WAIT_L(0); PG8_BAR; PG8_MMA(0, 0, At, B0); PG8_MMA(0, 1, At, B1); PG8_BAR; PG8_SCHED;
            PG8_LDA(At, 1, 1); PG8_STAGE(PG8_SB(1, 0), b3, voffB); PG8_STAGE(PG8_SB(1, 1), b3 + hstepB, voffB); PG8_STAGE(PG8_SA(1, 0), a3, voffA);
            PG8_WAIT_V(8); PG8_WAIT_L(0); PG8_BAR; PG8_MMA(1, 0, At, B0); PG8_MMA(1, 1, At, B1); PG8_BAR; PG8_SCHED;
            } else {
            PG8_LDB(B0, 0, 0); PG8_SCHED; PG8_LDA(At, 0, 0); PG8_STAGE(PG8_SA(1, 1), a1 + hstepA, voffA);
            PG8_WAIT_L(8); PG8_BAR; PG8_WAIT_L(0); PG8_MMA(0, 0, At, B0); PG8_BAR; PG8_SCHED;
            PG8_LDB(B1, 0, 1); PG8_STAGE(PG8_SB(0, 0), b2, voffB);
            PG8_BAR; PG8_WAIT_L(0); PG8_MMA(0, 1, At, B1); PG8_BAR;
            PG8_LDA(At, 0, 1); PG8_STAGE(PG8_SA(0, 0), a2, voffA);
            PG8_BAR; PG8_WAIT_L(0); PG8_MMA(1, 0, At, B0); PG8_BAR; PG8_SCHED;
            PG8_STAGE(PG8_SB(0, 1), b2 + hstepB, voffB);
            PG8_WAIT_V(6); PG8_BAR; PG8_MMA(1, 1, At, B1); PG8_BAR;
            PG8_LDB(B0, 1, 0); PG8_SCHED; PG8_LDA(At, 1, 0); PG8_STAGE(PG8_SA(0, 1), a2 + hstepA, voffA);
            PG8_WAIT_L(8); PG8_BAR; PG8_WAIT_L(0); PG8_MMA(0, 0, At, B0); PG8_BAR; PG8_SCHED;
            PG8_LDB(B1, 1, 1); PG8_STAGE(PG8_SB(1, 0), b3, voffB);
            PG8_BAR; PG8_WAIT_L(0); PG8_MMA(0, 1, At, B1); PG8_BAR;
            PG8_LDA(At, 1, 1); PG8_STAGE(PG8_SA(1, 0), a3, voffA);
            PG8_BAR; PG8_WAIT_L(0); PG8_MMA(1, 0, At, B0); PG8_BAR; PG8_SCHED;
            PG8_STAGE(PG8_SB(1, 1), b3 + hstepB, voffB);
            PG8_WAIT_V(6); PG8_BAR; PG8_MMA(1, 1, At, B1); PG8_BAR;
            }
        }
        if constexpr (ALIGN_EPI) { if (wr == 0) PG8_BAR; }
        if constexpr (!Epi::AFTER_DRAIN) { E(acc, cur, wr, wc, fr, fq); S.done(cur); }
        if (!has_next) break;
#pragma unroll
        for (int a = 0; a < 2; ++a)
#pragma unroll
            for (int b = 0; b < 2; ++b)
#pragma unroll
                for (int m = 0; m < 4; ++m)
#pragma unroll
                    for (int n = 0; n < 2; ++n) acc[a][b][m][n] = (f32x4){0.f, 0.f, 0.f, 0.f};
        cur = nxt; cA = nA; cB = nB; ++ui;
        if constexpr (ALIGN_EPI) { if (wr == 1) PG8_BAR; }
    }
    PG8_WAIT_V(0);
    if constexpr (!ALIGN_EPI) { if (wr == 0) PG8_BAR; }
    PG8_BAR;
    if constexpr (Epi::AFTER_DRAIN) { E.fused(acc, cur, wr, wc, fr, fq, lds, wid, lane); S.done(cur); }
#undef PG8_SA
#undef PG8_SB
#undef PG8_STAGE
#undef PG8_LDA
#undef PG8_LDB
#undef PG8_MMA
#undef PG8_WAIT_V
#undef PG8_WAIT_L
#undef PG8_BAR
#undef PG8_SCHED
}
}


#define LAS __attribute__((address_space(3)))
typedef unsigned short bf16_t;
typedef short bf16x8 __attribute__((ext_vector_type(8)));
typedef short s16x4 __attribute__((ext_vector_type(4)));
typedef float f32x4 __attribute__((ext_vector_type(4)));
typedef float f32x2 __attribute__((ext_vector_type(2)));
typedef float f32x16 __attribute__((ext_vector_type(16)));
typedef unsigned u32x4 __attribute__((ext_vector_type(4)));
typedef unsigned u32x2 __attribute__((ext_vector_type(2)));

constexpr int T_ = 4096, NB_ = 16, M_ = NB_ * T_, DM = 1024;
constexpr int ZLD0 = 2560, ZLD1 = 2816, FF_ = 2816, ULD = 5632, LLD = 1536;
constexpr float NORM_EPS = 1e-6f, GN_EPS = 64e-5f;
constexpr size_t MiB = (size_t)1 << 20;
constexpr size_t WS_HYIN = 1 * MiB, WS_HYOUT = 6 * MiB, WS_NSAIN = 8 * MiB, WS_NSAOUT = 14 * MiB, WS_UP0 = 16 * MiB, WS_UP1 = 27 * MiB,
                 WS_DN0 = 38 * MiB, WS_DN1 = 44 * MiB, WS_LORA = 50 * MiB, WS_CW1K = 51 * MiB, WS_CW1V = 52 * MiB, WS_CBIAS = 53 * MiB;
constexpr size_t WS_H = 64 * MiB, WS_Z = 192 * MiB, WS_AP = 512 * MiB, WS_O = 544 * MiB, WS_L = 672 * MiB, WS_C = 864 * MiB, WS_MM = 896 * MiB;
constexpr size_t WS_HID = 672 * MiB, WS_KCMP = 688 * MiB, WS_VCMP = 690 * MiB, WS_U = 192 * MiB, WS_END = 1024 * MiB;
constexpr int LDS_BYTES = 163840;
constexpr int NPHASE = 23;

__device__ __forceinline__ float bf2f(unsigned u) { return __uint_as_float(u << 16); }
__device__ __forceinline__ unsigned pk2(float lo, float hi) { return pg8::cvt_pk_bf16(lo, hi); }
__device__ __forceinline__ float wave_sum(float v) {
#pragma unroll
    for (int o = 1; o < 64; o <<= 1) v += __shfl_xor(v, o);
    return v;
}
__device__ __forceinline__ float sigmoidf_(float x) { return 1.0f / (1.0f + __expf(-x)); }
#define LDS_WAIT() asm volatile("s_waitcnt lgkmcnt(0)" ::: "memory")

struct Args { const float* in[31]; float* out; unsigned char* ws; int ph_lo, ph_hi; };

__device__ __forceinline__ void transpose_item(const float* W, int N, bf16_t* WT, int ldt, LAS float* scr, int item, int nblk, int lane, const float* gk = nullptr) {
    const int kb = item / nblk, nb = item % nblk, k0 = 64 * kb, n0 = 32 * nb;
    const int n = n0 + (lane & 31);
#pragma unroll 8
    for (int i = 0; i < 32; ++i) { const int kk = 2 * i + (lane >> 5); scr[kk * 33 + (lane & 31)] = (n < N) ? W[(size_t)(k0 + kk) * N + n] * (gk ? gk[k0 + kk] : 1.f) : 0.f; }
    LDS_WAIT(); asm volatile("" ::: "memory");
    const int c = lane & 7;
#pragma unroll
    for (int j = 0; j < 4; ++j) { const int nn = (lane >> 3) + 8 * j; const LAS float* s = scr + (8 * c) * 33 + nn;
        u32x4 o; o.x = pk2(s[0 * 33], s[1 * 33]); o.y = pk2(s[2 * 33], s[3 * 33]); o.z = pk2(s[4 * 33], s[5 * 33]); o.w = pk2(s[6 * 33], s[7 * 33]);
        *(u32x4*)(WT + (size_t)(n0 + nn) * ldt + k0 + 8 * c) = o; }
    LDS_WAIT(); asm volatile("" ::: "memory");
}

__device__ __forceinline__ void norm_phase(const float* xf, const bf16_t* xb, const bf16_t* mm, const float* gpost, float* outf, bf16_t* outb, float* rs_out, int gw, int NGW, int lane) {
    for (int m = gw; m < M_; m += NGW) {
        f32x4 v[4];
        if (xf) { const f32x4* xr = (const f32x4*)(xf + (size_t)m * DM) + lane;
#pragma unroll
            for (int j = 0; j < 4; ++j) v[j] = xr[64 * j]; }
        else { const u32x2* xr = (const u32x2*)(xb + (size_t)m * DM) + lane;
#pragma unroll
            for (int j = 0; j < 4; ++j) { const u32x2 w = xr[64 * j]; v[j] = (f32x4){bf2f(w.x & 0xffffu), bf2f(w.x >> 16), bf2f(w.y & 0xffffu), bf2f(w.y >> 16)}; } }
        if (mm) {
            const u32x2* mr = (const u32x2*)(mm + (size_t)m * DM) + lane;
            f32x4 q[4]; float ss = 0.f;
#pragma unroll
            for (int j = 0; j < 4; ++j) { const u32x2 w = mr[64 * j]; q[j] = (f32x4){bf2f(w.x & 0xffffu), bf2f(w.x >> 16), bf2f(w.y & 0xffffu), bf2f(w.y >> 16)};
                ss += (q[j].x * q[j].x + q[j].y * q[j].y) + (q[j].z * q[j].z + q[j].w * q[j].w); }
            const float rs = rsqrtf(wave_sum(ss) * (1.f / DM) + NORM_EPS);
#pragma unroll
            for (int j = 0; j < 4; ++j) { const f32x4 g = *((const f32x4*)gpost + lane + 64 * j); v[j] = v[j] + q[j] * rs * g; }
        }
        if (outf) { f32x4* xo = (f32x4*)(outf + (size_t)m * DM) + lane;
#pragma unroll
            for (int j = 0; j < 4; ++j) xo[64 * j] = v[j]; }
        if (outb) { u32x2* xo = (u32x2*)(outb + (size_t)m * DM) + lane;
#pragma unroll
            for (int j = 0; j < 4; ++j) { u32x2 w; w.x = pk2(v[j].x, v[j].y); w.y = pk2(v[j].z, v[j].w); xo[64 * j] = w; } }
        if (rs_out) {
            float s2 = 0.f;
#pragma unroll
            for (int j = 0; j < 4; ++j) s2 += (v[j].x * v[j].x + v[j].y * v[j].y) + (v[j].z * v[j].z + v[j].w * v[j].w);
            const float rs2 = rsqrtf(wave_sum(s2) * (1.f / DM) + NORM_EPS);
            if (lane == 0) rs_out[m] = rs2;
        }
    }
}

constexpr int KROW = 144, VROW = 152, KT_BYTES = 64 * KROW, VT_BYTES = 64 * VROW;
constexpr float NEGBIG = -1e30f;
__device__ __forceinline__ int crow(int r, int hi) { return (r & 3) + 8 * (r >> 2) + 4 * hi; }
struct TileRegs { u32x4 k, v; };
__device__ __forceinline__ void tile_gload(TileRegs& r, const bf16_t* Kg, const bf16_t* Vg, size_t ld, int tid) {
    r.k = *(const u32x4*)(Kg + (size_t)(tid >> 3) * ld + (tid & 7) * 8);
    r.v = *(const u32x4*)(Vg + (size_t)(tid & 63) * ld + (tid >> 6) * 8);
}
__device__ __forceinline__ void tile_lstore(const TileRegs& r, LAS unsigned char* Ks, LAS unsigned char* Vs, int tid) {
    *(LAS u32x4*)(Ks + (tid >> 3) * KROW + (tid & 7) * 16) = r.k;
    LAS unsigned char* vb = Vs + ((tid >> 6) * 8) * VROW + (tid & 63) * 2;
    *(LAS unsigned short*)(vb + 0 * VROW) = (unsigned short)(r.v.x & 0xffffu); *(LAS unsigned short*)(vb + 1 * VROW) = (unsigned short)(r.v.x >> 16);
    *(LAS unsigned short*)(vb + 2 * VROW) = (unsigned short)(r.v.y & 0xffffu); *(LAS unsigned short*)(vb + 3 * VROW) = (unsigned short)(r.v.y >> 16);
    *(LAS unsigned short*)(vb + 4 * VROW) = (unsigned short)(r.v.z & 0xffffu); *(LAS unsigned short*)(vb + 5 * VROW) = (unsigned short)(r.v.z >> 16);
    *(LAS unsigned short*)(vb + 6 * VROW) = (unsigned short)(r.v.w & 0xffffu); *(LAS unsigned short*)(vb + 7 * VROW) = (unsigned short)(r.v.w >> 16);
}
constexpr float QSCALE = 0.125f * 1.4426950408889634f;
__device__ __forceinline__ void load_qfrag(bf16x8 (&qf)[4], const bf16_t* qrow, int hi) {
#pragma unroll
    for (int d0 = 0; d0 < 4; ++d0) { const u32x4 w = *(const u32x4*)(qrow + d0 * 16 + hi * 8);
        u32x4 o; o.x = pk2(bf2f(w.x & 0xffffu) * QSCALE, bf2f(w.x >> 16) * QSCALE); o.y = pk2(bf2f(w.y & 0xffffu) * QSCALE, bf2f(w.y >> 16) * QSCALE);
        o.z = pk2(bf2f(w.z & 0xffffu) * QSCALE, bf2f(w.z >> 16) * QSCALE); o.w = pk2(bf2f(w.w & 0xffffu) * QSCALE, bf2f(w.w >> 16) * QSCALE);
        qf[d0] = __builtin_bit_cast(bf16x8, o); }
}
constexpr float LOG2E = 1.4426950408889634f, RESCALE_THR = 14.f;
__device__ __forceinline__ float max3f(float a, float b, float c) { return fmaxf(fmaxf(a, b), c); }
template <int KSTEP>
__device__ __forceinline__ void attn_tile2(const LAS unsigned char* Ks, const LAS unsigned char* Vs, const bf16x8 (&qf)[4], f32x16 (&o)[2], float& mref, float& l,
                                           float basep, float ks2, int maskmode, int dl, int W, int r32, int hi, bool do_pv, f32x16* pout0, f32x16* pout1) {
    f32x16 s0, s1;
    const float off = ks2 * (float)(4 * hi) - basep;
#pragma unroll
    for (int r = 0; r < 16; ++r) { s0[r] = ks2 * (float)((r & 3) + 8 * (r >> 2)) + off; s1[r] = ks2 * (float)((r & 3) + 8 * (r >> 2) + 32) + off; }
#pragma unroll
    for (int d0 = 0; d0 < 4; ++d0) {
        const bf16x8 k0 = *(const LAS bf16x8*)(Ks + r32 * KROW + (d0 * 16 + hi * 8) * 2);
        const bf16x8 k1 = *(const LAS bf16x8*)(Ks + (32 + r32) * KROW + (d0 * 16 + hi * 8) * 2);
        s0 = __builtin_amdgcn_mfma_f32_32x32x16_bf16(k0, qf[d0], s0, 0, 0, 0);
        s1 = __builtin_amdgcn_mfma_f32_32x32x16_bf16(k1, qf[d0], s1, 0, 0, 0);
    }
    if (maskmode) {
        const int dl0 = dl - KSTEP * 4 * hi;
#pragma unroll
        for (int r = 0; r < 16; ++r) {
            const int d0 = dl0 - KSTEP * ((r & 3) + 8 * (r >> 2)), d1 = d0 - KSTEP * 32;
            const bool v0 = (!(maskmode & 1) || d0 >= 0) && (!(maskmode & 2) || d0 < W), v1 = (!(maskmode & 1) || d1 >= 0) && (!(maskmode & 2) || d1 < W);
            s0[r] = v0 ? s0[r] : NEGBIG; s1[r] = v1 ? s1[r] : NEGBIG;
        }
    }
    if (do_pv) {
        float mt = max3f(s0[0], s0[1], s1[0]);
        mt = max3f(mt, s1[1], s0[2]);
#pragma unroll
        for (int r = 2; r < 16; r += 2) { mt = max3f(mt, s0[r], s0[r + 1]); mt = max3f(mt, s1[r], s1[r + 1]); }
        mt = fmaxf(mt, __shfl_xor(mt, 32));
        if (__any(mt > RESCALE_THR)) {
            const float delta = fmaxf(mt, 0.f), sc = __builtin_amdgcn_exp2f(-delta);
            mref += delta; l *= sc;
#pragma unroll
            for (int r = 0; r < 16; ++r) { o[0][r] *= sc; o[1][r] *= sc; s0[r] -= delta; s1[r] -= delta; }
        }
    }
    float ps = 0.f;
#pragma unroll
    for (int r = 0; r < 16; ++r) { s0[r] = __builtin_amdgcn_exp2f(s0[r]); s1[r] = __builtin_amdgcn_exp2f(s1[r]); ps += s0[r] + s1[r]; }
    if (!do_pv) { *pout0 = s0; *pout1 = s1; return; }
    l += ps;
    bf16x8 pb[4];
    { u32x4 w; w.x = pk2(s0[0], s0[1]); w.y = pk2(s0[2], s0[3]); w.z = pk2(s0[4], s0[5]); w.w = pk2(s0[6], s0[7]); pb[0] = __builtin_bit_cast(bf16x8, w); }
    { u32x4 w; w.x = pk2(s0[8], s0[9]); w.y = pk2(s0[10], s0[11]); w.z = pk2(s0[12], s0[13]); w.w = pk2(s0[14], s0[15]); pb[1] = __builtin_bit_cast(bf16x8, w); }
    { u32x4 w; w.x = pk2(s1[0], s1[1]); w.y = pk2(s1[2], s1[3]); w.z = pk2(s1[4], s1[5]); w.w = pk2(s1[6], s1[7]); pb[2] = __builtin_bit_cast(bf16x8, w); }
    { u32x4 w; w.x = pk2(s1[8], s1[9]); w.y = pk2(s1[10], s1[11]); w.z = pk2(s1[12], s1[13]); w.w = pk2(s1[14], s1[15]); pb[3] = __builtin_bit_cast(bf16x8, w); }
#pragma unroll
    for (int dh = 0; dh < 2; ++dh) {
#pragma unroll
        for (int ks = 0; ks < 4; ++ks) {
            const LAS unsigned char* vp = Vs + (dh * 32 + r32) * VROW + (16 * ks + 4 * hi) * 2;
            const u32x2 lo = *(const LAS u32x2*)vp, hh = *(const LAS u32x2*)(vp + 16);
            const u32x4 a4 = (u32x4){lo.x, lo.y, hh.x, hh.y};
            o[dh] = __builtin_amdgcn_mfma_f32_32x32x16_bf16(__builtin_bit_cast(bf16x8, a4), pb[ks], o[dh], 0, 0, 0);
        }
        asm volatile("" ::: "memory");
    }
}
__device__ __forceinline__ void store_o(const f32x16 (&o)[2], bf16_t* orow, int hi) {
#pragma unroll
    for (int dh = 0; dh < 2; ++dh)
#pragma unroll
        for (int r4 = 0; r4 < 4; ++r4) { u32x2 w; w.x = pk2(o[dh][4 * r4], o[dh][4 * r4 + 1]); w.y = pk2(o[dh][4 * r4 + 2], o[dh][4 * r4 + 3]);
            *(u32x2*)(orow + dh * 32 + 8 * r4 + 4 * hi) = w; }
}

__device__ __forceinline__ void swa_unit(int u, const bf16_t* Z, bf16_t* O, const float* sinks, LAS unsigned char* lds, int tid) {
    const int g = u & 1, sb = (u >> 1) & 63, b = u >> 7;
    const int lane = tid & 63, w = tid >> 6, r32 = lane & 31, hi = lane >> 5;
    const int h = g * 4 + (w >> 1), t0 = sb * 64, t = t0 + (w & 1) * 32 + r32;
    const size_t mrow = (size_t)b * T_ + t;
    LAS unsigned char* Ks = lds; LAS unsigned char* Vs = lds + KT_BYTES;
    bf16x8 qf[4]; load_qfrag(qf, Z + mrow * ZLD0 + h * 64, hi);
    const float slope2 = exp2f(-(float)(h + 1)) * LOG2E;
    float mref = 0.f, l = hi == 0 ? __builtin_amdgcn_exp2f(sinks[h] * LOG2E) : 0.f;
    f32x16 o[2];
#pragma unroll
    for (int r = 0; r < 16; ++r) { o[0][r] = 0.f; o[1][r] = 0.f; }
    const int first = sb >= 2 ? 0 : 2 - sb;
    TileRegs tr;
    { const bf16_t* base = Z + ((size_t)b * T_ + t0) * ZLD0; tile_gload(tr, base + 512 + g * 64, base + 640 + g * 64, ZLD0, tid); }
    for (int ti = 2; ti >= first; --ti) {
        const int kp0 = t0 - 128 + 64 * ti;
        __syncthreads(); tile_lstore(tr, Ks, Vs, tid); __syncthreads();
        if (ti - 1 >= first) { const bf16_t* base = Z + ((size_t)b * T_ + kp0 - 64) * ZLD0; tile_gload(tr, base + 512 + g * 64, base + 640 + g * 64, ZLD0, tid); }
        const int dl = t - kp0;
        attn_tile2<1>(Ks, Vs, qf, o, mref, l, slope2 * (float)dl + mref, slope2, ti == 2 ? 1 : (ti == 0 ? 2 : 0), dl, 128, r32, hi, true, nullptr, nullptr);
    }
    l += __shfl_xor(l, 32);
    const float inv = 1.f / l;
#pragma unroll
    for (int r = 0; r < 16; ++r) { o[0][r] *= inv; o[1][r] *= inv; }
    store_o(o, O + mrow * DM + h * 64, hi);
}

constexpr int IMP_OFF = 19456, IMP_LD = 257, SELM_OFF = IMP_OFF + 64 * IMP_LD * 4  , UNI_OFF = SELM_OFF + 512;
__device__ __forceinline__ void nsa_unit(int u, const bf16_t* Z, const bf16_t* KC, const bf16_t* VC, bf16_t* O, LAS unsigned char* lds, int tid) {
    const int bg = u & 63, i = u >> 6, g = bg & 3, b = bg >> 2;
    const int lane = tid & 63, w = tid >> 6, r32 = lane & 31, hi = lane >> 5;
    const int hr = w >> 1, h = g * 4 + hr, t0 = i * 64, ql = (w & 1) * 32 + r32, t = t0 + ql;
    const size_t mrow = (size_t)b * T_ + t;
    LAS unsigned char* Ks = lds; LAS unsigned char* Vs = lds + KT_BYTES;
    LAS float* imp = (LAS float*)(lds + IMP_OFF);
    LAS unsigned* selm = (LAS unsigned*)(lds + SELM_OFF); LAS unsigned* uni = (LAS unsigned*)(lds + UNI_OFF);
    bf16x8 qf[4]; load_qfrag(qf, Z + mrow * ZLD1 + h * 64, hi);
    const float slope2 = exp2f(-0.5f * (float)(h + 1)) * LOG2E;
    const unsigned goff = (unsigned)(mrow * ZLD1) + 2560u + (unsigned)(h * 3);
    LAS float* park = (LAS float*)(lds + 86016) + tid;
    f32x16 o[2]; float mref, l; TileRegs tr;
    const size_t cbase = ((size_t)(b * 4 + g) * 256) * 64;
    const int ncv = min(4 * i + 3, 255), nct = (ncv + 63) >> 6;
    mref = 0.f; l = 0.f;
#pragma unroll
    for (int r = 0; r < 16; ++r) { o[0][r] = 0.f; o[1][r] = 0.f; }
    tile_gload(tr, KC + cbase + (size_t)(nct - 1) * 4096, VC + cbase + (size_t)(nct - 1) * 4096, 64, tid);
    for (int ti = nct - 1; ti >= 0; --ti) {
        __syncthreads(); tile_lstore(tr, Ks, Vs, tid); __syncthreads();
        if (ti > 0) tile_gload(tr, KC + cbase + (size_t)(ti - 1) * 4096, VC + cbase + (size_t)(ti - 1) * 4096, 64, tid);
        const int dl = t - 31 - 1024 * ti;
        attn_tile2<16>(Ks, Vs, qf, o, mref, l, slope2 * (float)dl + mref, 16.f * slope2, 1, dl, 0, r32, hi, true, nullptr, nullptr);
    }
    l += __shfl_xor(l, 32);
    const float invc = l > 0.f ? 1.f / l : 0.f;
    { const float wg = sigmoidf_(bf2f(Z[goff])) * invc;
#pragma unroll
      for (int r = 0; r < 16; ++r) { park[r * 512] = o[0][r] * wg; park[(16 + r) * 512] = o[1][r] * wg; } }
    if (i > 7) {
        tile_gload(tr, KC + cbase, VC + cbase, 64, tid);
        for (int ti = 0; ti < nct; ++ti) {
            __syncthreads(); tile_lstore(tr, Ks, Vs, tid); __syncthreads();
            if (ti + 1 < nct) tile_gload(tr, KC + cbase + (size_t)(ti + 1) * 4096, VC + cbase + (size_t)(ti + 1) * 4096, 64, tid);
            const int dl = t - 31 - 1024 * ti;
            f32x16 s0, s1; float dm = mref, dlq = 0.f;
            attn_tile2<16>(Ks, Vs, qf, o, dm, dlq, slope2 * (float)dl + mref, 16.f * slope2, 1, dl, 0, r32, hi, false, &s0, &s1);
            LAS float* ip = imp + ql * IMP_LD + ti * 64;
#pragma unroll
            for (int rr = 0; rr < 4; ++rr) {
                if (hr == rr) {
#pragma unroll
                    for (int r = 0; r < 16; ++r) { const int c = crow(r, hi);
                        if (rr == 0) { ip[c] = s0[r] * invc; ip[32 + c] = s1[r] * invc; } else { ip[c] += s0[r] * invc; ip[32 + c] += s1[r] * invc; } }
                }
                __syncthreads();
            }
        }
    }
    if (tid == 0) { uni[0] = 0u; uni[1] = 0u; }
    __syncthreads();
    if (tid < 64) {
        unsigned long long mask;
        if (i <= 7) mask = (2ull << i) - 1ull;
        else {
            float v0 = -1.f, v1 = -1.f, v2 = -1.f, v3 = -1.f, v4 = -1.f; int j0 = 0, j1 = 0, j2 = 0, j3 = 0, j4 = 0;
            const LAS float* ip = imp + tid * IMP_LD;
            for (int j = 1; j <= i - 2; ++j) {
                float v = ip[4 * j - 1] + 2.f * (ip[4 * j] + ip[4 * j + 1] + ip[4 * j + 2]) + ip[4 * j + 3]; int jj = j;
#define INS(vk, jk) if (v > vk) { const float tv = vk; const int tj = jk; vk = v; jk = jj; v = tv; jj = tj; }
                INS(v0, j0) INS(v1, j1) INS(v2, j2) INS(v3, j3) INS(v4, j4)
#undef INS
            }
            mask = 1ull | (1ull << i) | (1ull << (i - 1)) | (1ull << j0) | (1ull << j1) | (1ull << j2) | (1ull << j3) | (1ull << j4);
        }
        selm[2 * tid] = (unsigned)mask; selm[2 * tid + 1] = (unsigned)(mask >> 32);
        atomicOr((unsigned*)(uni), (unsigned)mask); atomicOr((unsigned*)(uni + 1), (unsigned)(mask >> 32));
    }
    __syncthreads();
    {
        unsigned long long um = (unsigned long long)uni[0] | ((unsigned long long)uni[1] << 32);
        mref = 0.f; l = 0.f;
#pragma unroll
        for (int r = 0; r < 16; ++r) { o[0][r] = 0.f; o[1][r] = 0.f; }
        int j = 63 - __builtin_clzll(um); um &= ~(1ull << j);
        { const bf16_t* base = Z + ((size_t)b * T_ + 64 * j) * ZLD1; tile_gload(tr, base + 1536 + g * 64, base + 1792 + g * 64, ZLD1, tid); }
        for (;;) {
            __syncthreads(); tile_lstore(tr, Ks, Vs, tid); __syncthreads();
            int jn = -1;
            if (um) { jn = 63 - __builtin_clzll(um); um &= ~(1ull << jn); }
            if (jn >= 0) { const bf16_t* base = Z + ((size_t)b * T_ + 64 * jn) * ZLD1; tile_gload(tr, base + 1536 + g * 64, base + 1792 + g * 64, ZLD1, tid); }
            const bool sel = (selm[2 * ql + (j >> 5)] >> (j & 31)) & 1u;
            const int dl = t - 64 * j;
            attn_tile2<1>(Ks, Vs, qf, o, mref, l, sel ? slope2 * (float)dl + mref : 1e30f, slope2, j == i ? 1 : 0, dl, 0, r32, hi, true, nullptr, nullptr);
            if (jn < 0) break;
            j = jn;
        }
        l += __shfl_xor(l, 32);
        const float wg = sigmoidf_(bf2f(Z[goff + 1])) / l;
#pragma unroll
        for (int r = 0; r < 16; ++r) { park[r * 512] += wg * o[0][r]; park[(16 + r) * 512] += wg * o[1][r]; }
    }
    {
        mref = 0.f; l = 0.f;
#pragma unroll
        for (int r = 0; r < 16; ++r) { o[0][r] = 0.f; o[1][r] = 0.f; }
        const int first = i >= 4 ? 0 : 4 - i;
        { const bf16_t* base = Z + ((size_t)b * T_ + t0) * ZLD1; tile_gload(tr, base + 2048 + g * 64, base + 2304 + g * 64, ZLD1, tid); }
        for (int ti = 4; ti >= first; --ti) {
            const int kp0 = t0 - 256 + 64 * ti;
            __syncthreads(); tile_lstore(tr, Ks, Vs, tid); __syncthreads();
            if (ti - 1 >= first) { const bf16_t* base = Z + ((size_t)b * T_ + kp0 - 64) * ZLD1; tile_gload(tr, base + 2048 + g * 64, base + 2304 + g * 64, ZLD1, tid); }
            const int dl = t - kp0;
            attn_tile2<1>(Ks, Vs, qf, o, mref, l, slope2 * (float)dl + mref, slope2, ti == 4 ? 1 : (ti == 0 ? 2 : 0), dl, 256, r32, hi, true, nullptr, nullptr);
        }
        l += __shfl_xor(l, 32);
        const float wg = sigmoidf_(bf2f(Z[goff + 2])) / l;
#pragma unroll
        for (int r = 0; r < 16; ++r) { o[0][r] = park[r * 512] + wg * o[0][r]; o[1][r] = park[(16 + r) * 512] + wg * o[1][r]; }
    }
    store_o(o, O + mrow * DM + h * 64, hi);
    __syncthreads();
}

__device__ __forceinline__ float dpp_xadd(float x, int which) {
    int r;
    const int xi = __float_as_int(x);
    if (which == 0) r = __builtin_amdgcn_update_dpp(0, xi, 0xB1, 0xf, 0xf, false);
    else if (which == 1) r = __builtin_amdgcn_update_dpp(0, xi, 0x4E, 0xf, 0xf, false);
    else if (which == 2) r = __builtin_amdgcn_update_dpp(0, xi, 0x141, 0xf, 0xf, false);
    else r = __builtin_amdgcn_update_dpp(0, xi, 0x140, 0xf, 0xf, false);
    return x + __int_as_float(r);
}
__device__ __forceinline__ float row16_sum(float x) { x = dpp_xadd(x, 0); x = dpp_xadd(x, 1); x = dpp_xadd(x, 2); x = dpp_xadd(x, 3); return x; }

#define UNPK4(w) (f32x4){bf2f((w).x & 0xffffu), bf2f((w).x >> 16), bf2f((w).y & 0xffffu), bf2f((w).y >> 16)}
#define PK4(v) (u32x2){pk2((v).x, (v).y), pk2((v).z, (v).w)}
__device__ __forceinline__ f32x4 sig4(f32x4 v) { return (f32x4){sigmoidf_(v.x), sigmoidf_(v.y), sigmoidf_(v.z), sigmoidf_(v.w)}; }
__device__ __forceinline__ void rwkv_prep(const Args& a, const bf16_t* Z, const bf16_t* L, bf16_t* KK, bf16_t* WR, bf16_t* WE, bf16_t* KKA, bf16_t* KT, bf16_t* VS, float* C, int gw, int NGW, int lane) {
    const int h = gw & 7, col = h * 64 + (lane & 15) * 4, q = lane >> 4;
    const f32x4 mu_r = *(const f32x4*)(a.in[8] + col), mu_k = *(const f32x4*)(a.in[8] + 512 + col), mu_v = *(const f32x4*)(a.in[8] + 1024 + col);
    const f32x4 w0 = *(const f32x4*)(a.in[9] + col), a0 = *(const f32x4*)(a.in[11] + col), k_k = *(const f32x4*)(a.in[14] + col), k_a = *(const f32x4*)(a.in[15] + col), r_k = *(const f32x4*)(a.in[16] + col);
    for (int m4 = gw >> 3; m4 < M_ / 4; m4 += NGW >> 3) {
        const int m = m4 * 4 + q;
        const bf16_t* zr = Z + (size_t)m * ZLD0 + 768 + col;
        f32x4 r = UNPK4(*(const u32x2*)zr), k = UNPK4(*(const u32x2*)(zr + 512)), v = UNPK4(*(const u32x2*)(zr + 1024));
        f32x4 rp = (f32x4){0.f, 0.f, 0.f, 0.f}, kp = rp, vp = rp;
        if ((m & (T_ - 1)) != 0) { rp = UNPK4(*(const u32x2*)(zr - ZLD0)); kp = UNPK4(*(const u32x2*)(zr + 512 - ZLD0)); vp = UNPK4(*(const u32x2*)(zr + 1024 - ZLD0)); }
        r += (rp - r) * mu_r; k += (kp - k) * mu_k; v += (vp - v) * mu_v;
        const f32x4 lw = UNPK4(*(const u32x2*)(L + (size_t)m * LLD + col)), la = UNPK4(*(const u32x2*)(L + (size_t)m * LLD + 512 + col));
        const f32x4 e = sig4(w0 + lw) * 0.60653065971f;
        const u32x2 eb = PK4(e);
        const f32x4 er = UNPK4(eb);
        const f32x4 wdec = (f32x4){__expf(-er.x), __expf(-er.y), __expf(-er.z), __expf(-er.w)};
        const f32x4 av = sig4(a0 + la);
        f32x4 kk = k * k_k;
        const float nrm = sqrtf(row16_sum((kk.x * kk.x + kk.y * kk.y) + (kk.z * kk.z + kk.w * kk.w)));
        kk = kk * (1.f / fmaxf(nrm, 1e-12f));
        const f32x4 kt = k * (1.f + (av - 1.f) * k_a);
        const f32x4 kka = kk * av;
        const f32x4 t1 = kka * r, t2 = kt * r, t3 = t2 * r_k;
        const float c1 = row16_sum((t1.x + t1.y) + (t1.z + t1.w)), c2 = row16_sum((t2.x + t2.y) + (t2.z + t2.w)), c3 = row16_sum((t3.x + t3.y) + (t3.z + t3.w));
        const size_t o = (size_t)m * 512 + col;
        const f32x4 wr = wdec * r;
        *(u32x2*)(KK + o) = PK4(kk); *(u32x2*)(WR + o) = PK4(wr); *(u32x2*)(WE + o) = eb;
        *(u32x2*)(KKA + o) = PK4(kka); *(u32x2*)(KT + o) = PK4(kt); *(u32x2*)(VS + o) = PK4(v);
        if ((lane & 15) == 0) *(f32x4*)(C + (size_t)m * 32 + h * 4) = (f32x4){c1, c2, c3, 0.f};
    }
}

constexpr int SC_TS = 32, SC_BUF = 5 * SC_TS * 64 + SC_TS * 32 + SC_TS * 2;
__device__ __forceinline__ void scan_unit(int u, const bf16_t* KK, const bf16_t* WR, const bf16_t* WE, const bf16_t* KKA, const bf16_t* KT, const bf16_t* VS, const float* C, float* Y, LAS unsigned char* lds, int tid) {
    const int half = u & 1, h = (u >> 1) & 7, b = u >> 4;
    const int il = tid >> 4, jg = tid & 15;
    LAS float* buf0 = (LAS float*)lds; LAS float* buf1 = buf0 + SC_BUF; LAS float* ybuf = buf1 + SC_BUF;
    float S0 = 0.f, S1 = 0.f, S2 = 0.f, S3 = 0.f;
    const size_t rowbase = (size_t)b * T_;
    const size_t goff = (rowbase + il) * 512 + h * 64 + jg * 4;
    const size_t voff = (rowbase + il) * 512 + h * 64 + half * 32 + jg * 2;
    u32x2 rkk, rwr, rwe, rkka, rkt; unsigned rv; f32x2 rc;
#define SC_GLOAD(t0) do { const size_t d_ = (size_t)(t0) * 512; rkk = *(const u32x2*)(KK + goff + d_); rwr = *(const u32x2*)(WR + goff + d_); rwe = *(const u32x2*)(WE + goff + d_); \
        rkka = *(const u32x2*)(KKA + goff + d_); rkt = *(const u32x2*)(KT + goff + d_); rv = *(const unsigned*)(VS + voff + d_); \
        if (tid < SC_TS) rc = *(const f32x2*)(C + (rowbase + (t0) + tid) * 32 + h * 4); } while (0)
#define SC_EXP4(w) (f32x4){bf2f((w).x & 0xffffu), bf2f((w).x >> 16), bf2f((w).y & 0xffffu), bf2f((w).y >> 16)}
#define SC_LSTORE(bf) do { LAS float* p_ = (bf) + il * 64 + jg * 4; *(LAS f32x4*)(p_) = SC_EXP4(rkk); *(LAS f32x4*)(p_ + 2048) = SC_EXP4(rwr); \
        { f32x4 e_ = SC_EXP4(rwe); *(LAS f32x4*)(p_ + 4096) = (f32x4){__expf(-e_.x), __expf(-e_.y), __expf(-e_.z), __expf(-e_.w)}; } \
        *(LAS f32x4*)(p_ + 6144) = SC_EXP4(rkka); *(LAS f32x4*)(p_ + 8192) = SC_EXP4(rkt); \
        *(LAS f32x2*)((bf) + 10240 + il * 32 + jg * 2) = (f32x2){bf2f(rv & 0xffffu), bf2f(rv >> 16)}; \
        if (tid < SC_TS) *(LAS f32x2*)((bf) + 11264 + tid * 2) = rc; } while (0)
    __syncthreads();
    SC_GLOAD(0); SC_LSTORE(buf0);
    __syncthreads();
    for (int n = 0; n < T_ / SC_TS; ++n) {
        LAS float* cb = (n & 1) ? buf1 : buf0; LAS float* nb = (n & 1) ? buf0 : buf1;
        if (n + 1 < T_ / SC_TS) SC_GLOAD((n + 1) * SC_TS);
#pragma unroll 8
        for (int s = 0; s < SC_TS; ++s) {
            const LAS float* B = cb + s * 64 + jg * 4;
            const f32x4 kk = *(const LAS f32x4*)B, wr = *(const LAS f32x4*)(B + 2048), w = *(const LAS f32x4*)(B + 4096), kka = *(const LAS f32x4*)(B + 6144), kt = *(const LAS f32x4*)(B + 8192);
            const float v = cb[10240 + s * 32 + il]; const f32x2 c = *(const LAS f32x2*)(cb + 11264 + s * 2);
            float sa = (S0 * kk.x + S1 * kk.y) + (S2 * kk.z + S3 * kk.w);
            float uu = (S0 * wr.x + S1 * wr.y) + (S2 * wr.z + S3 * wr.w);
            sa = row16_sum(sa); uu = row16_sum(uu);
            const float y = uu - sa * c.x + v * c.y;
            if (jg == 0) ybuf[s * 32 + il] = y;
            S0 = S0 * w.x + (v * kt.x - sa * kka.x); S1 = S1 * w.y + (v * kt.y - sa * kka.y);
            S2 = S2 * w.z + (v * kt.z - sa * kka.z); S3 = S3 * w.w + (v * kt.w - sa * kka.w);
        }
        __syncthreads();
        if (n + 1 < T_ / SC_TS) SC_LSTORE(nb);
        { const f32x2 yv = *(const LAS f32x2*)(ybuf + il * 32 + jg * 2);
          *(f32x2*)(Y + (rowbase + (size_t)n * SC_TS + il) * 512 + h * 64 + half * 32 + jg * 2) = yv; }
        __syncthreads();
    }
#undef SC_GLOAD
#undef SC_EXP4
#undef SC_LSTORE
}

__device__ __forceinline__ void rwkv_post(const Args& a, const float* Y, const bf16_t* VS, const bf16_t* L, const float* C, bf16_t* O, int gw, int NGW, int lane) {
    const int h = gw & 7, col = h * 64 + (lane & 15) * 4, q = lane >> 4;
    const f32x4 lg = *(const f32x4*)(a.in[17] + col), lb = *(const f32x4*)(a.in[18] + col);
    for (int m4 = gw >> 3; m4 < M_ / 4; m4 += NGW >> 3) {
        const int m = m4 * 4 + q;
        const f32x4 y = *(const f32x4*)(Y + (size_t)m * 512 + col);
        const float mean = row16_sum((y.x + y.y) + (y.z + y.w)) * (1.f / 64.f); const f32x4 d = y - mean;
        const float var = row16_sum((d.x * d.x + d.y * d.y) + (d.z * d.z + d.w * d.w)) * (1.f / 64.f);
        const f32x4 yn = d * rsqrtf(var + GN_EPS) * lg + lb;
        const f32x4 v = UNPK4(*(const u32x2*)(VS + (size_t)m * 512 + col)), g = UNPK4(*(const u32x2*)(L + (size_t)m * LLD + 1024 + col));
        const float c3 = C[(size_t)m * 32 + h * 4 + 2];
        const f32x4 ov = (yn + v * c3) * g;
        *(u32x2*)(O + (size_t)m * DM + 512 + col) = PK4(ov);
    }
}

#define XB_TMO      128
#define XB_XCNT(j)  (256  + 64 * (j))
#define XB_XSUB(j)  (1280 + 64 * (j))
#define XB_XGEN(j)  (2304 + 64 * (j))
#define XB_TOP      3328
#define XB_TOPGEN   3392
#define XCD_BAR_WORDS 3456
#define XB_SPIN_CAP (1u << 18)

__device__ __forceinline__ unsigned xb_ld(unsigned* p)              { return __hip_atomic_load(p, __ATOMIC_RELAXED, __HIP_MEMORY_SCOPE_AGENT); }
__device__ __forceinline__ unsigned xb_add(unsigned* p, unsigned v) { return __hip_atomic_fetch_add(p, v, __ATOMIC_RELAXED, __HIP_MEMORY_SCOPE_AGENT); }
__device__ __forceinline__ unsigned xb_xcc_id() { return (unsigned)__builtin_amdgcn_s_getreg((3 << 11) | 20) & 0xFu; }
#define XB_SPIN(cond, bar) do { unsigned _sp = 0; while (cond) { __builtin_amdgcn_s_sleep(1); \
    if ((++_sp & 255u) == 0u) { if (xb_ld(&(bar)[XB_TMO])) break; if (_sp > XB_SPIN_CAP) { atomicAdd(&(bar)[XB_TMO], 1u); break; } } } } while (0)
struct XcdBarrier {
    unsigned* bar; unsigned x;
    volatile LAS unsigned* st;
};

__device__ __forceinline__ XcdBarrier xcd_barrier_post(unsigned* bar, volatile LAS unsigned* st) {
    XcdBarrier b; b.bar = bar; b.x = xb_xcc_id(); b.st = st;
    if (threadIdx.x == 0) (void)xb_add(&bar[XB_XCNT(b.x)], 1u);
    return b;
}
__device__ __forceinline__ void xcd_barrier_complete(unsigned* bar, unsigned x, unsigned& nloc, unsigned& nx) {
    const unsigned G = gridDim.x * gridDim.y * gridDim.z;
    unsigned sum, cnt, mine, sp = 0u;
    for (;;) {
        sum = 0u; cnt = 0u; mine = 0u;
#pragma unroll
        for (unsigned j = 0; j < 16; ++j) { const unsigned c = xb_ld(&bar[XB_XCNT(j)]); sum += c; cnt += (c > 0u) ? 1u : 0u; mine = (j == x) ? c : mine; }
        if (sum == G) break;
        __builtin_amdgcn_s_sleep(1);
        if ((++sp & 255u) == 0u) { if (xb_ld(&bar[XB_TMO])) break; if (sp > XB_SPIN_CAP) { atomicAdd(&bar[XB_TMO], 1u); break; } }
    }
    nloc = mine > 0u ? mine : 1u; nx = cnt > 0u ? cnt : 1u;
}

__device__ __forceinline__ void xcd_barrier(const XcdBarrier& b) {
    asm volatile("s_waitcnt vmcnt(0)" ::: "memory");
    __syncthreads();
    if (threadIdx.x == 0) {
        unsigned* bar = b.bar;
        __builtin_amdgcn_s_waitcnt(0);
        unsigned nloc = b.st[0], nx = b.st[1];
        if (nloc == 0u) { xcd_barrier_complete(bar, b.x, nloc, nx); b.st[0] = nloc; b.st[1] = nx; }
        const unsigned old = xb_add(&bar[XB_XSUB(b.x)], 1u);
        const unsigned gen = old / nloc;
        if (old + 1u == (gen + 1u) * nloc) {
            __builtin_amdgcn_fence(__ATOMIC_RELEASE, "agent");
            asm volatile("s_waitcnt vmcnt(0)" ::: "memory");
            const unsigned og = xb_add(&bar[XB_TOP], 1u);
            const unsigned tg = og / nx;
            if (og + 1u == (tg + 1u) * nx) xb_add(&bar[XB_TOPGEN], 1u);
            else XB_SPIN(xb_ld(&bar[XB_TOPGEN]) == tg, bar);
            __builtin_amdgcn_fence(__ATOMIC_ACQUIRE, "agent");
            xb_add(&bar[XB_XGEN(b.x)], 1u);
            asm volatile("s_waitcnt vmcnt(0)" ::: "memory");
        } else {
            XB_SPIN(xb_ld(&bar[XB_XGEN(b.x)]) == gen, bar);
            __builtin_amdgcn_fence(__ATOMIC_ACQUIRE, "agent");
            asm volatile("s_waitcnt vmcnt(0)" ::: "memory");
        }
    }
    __syncthreads();
}

__device__ __forceinline__ void run_gemm0(LAS unsigned char* lds, const bf16_t* A, const bf16_t* Bt, int M, int N, int K, int lda, bf16_t* Oo, int ldc, const float* rscale = nullptr) {
    pg8::Gemm g{A, Bt, M, N, K, lda, (size_t)128, 0}; pg8::StaticOrder S; S.init(M, N, (int)gridDim.x, (int)blockIdx.x);
    pg8::EpiStore<0> E{Oo, ldc, nullptr, rscale};

#ifndef NO_GEMM
    pg8::gemm_phase<pg8::EpiStore<0>, pg8::StaticOrder, true, true>(lds, g, S, E);
#endif
}


#define Wt_hyin ((bf16_t*)(ws + WS_HYIN))
#define Wt_hyout ((bf16_t*)(ws + WS_HYOUT))
#define Wt_nsain ((bf16_t*)(ws + WS_NSAIN))
#define Wt_nsaout ((bf16_t*)(ws + WS_NSAOUT))
#define Wt_lora ((bf16_t*)(ws + WS_LORA))
#define Wt_cw1k ((bf16_t*)(ws + WS_CW1K))
#define Wt_cw1v ((bf16_t*)(ws + WS_CW1V))
#define cbias ((float*)(ws + WS_CBIAS))
#define W2T ((bf16_t*)(ws + WS_CBIAS + 4096))
#define RS ((float*)(ws + WS_CBIAS + 131072))
#define H ((bf16_t*)(ws + WS_H))
#define Z ((bf16_t*)(ws + WS_Z))
#define AP ((bf16_t*)(ws + WS_AP))
#define O ((bf16_t*)(ws + WS_O))
#define L ((bf16_t*)(ws + WS_L))
#define C ((float*)(ws + WS_C))
#define MM ((bf16_t*)(ws + WS_MM))
#define Y ((float*)(ws + WS_MM))
#define HID ((bf16_t*)(ws + WS_HID))
#define KC ((bf16_t*)(ws + WS_KCMP))
#define VC ((bf16_t*)(ws + WS_VCMP))
#define U ((bf16_t*)(ws + WS_U))
#define KK ((bf16_t*)(ws + WS_H))
#define WR (KK + (size_t)M_ * 512)
#define WE ((bf16_t*)args.out)
#define KKA (WE + (size_t)M_ * 512)
#define KT (WE + (size_t)M_ * 1024)
#define VS (WE + (size_t)M_ * 1536)
#define XIN (args.in[0])
#define X (args.out)
#define PH_BEGIN unsigned char* ws = args.ws; asm volatile("" : "+s"(ws)); int tid_ = threadIdx.x; asm volatile("" : "+v"(tid_)); const int tid = tid_, lane = tid & 63, wave = __builtin_amdgcn_readfirstlane(tid >> 6); const int G = gridDim.x, gw = blockIdx.x * 8 + wave, NGW = G * 8; const int gtid = blockIdx.x * 512 + tid, NT = G * 512; (void)lane; (void)gw; (void)NGW; (void)gtid; (void)NT; (void)ws;
__global__ void __launch_bounds__(512, 2) mega_fwd(Args args) {
    extern __shared__ __attribute__((aligned(16))) unsigned char lds_raw[];
    LAS unsigned char* lds = (LAS unsigned char*)lds_raw;
    cg::grid_group grid = cg::this_grid();
    volatile LAS unsigned* xst = (volatile LAS unsigned*)(lds + LDS_BYTES - 64);
    if (threadIdx.x < 2) xst[threadIdx.x] = 0u;
    __syncthreads();
    const XcdBarrier xbar = xcd_barrier_post((unsigned*)args.ws, xst);
    const int lo = args.ph_lo, hi = args.ph_hi;
#define IN(k) (lo <= (k) && (k) < hi)
#ifndef DUP_MASK
#define DUP_MASK 0u
#endif
#define REP(k) for (int rep_ = 0; rep_ < (((DUP_MASK >> (k)) & 1u) ? 2 : 1); ++rep_)
#define SEAM(k) do { if (IN(k) && IN((k) + 1)) { if ((k) == 0) grid.sync(); else xcd_barrier(xbar); } } while (0)

#ifdef EXTRA_SYNCS
    if (IN(0) && IN(1)) for (int es_ = 0; es_ < EXTRA_SYNCS; ++es_) grid.sync();
#endif
    if (IN(0)) REP(0) { PH_BEGIN
        LAS float* scr = (LAS float*)(lds + wave * 16384);
        constexpr int I0 = 16 * 80, I1 = 16 * 32, I2 = 16 * 88, I3 = 16 * 32, I4 = 16 * 176, I5 = 44 * 32, I6 = 32 * 8;
        constexpr int NIT = I0 + I1 + I2 + I3 + 2 * I4 + 2 * I5 + 2 * I6;
        for (int it = gw; it < NIT; it += NGW) {
            int r = it;
            if (r < I0) { transpose_item(args.in[5], 2560, Wt_hyin, 1024, scr, r, 80, lane, args.in[1]); continue; } r -= I0;
            if (r < I1) { transpose_item(args.in[6], 1024, Wt_hyout, 1024, scr, r, 32, lane); continue; } r -= I1;
            if (r < I2) { transpose_item(args.in[19], 2608, Wt_nsain, 1024, scr, r, 88, lane, args.in[1] + 1024); continue; } r -= I2;
            if (r < I3) { transpose_item(args.in[20], 1024, Wt_nsaout, 1024, scr, r, 32, lane); continue; } r -= I3;
            if (r < 2 * I4) { const int l = r / I4; transpose_item(args.in[27] + (size_t)l * 1024 * 5632, 5632, (bf16_t*)(ws + (l ? WS_UP1 : WS_UP0)), 1024, scr, r % I4, 176, lane, args.in[3] + l * 1024); continue; } r -= 2 * I4;
            if (r < 2 * I5) { const int l = r / I5; transpose_item(args.in[30] + (size_t)l * 2816 * 1024, 1024, (bf16_t*)(ws + (l ? WS_DN1 : WS_DN0)), 2816, scr, r % I5, 32, lane); continue; } r -= 2 * I5;
            if (r < I6) { transpose_item(args.in[22], 256, Wt_cw1k, 2048, scr, r, 8, lane); continue; } r -= I6;
            transpose_item(args.in[25], 256, Wt_cw1v, 2048, scr, r, 8, lane);
        }
        for (int e = gtid; e < 1536 * 256; e += NT) {
            const int n = e >> 8, k = e & 255; float v = 0.f;
            if (n < 512) { if (k < 64) v = args.in[10][k * 512 + n]; }
            else if (n < 1024) { if (k >= 64 && k < 128) v = args.in[12][(k - 64) * 512 + (n - 512)]; }
            else { if (k >= 128) v = args.in[13][(k - 128) * 512 + (n - 1024)]; }
            Wt_lora[e] = (bf16_t)(pk2(v, 0.f) & 0xffffu);
        }
        for (int e = gtid; e < 2 * 16384; e += NT) { const int which = e >> 14, d = (e >> 8) & 63, f = e & 255; W2T[e] = (bf16_t)(pk2(args.in[which ? 26 : 23][f * 64 + d], 0.f) & 0xffffu); }
        for (int it = gw; it < 512; it += NGW) {
            const int which = it >> 8, f = it & 255; const float* pos = args.in[which ? 24 : 21]; const float* w1 = args.in[which ? 25 : 22];
            float s = 0.f;
            for (int e = lane; e < 2048; e += 64) s += pos[e] * w1[(size_t)e * 256 + f];
            s = wave_sum(s);
            if (lane == 0) cbias[it] = s;
        }
        norm_phase(XIN, nullptr, nullptr, nullptr, nullptr, H, RS, gw, NGW, lane);
    }
    SEAM(0);
    if (IN(1)) REP(1) { PH_BEGIN run_gemm0(lds, H, Wt_hyin, M_, ZLD0, 1024, 1024, Z, ZLD0, RS); }
    SEAM(1);
    if (IN(2)) REP(2) { PH_BEGIN
        const float* mu = args.in[8];
        for (int it = gtid; it < M_ * 32; it += NT) {
            const int m = it >> 5, col = (it & 31) * 8;
            const bf16_t* zp = Z + (size_t)m * ZLD0 + 2304 + col;
            const u32x4 zc = *(const u32x4*)zp; u32x4 zq = (u32x4){0u, 0u, 0u, 0u};
            if ((m & (T_ - 1)) != 0) zq = *(const u32x4*)(zp - ZLD0);
            const unsigned cw[4] = {zc.x, zc.y, zc.z, zc.w}, pw[4] = {zq.x, zq.y, zq.z, zq.w}; unsigned ow[4];
#pragma unroll
            for (int e = 0; e < 4; ++e) {
                float a0 = bf2f(cw[e] & 0xffffu), a1 = bf2f(cw[e] >> 16); const float p0 = bf2f(pw[e] & 0xffffu), p1 = bf2f(pw[e] >> 16);
                a0 += (p0 - a0) * mu[1536 + col + 2 * e]; a1 += (p1 - a1) * mu[1536 + col + 2 * e + 1];
                if (col < 64) { a0 = tanhf(a0); a1 = tanhf(a1); } else if (col >= 128) { a0 = sigmoidf_(a0); a1 = sigmoidf_(a1); }
                ow[e] = pk2(a0, a1);
            }
            *(u32x4*)(AP + (size_t)m * 256 + col) = (u32x4){ow[0], ow[1], ow[2], ow[3]};
        }

#ifndef NO_SWA
for (int u = blockIdx.x; u < NB_ * 64 * 2; u += G) swa_unit(u, Z, O, args.in[7], lds, tid);
#endif

        __syncthreads();
    }
    SEAM(2);
    if (IN(3)) REP(3) { PH_BEGIN run_gemm0(lds, AP, Wt_lora, M_, LLD, 256, 256, L, LLD); }
    SEAM(3);
    if (IN(4)) REP(4) { PH_BEGIN rwkv_prep(args, Z, L, KK, WR, WE, KKA, KT, VS, C, gw, NGW, lane); }
    SEAM(4);
    if (IN(5)) REP(5) { PH_BEGIN
#ifndef NO_SCAN
for (int u = blockIdx.x; u < 256; u += G) scan_unit(u, KK, WR, WE, KKA, KT, VS, C, Y, lds, tid);
#endif
 }
    SEAM(5);
    if (IN(6)) REP(6) { PH_BEGIN rwkv_post(args, Y, VS, L, C, O, gw, NGW, lane); }
    SEAM(6);
    if (IN(7)) REP(7) { PH_BEGIN run_gemm0(lds, O, Wt_hyout, M_, 1024, 1024, 1024, MM, 1024); }
    SEAM(7);
    if (IN(8)) REP(8) { PH_BEGIN norm_phase(XIN, nullptr, MM, args.in[2], nullptr, H, RS, gw, NGW, lane); }
    SEAM(8);
#pragma unroll
    for (int l = 0; l < 2; ++l) {
        const int pb = l ? 19 : 9;
        if (IN(pb)) REP(pb) { PH_BEGIN run_gemm0(lds, H, (const bf16_t*)(ws + (l ? WS_UP1 : WS_UP0)), M_, ULD, 1024, 1024, U, ULD, RS); }
        SEAM(pb);
        if (IN(pb + 1)) REP(pb + 1) { PH_BEGIN
            const float* cw = args.in[28] + (size_t)l * 3 * FF_; const float* cbv = args.in[29] + (size_t)l * FF_;
            for (int it = gtid; it < (M_ / 16) * (FF_ / 8); it += NT) {
                const int run = it / (FF_ / 8), f = (it - run * (FF_ / 8)) * 8, m0 = run * 16;
                f32x4 w0a = *(const f32x4*)(cw + f), w0b = *(const f32x4*)(cw + f + 4), w1a = *(const f32x4*)(cw + FF_ + f), w1b = *(const f32x4*)(cw + FF_ + f + 4);
                f32x4 w2a = *(const f32x4*)(cw + 2 * FF_ + f), w2b = *(const f32x4*)(cw + 2 * FF_ + f + 4), cba = *(const f32x4*)(cbv + f), cbb = *(const f32x4*)(cbv + f + 4);
                bf16_t* up = U + (size_t)m0 * ULD + f;
                u32x4 g1 = (u32x4){0u, 0u, 0u, 0u}, g2 = g1;
                if ((m0 & (T_ - 1)) != 0) { g1 = *(const u32x4*)(up - ULD); g2 = *(const u32x4*)(up - 2 * ULD); }
                f32x4 p1a = UNPK4(((u32x2){g1.x, g1.y})), p1b = UNPK4(((u32x2){g1.z, g1.w})), p2a = UNPK4(((u32x2){g2.x, g2.y})), p2b = UNPK4(((u32x2){g2.z, g2.w}));
#pragma unroll 4
                for (int rr = 0; rr < 16; ++rr) {
                    const u32x4 g0 = *(const u32x4*)(up + (size_t)rr * ULD), vv = *(const u32x4*)(up + (size_t)rr * ULD + FF_);
                    const f32x4 ca = UNPK4(((u32x2){g0.x, g0.y})), cb4 = UNPK4(((u32x2){g0.z, g0.w}));
                    const f32x4 va = UNPK4(((u32x2){vv.x, vv.y})), vb = UNPK4(((u32x2){vv.z, vv.w}));
                    const f32x4 xa = cba + ca * w2a + p1a * w1a + p2a * w0a, xb = cbb + cb4 * w2b + p1b * w1b + p2b * w0b;
                    const f32x4 oa = (f32x4){pg8::gelu_tanh(xa.x), pg8::gelu_tanh(xa.y), pg8::gelu_tanh(xa.z), pg8::gelu_tanh(xa.w)} * va;
                    const f32x4 ob = (f32x4){pg8::gelu_tanh(xb.x), pg8::gelu_tanh(xb.y), pg8::gelu_tanh(xb.z), pg8::gelu_tanh(xb.w)} * vb;
                    const u32x2 oa2 = PK4(oa), ob2 = PK4(ob);
                    *(u32x4*)(up + (size_t)rr * ULD + FF_) = (u32x4){oa2.x, oa2.y, ob2.x, ob2.y};
                    p2a = p1a; p2b = p1b; p1a = ca; p1b = cb4;
                }
            }
        }
        SEAM(pb + 1);
        if (IN(pb + 2)) REP(pb + 2) { PH_BEGIN run_gemm0(lds, U + FF_, (const bf16_t*)(ws + (l ? WS_DN1 : WS_DN0)), M_, 1024, FF_, ULD, MM, 1024); }
        SEAM(pb + 2);
        if (IN(pb + 3)) REP(pb + 3) { PH_BEGIN
            if (l == 0) norm_phase(nullptr, H, MM, args.in[4], nullptr, H, RS, gw, NGW, lane);
            else norm_phase(nullptr, H, MM, args.in[4] + 1024, X, nullptr, nullptr, gw, NGW, lane);
        }
        if (l == 0) {
            SEAM(12);
            if (IN(13)) REP(13) { PH_BEGIN run_gemm0(lds, H, Wt_nsain, M_, ZLD1, 1024, 1024, Z, ZLD1, RS); }
            SEAM(13);
            if (IN(14)) REP(14) { PH_BEGIN
                const int G2 = G >> 1, which = (int)blockIdx.x >= G2 ? 1 : 0;
                pg8::Gemm g{Z + 1024 + which * 256, which ? Wt_cw1v : Wt_cw1k, 16384, 256, 2048, 16 * ZLD1, (size_t)ZLD1 * 2, 1};
                pg8::StaticOrder S; S.init(16384, 256, G2, (int)blockIdx.x - which * G2);
                pg8::EpiStore<2> E{HID + (size_t)which * 16384 * 256, 256, cbias + which * 256, nullptr};

#ifndef NO_GEMM2
if ((int)blockIdx.x < 2 * G2) pg8::gemm_phase<pg8::EpiStore<2>, pg8::StaticOrder, true, true>(lds, g, S, E);
#endif

            }
            SEAM(14);
            if (IN(15)) REP(15) { PH_BEGIN
                for (int wt = gw; wt < 2 * 512; wt += NGW) {
                    const int which = wt >> 9, row0 = (wt & 511) * 32, r32 = lane & 31, hi5 = lane >> 5;
                    const bf16_t* hp = HID + ((size_t)which * 16384 + row0 + r32) * 256 + hi5 * 8;
                    const bf16_t* wp = W2T + (size_t)which * 16384 + (size_t)r32 * 256 + hi5 * 8;
                    f32x16 c0, c1;
#pragma unroll
                    for (int r = 0; r < 16; ++r) { c0[r] = 0.f; c1[r] = 0.f; }
#pragma unroll 4
                    for (int ks = 0; ks < 16; ++ks) {
                        const bf16x8 av = *(const bf16x8*)(hp + ks * 16), b0 = *(const bf16x8*)(wp + ks * 16), b1 = *(const bf16x8*)(wp + 32 * 256 + ks * 16);
                        c0 = __builtin_amdgcn_mfma_f32_32x32x16_bf16(av, b0, c0, 0, 0, 0);
                        c1 = __builtin_amdgcn_mfma_f32_32x32x16_bf16(av, b1, c1, 0, 0, 0);
                    }
                    bf16_t* op = (which ? VC : KC) + (size_t)row0 * 64 + r32;
#pragma unroll
                    for (int r = 0; r < 16; ++r) { const int rw = crow(r, hi5); op[(size_t)rw * 64] = (bf16_t)(pk2(c0[r], 0.f) & 0xffffu); op[(size_t)rw * 64 + 32] = (bf16_t)(pk2(c1[r], 0.f) & 0xffffu); }
                }
            }
            SEAM(15);
            if (IN(16)) REP(16) { PH_BEGIN
#ifndef NO_NSA
for (int u = blockIdx.x; u < 64 * 64; u += G) nsa_unit(u, Z, KC, VC, O, lds, tid);
#endif
 }
            SEAM(16);
            if (IN(17)) REP(17) { PH_BEGIN run_gemm0(lds, O, Wt_nsaout, M_, 1024, 1024, 1024, MM, 1024); }
            SEAM(17);
            if (IN(18)) REP(18) { PH_BEGIN norm_phase(nullptr, H, MM, args.in[2] + 1024, nullptr, H, RS, gw, NGW, lane); }
            SEAM(18);
        }
    }
#undef IN
#undef SEAM
}

#undef XIN
#undef X
#undef H
#undef Z
#undef O
#undef L
#undef C
#undef U
#undef Y
extern "C" void kernel_launch(void* const* d_in, const int* in_sizes, int n_in, void* d_out, int out_size, void* d_ws, size_t ws_size, hipStream_t stream) {
    static int grid = 0;
    if (grid == 0) {
        if (n_in != 31 || out_size != M_ * DM || ws_size < WS_END) { fprintf(stderr, "kernel_launch: unexpected shapes (n_in %d out %d ws %zu)\n", n_in, out_size, ws_size); grid = -1; return; }
        int dev = 0, cus = 0, per_cu = 0;
        hipGetDevice(&dev); hipDeviceGetAttribute(&cus, hipDeviceAttributeMultiprocessorCount, dev);
        hipFuncSetAttribute((const void*)mega_fwd, hipFuncAttributeMaxDynamicSharedMemorySize, LDS_BYTES);
        hipOccupancyMaxActiveBlocksPerMultiprocessor(&per_cu, (const void*)mega_fwd, 512, LDS_BYTES);
        if (per_cu < 1) { fprintf(stderr, "kernel_launch: occupancy query says %d blocks/CU\n", per_cu); per_cu = 1; }
        (void)hipGetLastError();
        grid = cus * 1;
    }
    if (grid < 0) return;
    hipMemsetAsync(d_ws, 0, 16384, stream);
    Args a{};
    for (int i = 0; i < 31; ++i) a.in[i] = (const float*)d_in[i];
    a.out = (float*)d_out; a.ws = (unsigned char*)d_ws;
#if ONE_LAUNCH
    a.ph_lo = 0; a.ph_hi = NPHASE;
    void* kargs[] = {&a};
    hipError_t e = hipLaunchCooperativeKernel((const void*)mega_fwd, dim3(grid), dim3(512), kargs, LDS_BYTES, stream);
    if (e != hipSuccess) fprintf(stderr, "cooperative launch failed: %s (grid %d)\n", hipGetErrorString(e), grid);
#else
    for (int p = 0; p < NPHASE; ++p) { a.ph_lo = p; a.ph_hi = p + 1; hipLaunchKernelGGL(mega_fwd, dim3(grid), dim3(512), LDS_BYTES, stream, a); }
#endif
}
```

```cpp
#include <hip/hip_runtime.h>
#include <hip/hip_cooperative_groups.h>
#include <cstdio>
#include <cstdint>
namespace cg = cooperative_groups;

#ifndef ONE_LAUNCH
#define ONE_LAUNCH 1
#endif

namespace pg8 {
#define PG8_LAS __attribute__((address_space(3)))
typedef unsigned short bf16_t;
typedef short bf16x8 __attribute__((ext_vector_type(8)));
typedef float f32x4 __attribute__((ext_vector_type(4)));
typedef unsigned u32x4 __attribute__((ext_vector_type(4)));
constexpr int BM = 256, BK = 64, HALF = 128, HTB = HALF * BK * 2  , STAGE_BYTES = 8 * HTB, NXCD = 8, WGM = 8;

__host__ __device__ __forceinline__ int lds_byte(int r, int c) { const int st = (r >> 4) * 2 + (c >> 5), rr = r & 15, cc = c & 31, ob = rr * 64 + cc * 2; return st * 1024 + (ob ^ (((ob >> 9) & 1) << 5)); }
__host__ __device__ __forceinline__ void stage_rc(int b, int& R, int& C) { const int st = b / 1024, sb = b % 1024, swz = sb ^ (((sb >> 9) & 1) << 5); R = (st >> 1) * 16 + swz / 64; C = (st & 1) * 32 + (swz % 64) / 2; }
__host__ __device__ __forceinline__ int perm32(int rho) { const int n = rho >> 4, i = rho & 15; return 8 * (i >> 2) + 4 * n + (i & 3); }

struct Unit { int pm, pn; };
struct Gemm { const bf16_t* A; const bf16_t* Bt; int M, N, K; int lda; size_t a_kstep; int amode; };
__device__ __forceinline__ const char* a_base(const Gemm& g, int pm) { return g.amode == 0 ? (const char*)g.A + (size_t)pm * ((size_t)BM * g.lda * 2) : (const char*)g.A + (size_t)(pm >> 2) * ((size_t)4096 * 2816 * 2) + (size_t)(pm & 3) * 128; }

struct StaticOrder {
    int nM, nN, nwg, G, c;
    __host__ __device__ void init(int M, int N, int G_, int c_) { nM = M / BM; nN = N / BM; nwg = nM * nN; G = G_; c = c_; }
    __host__ __device__ bool next(int i, Unit& u) const {
        const long L = (long)i * G + c; if (L >= nwg) return false;
        int wgid = (int)L; { const int q = nwg / NXCD, r = nwg % NXCD, xcd = wgid % NXCD, off = wgid / NXCD; wgid = (xcd < r ? xcd * (q + 1) : r * (q + 1) + (xcd - r) * q) + off; }
        const int nig = WGM * nN, gid = wgid / nig, fm = gid * WGM, gsz = (nM - fm) < WGM ? (nM - fm) : WGM;
        u.pm = fm + ((wgid % nig) % gsz); u.pn = (wgid % nig) / gsz; return true;
    }
    __device__ __forceinline__ void a_ready(const Unit&) const {}
    __device__ __forceinline__ void done(const Unit&) const {}
};


__device__ __forceinline__ unsigned cvt_pk_bf16(float lo, float hi) { unsigned r; asm volatile("v_cvt_pk_bf16_f32 %0, %1, %2" : "=v"(r) : "v"(lo), "v"(hi)); return r; }
__device__ __forceinline__ float gelu_tanh(float x) { const float u = 1.5957691216f * (x + 0.044715f * x * x * x); return x / (1.0f + __expf(-u)); }
template <int ACT> struct EpiStore {
    static constexpr bool PERM = true, AFTER_DRAIN = false;
    bf16_t* O; int ldc; const float* bias; const float* rscale;
    __device__ __forceinline__ void operator()(const f32x4 (&acc)[2][2][4][2], const Unit& u, int wr, int wc, int fr, int fq) const {
        const int row0 = u.pm * BM + wr * 64 + fr; const int col0 = u.pn * BM + wc * 32 + 8 * fq;
        f32x4 bv[2][2];
#pragma unroll
        for (int bj = 0; bj < 2; ++bj)
#pragma unroll
            for (int n = 0; n < 2; ++n) bv[bj][n] = bias ? *(const f32x4*)(bias + col0 + bj * HALF + 4 * n) : (f32x4){0.f, 0.f, 0.f, 0.f};
#pragma unroll
        for (int ai = 0; ai < 2; ++ai)
#pragma unroll
            for (int m = 0; m < 4; ++m) { bf16_t* rowp = O + (size_t)(row0 + ai * HALF + m * 16) * ldc + col0; const float rsc = rscale ? rscale[row0 + ai * HALF + m * 16] : 1.f;
#pragma unroll
                for (int bj = 0; bj < 2; ++bj) { f32x4 v0 = acc[ai][bj][m][0] * rsc + bv[bj][0], v1 = acc[ai][bj][m][1] * rsc + bv[bj][1];
                    if (ACT == 2) { v0 = (f32x4){gelu_tanh(v0[0]), gelu_tanh(v0[1]), gelu_tanh(v0[2]), gelu_tanh(v0[3])}; v1 = (f32x4){gelu_tanh(v1[0]), gelu_tanh(v1[1]), gelu_tanh(v1[2]), gelu_tanh(v1[3])}; }
                    u32x4 w; w.x = cvt_pk_bf16(v0[0], v0[1]); w.y = cvt_pk_bf16(v0[2], v0[3]); w.z = cvt_pk_bf16(v1[0], v1[1]); w.w = cvt_pk_bf16(v1[2], v1[3]);
                    *(u32x4*)(rowp + bj * HALF) = w; } }
    }
};


__device__ __forceinline__ float dpp_ror1(float x) { return __int_as_float(__builtin_amdgcn_update_dpp(0, __float_as_int(x), 0x121, 0xf, 0xf, false)); }
__device__ __forceinline__ float dpp_ror2(float x) { return __int_as_float(__builtin_amdgcn_update_dpp(0, __float_as_int(x), 0x122, 0xf, 0xf, false)); }
struct EpiConv {
    static constexpr bool PERM = true, AFTER_DRAIN = false;
    bf16_t* ACT; const float* rscale; const float* cw; const float* cb; float* HB;
    __device__ __forceinline__ void operator()(const f32x4 (&acc)[2][2][4][2], const Unit& u, int wr, int wc, int fr, int fq) const {
        constexpr int FF = 2816;
        const int colw = wc * 32 + 8 * fq, f0 = u.pn * 128 + colw, row0 = u.pm * BM + wr * 64 + fr;
        f32x4 w0[2], w1[2], w2[2], cbv[2];
#pragma unroll
        for (int n = 0; n < 2; ++n) { w0[n] = *(const f32x4*)(cw + f0 + 4 * n); w1[n] = *(const f32x4*)(cw + FF + f0 + 4 * n); w2[n] = *(const f32x4*)(cw + 2 * FF + f0 + 4 * n); cbv[n] = *(const f32x4*)(cb + f0 + 4 * n); }
#pragma unroll
        for (int ai = 0; ai < 2; ++ai) {
            float* hb = HB + ((size_t)((u.pm * 22 + u.pn) * 4 + ai * 2 + wr) * 6) * 128 + colw;
            f32x4 prev[2];
#pragma unroll
            for (int n = 0; n < 2; ++n) prev[n] = (f32x4){0.f, 0.f, 0.f, 0.f};
#pragma unroll
            for (int m = 0; m < 4; ++m) {
                const float rsc = rscale[row0 + ai * HALF + m * 16];
                f32x4 g[2], v[2], res[2];
#pragma unroll
                for (int n = 0; n < 2; ++n) { g[n] = acc[ai][0][m][n] * rsc; v[n] = acc[ai][1][m][n] * rsc; }
#pragma unroll
                for (int n = 0; n < 2; ++n)
#pragma unroll
                    for (int e = 0; e < 4; ++e) {
                        const float gg = g[n][e], pp = prev[n][e];
                        const float r1g = dpp_ror1(gg), r1p = dpp_ror1(pp), r2g = dpp_ror2(gg), r2p = dpp_ror2(pp);
                        const float p1 = fr == 0 ? r1p : r1g, p2 = fr < 2 ? r2p : r2g;
                        const float xv = cbv[n][e] + gg * w2[n][e] + p1 * w1[n][e] + p2 * w0[n][e];
                        res[n][e] = gelu_tanh(xv) * v[n][e];
                    }
                if (m == 0 && fr < 2) {
#pragma unroll
                    for (int n = 0; n < 2; ++n) { *(f32x4*)(hb + (2 + fr) * 128 + 4 * n) = g[n]; *(f32x4*)(hb + (4 + fr) * 128 + 4 * n) = v[n]; }
                } else {
                    u32x4 w; w.x = cvt_pk_bf16(res[0][0], res[0][1]); w.y = cvt_pk_bf16(res[0][2], res[0][3]); w.z = cvt_pk_bf16(res[1][0], res[1][1]); w.w = cvt_pk_bf16(res[1][2], res[1][3]);
                    *(u32x4*)(ACT + (size_t)(row0 + ai * HALF + m * 16) * FF + f0) = w;
                }
                if (m == 3 && fr >= 14) {
#pragma unroll
                    for (int n = 0; n < 2; ++n) *(f32x4*)(hb + (fr - 14) * 128 + 4 * n) = g[n]; }
#pragma unroll
                for (int n = 0; n < 2; ++n) prev[n] = g[n];
            }
        }
    }
};

template <class Epi, class Sched, bool ALIGN_EPI = false, bool SP2 = false>
__device__ __forceinline__ void gemm_phase(PG8_LAS unsigned char* lds, const Gemm g, const Sched& S, const Epi& E) {
    int tid = threadIdx.x; asm volatile("" : "+v"(tid)); const int wid = __builtin_amdgcn_readfirstlane(tid >> 6), lane = tid & 63, wr = wid >> 2, wc = wid & 3, fr = lane & 15, fq = lane >> 4;
    const int K = g.K, nt = K / BK;
    unsigned voffA[2], voffB[2];
#pragma unroll
    for (int i = 0; i < 2; ++i) { int R, C; stage_rc(tid * 16 + i * 8192, R, C); const int Rb = Epi::PERM ? ((R & ~31) + perm32(R & 31)) : R;
        voffA[i] = (unsigned)(R * g.lda + C) * 2u; voffB[i] = (unsigned)(Rb * K + C) * 2u; }
    const size_t kstep = (size_t)(BK * 2);
    const size_t hstepB = (size_t)HALF * K * 2, hstepA = (size_t)HALF * g.lda * 2, kstepA = g.a_kstep;
    const size_t tstep = 2 * hstepB;
    const unsigned ldsw = (unsigned)wid * 1024u;
    const int aoff = lds_byte(wr * 64 + fr, fq * 8), boff = lds_byte(wc * 32 + fr, fq * 8);
#define PG8_SA(b, h) (((b) * 2 + (h)) * HTB)
#define PG8_SB(b, h) ((4 + (b) * 2 + (h)) * HTB)
#define PG8_STAGE(bufoff, gbase, voff) do { _Pragma("unroll") for (int _i = 0; _i < 2; ++_i) \
        __builtin_amdgcn_global_load_lds((const unsigned*)((const char*)(gbase) + (voff)[_i]), (PG8_LAS unsigned*)(lds + (bufoff) + ldsw + _i * 8192), 16, 0, 0); } while (0)
#define PG8_LDA(dst, b, h) do { _Pragma("unroll") for (int m = 0; m < 4; ++m) _Pragma("unroll") for (int k = 0; k < 2; ++k) dst[m][k] = *(const PG8_LAS bf16x8*)(lds + PG8_SA(b, h) + aoff + m * 2048 + k * 1024); } while (0)
#define PG8_LDB(dst, b, h) do { _Pragma("unroll") for (int n = 0; n < 2; ++n) _Pragma("unroll") for (int k = 0; k < 2; ++k) dst[n][k] = *(const PG8_LAS bf16x8*)(lds + PG8_SB(b, h) + boff + n * 2048 + k * 1024); } while (0)
#define PG8_MMA(ai, bj, At, Bt) do { __builtin_amdgcn_s_setprio(1); _Pragma("unroll") for (int m = 0; m < 4; ++m) _Pragma("unroll") for (int n = 0; n < 2; ++n) _Pragma("unroll") for (int k = 0; k < 2; ++k) \
        acc[ai][bj][m][n] = __builtin_amdgcn_mfma_f32_16x16x32_bf16(Bt[n][k], At[m][k], acc[ai][bj][m][n], 0, 0, 0); __builtin_amdgcn_s_setprio(0); } while (0)
#define PG8_WAIT_V(n) asm volatile("s_waitcnt vmcnt(" #n ")" ::: "memory")
#define PG8_WAIT_L(n) asm volatile("s_waitcnt lgkmcnt(" #n ")" ::: "memory")
#define PG8_BAR __builtin_amdgcn_s_barrier()
#define PG8_SCHED __builtin_amdgcn_sched_barrier(0)
    Unit cur, nxt; int ui = 0;
    if (!S.next(0, cur)) return;
    f32x4 acc[2][2][4][2];
#pragma unroll
    for (int a = 0; a < 2; ++a)
#pragma unroll
        for (int b = 0; b < 2; ++b)
#pragma unroll
            for (int m = 0; m < 4; ++m)
#pragma unroll
                for (int n = 0; n < 2; ++n) acc[a][b][m][n] = (f32x4){0.f, 0.f, 0.f, 0.f};
    bf16x8 At[4][2], B0[2][2], B1[2][2];
    const char* cA = a_base(g, cur.pm); const char* cB = (const char*)g.Bt + (size_t)cur.pn * tstep;
    S.a_ready(cur);
    if constexpr (SP2) {
        PG8_STAGE(PG8_SB(0, 0), cB, voffB); PG8_STAGE(PG8_SB(0, 1), cB + hstepB, voffB); PG8_STAGE(PG8_SA(0, 0), cA, voffA); PG8_STAGE(PG8_SA(0, 1), cA + hstepA, voffA);
        if (wr == 1) PG8_BAR;
        PG8_WAIT_V(2); PG8_BAR;
        PG8_STAGE(PG8_SB(1, 0), cB + kstep, voffB); PG8_STAGE(PG8_SA(1, 0), cA + kstepA, voffA); PG8_STAGE(PG8_SB(1, 1), cB + hstepB + kstep, voffB);
        PG8_WAIT_V(6); PG8_BAR;
    } else {
        PG8_STAGE(PG8_SB(0, 0), cB, voffB); PG8_STAGE(PG8_SA(0, 0), cA, voffA); PG8_STAGE(PG8_SB(0, 1), cB + hstepB, voffB); PG8_STAGE(PG8_SA(0, 1), cA + hstepA, voffA);
        if (wr == 1) PG8_BAR;
        PG8_WAIT_V(4); PG8_BAR;
        PG8_STAGE(PG8_SB(1, 0), cB + kstep, voffB); PG8_STAGE(PG8_SA(1, 0), cA + kstepA, voffA); PG8_STAGE(PG8_SB(1, 1), cB + hstepB + kstep, voffB);
        PG8_WAIT_V(6); PG8_BAR;
    }
    for (;;) {
        const bool has_next = S.next(ui + 1, nxt);
        const char* nA = has_next ? a_base(g, nxt.pm) : cA; const char* nB = has_next ? (const char*)g.Bt + (size_t)nxt.pn * tstep : cB;
        for (int t = 0; t < nt; t += 2) {
            const bool last = (t == nt - 2);
            const char* a1 = cA + (size_t)(t + 1) * kstepA;
            const char* a2 = last ? nA : cA + (size_t)(t + 2) * kstepA; const char* b2 = last ? nB : cB + (size_t)(t + 2) * kstep;
            const char* a3 = a2 + kstepA; const char* b3 = b2 + kstep;
            if (last && has_next) S.a_ready(nxt);
            if constexpr (SP2) {
            PG8_LDB(B0, 0, 0); PG8_LDB(B1, 0, 1); PG8_SCHED; PG8_LDA(At, 0, 0); PG8_STAGE(PG8_SA(1, 1), a1 + hstepA, voffA);
            PG8_WAIT_V(8); PG8_WAIT_L(0); PG8_BAR; PG8_MMA(0, 0, At, B0); PG8_MMA(0, 1, At, B1); PG8_BAR; PG8_SCHED;
            PG8_LDA(At, 0, 1); PG8_STAGE(PG8_SB(0, 0), b2, voffB); PG8_STAGE(PG8_SB(0, 1), b2 + hstepB, voffB); PG8_STAGE(PG8_SA(0, 0), a2, voffA);
            PG8_WAIT_V(8); PG8_WAIT_L(0); PG8_BAR; PG8_MMA(1, 0, At, B0); PG8_MMA(1, 1, At, B1); PG8_BAR; PG8_SCHED;
            PG8_LDB(B0, 1, 0); PG8_LDB(B1, 1, 1); PG8_SCHED; PG8_LDA(At, 1, 0); PG8_STAGE(PG8_SA(0, 1), a2 + hstepA, voffA);
            PG8_WAIT_V(8); PG8_WAIT_L(0); PG8_BAR; PG8_MMA(0, 0, At, B0); PG8_MMA(0, 1, At, B1); PG8_BAR; PG8_SCHED;
            PG8_LDA(At, 1, 1); PG8_STAGE(PG8_SB(1, 0), b3, voffB); PG8_STAGE(PG8_SB(1, 1), b3 + hstepB, voffB); PG8_STAGE(PG8_SA(1, 0), a3, voffA);
            PG8_WAIT_V(8); PG8_WAIT_L(0); PG8_BAR; PG8_MMA(1, 0, At, B0); PG8_MMA(1, 1, At, B1); PG8_BAR; PG8_SCHED;
            } else {
            PG8_LDB(B0, 0, 0); PG8_SCHED; PG8_LDA(At, 0, 0); PG8_STAGE(PG8_SA(1, 1), a1 + hstepA, voffA);
            PG8_WAIT_L(8); PG8_BAR; PG8_WAIT_L(0); PG8_MMA(0, 0, At, B0); PG8_BAR; PG8_SCHED;
            PG8_LDB(B1, 0, 1); PG8_STAGE(PG8_SB(0, 0), b2, voffB);
            PG8_BAR; PG8_WAIT_L(0); PG8_MMA(0, 1, At, B1); PG8_BAR;
            PG8_LDA(At, 0, 1); PG8_STAGE(PG8_SA(0, 0), a2, voffA);
            PG8_BAR; PG8_WAIT_L(0); PG8_MMA(1, 0, At, B0); PG8_BAR; PG8_SCHED;
            PG8_STAGE(PG8_SB(0, 1), b2 + hstepB, voffB);
            PG8_WAIT_V(6); PG8_BAR; PG8_MMA(1, 1, At, B1); PG8_BAR;
            PG8_LDB(B0, 1, 0); PG8_SCHED; PG8_LDA(At, 1, 0); PG8_STAGE(PG8_SA(0, 1), a2 + hstepA, voffA);
            PG8_WAIT_L(8); PG8_BAR; PG8_WAIT_L(0); PG8_MMA(0, 0, At, B0); PG8_BAR; PG8_SCHED;
            PG8_LDB(B1, 1, 1); PG8_STAGE(PG8_SB(1, 0), b3, voffB);
            PG8_BAR; PG8_WAIT_L(0); PG8_MMA(0, 1, At, B1); PG8_BAR;
            PG8_LDA(At, 1, 1); PG8_STAGE(PG8_SA(1, 0), a3, voffA);
            PG8_BAR; PG8_WAIT_L(0); PG8_MMA(1, 0, At, B0); PG8_BAR; PG8_SCHED;
            PG8_STAGE(PG8_SB(1, 1), b3 + hstepB, voffB);
            PG8_WAIT_V(6); PG8_BAR; PG8_MMA(1, 1, At, B1); PG8_BAR;
            }
        }
        if constexpr (ALIGN_EPI) { if (wr == 0) PG8_BAR; }
        if constexpr (!Epi::AFTER_DRAIN) { E(acc, cur, wr, wc, fr, fq); S.done(cur); }
        if (!has_next) break;
#pragma unroll
        for (int a = 0; a < 2; ++a)
#pragma unroll
            for (int b = 0; b < 2; ++b)
#pragma unroll
                for (int m = 0; m < 4; ++m)
#pragma unroll
                    for (int n = 0; n < 2; ++n) acc[a][b][m][n] = (f32x4){0.f, 0.f, 0.f, 0.f};
        cur = nxt; cA = nA; cB = nB; ++ui;
        if constexpr (ALIGN_EPI) { if (wr == 1) PG8_BAR; }
    }
    PG8_WAIT_V(0);
    if constexpr (!ALIGN_EPI) { if (wr == 0) PG8_BAR; }
    PG8_BAR;
    if constexpr (Epi::AFTER_DRAIN) { E.fused(acc, cur, wr, wc, fr, fq, lds, wid, lane); S.done(cur); }
#undef PG8_SA
#undef PG8_SB
#undef PG8_STAGE
#undef PG8_LDA
#undef PG8_LDB
#undef PG8_MMA
#undef PG8_WAIT_V
#undef PG8_WAIT_L
#undef PG8_BAR
#undef PG8_SCHED
}
}


#define LAS __attribute__((address_space(3)))
typedef unsigned short bf16_t;
typedef short bf16x8 __attribute__((ext_vector_type(8)));
typedef short s16x4 __attribute__((ext_vector_type(4)));
typedef float f32x4 __attribute__((ext_vector_type(4)));
typedef float f32x2 __attribute__((ext_vector_type(2)));
typedef float f32x16 __attribute__((ext_vector_type(16)));
typedef unsigned u32x4 __attribute__((ext_vector_type(4)));
typedef unsigned u32x2 __attribute__((ext_vector_type(2)));

constexpr int T_ = 4096, NB_ = 16, M_ = NB_ * T_, DM = 1024;
constexpr int ZLD0 = 2560, ZLD1 = 2816, FF_ = 2816, ULD = 5632, LLD = 1536;
constexpr float NORM_EPS = 1e-6f, GN_EPS = 64e-5f;
constexpr size_t MiB = (size_t)1 << 20;
constexpr size_t WS_HYIN = 1 * MiB, WS_HYOUT = 6 * MiB, WS_NSAIN = 8 * MiB, WS_NSAOUT = 14 * MiB, WS_UP0 = 16 * MiB, WS_UP1 = 27 * MiB,
                 WS_DN0 = 38 * MiB, WS_DN1 = 44 * MiB, WS_LORA = 50 * MiB, WS_CW1K = 51 * MiB, WS_CW1V = 52 * MiB, WS_CBIAS = 53 * MiB;
constexpr size_t WS_H = 64 * MiB, WS_Z = 192 * MiB, WS_AP = 512 * MiB, WS_O = 544 * MiB, WS_L = 672 * MiB, WS_C = 864 * MiB, WS_MM = 896 * MiB;
constexpr size_t WS_HID = 672 * MiB, WS_KCMP = 688 * MiB, WS_VCMP = 690 * MiB, WS_U = 192 * MiB, WS_END = 1024 * MiB;
constexpr int LDS_BYTES = 163840;
constexpr int NPHASE = 23;

__device__ __forceinline__ float bf2f(unsigned u) { return __uint_as_float(u << 16); }
__device__ __forceinline__ unsigned pk2(float lo, float hi) { return pg8::cvt_pk_bf16(lo, hi); }
__device__ __forceinline__ float wave_sum(float v) {
#pragma unroll
    for (int o = 1; o < 64; o <<= 1) v += __shfl_xor(v, o);
    return v;
}
__device__ __forceinline__ float sigmoidf_(float x) { return 1.0f / (1.0f + __expf(-x)); }
#define LDS_WAIT() asm volatile("s_waitcnt lgkmcnt(0)" ::: "memory")

struct Args { const float* in[31]; float* out; unsigned char* ws; int ph_lo, ph_hi; };

__device__ __forceinline__ void transpose_item(const float* W, int N, bf16_t* WT, int ldt, LAS float* scr, int item, int nblk, int lane, const float* gk = nullptr, bool gvmap = false) {
    const int kb = item / nblk, nb = item % nblk, k0 = 64 * kb, n0 = 32 * nb;
    const int n = n0 + (lane & 31);
#pragma unroll 8
    for (int i = 0; i < 32; ++i) { const int kk = 2 * i + (lane >> 5); scr[kk * 33 + (lane & 31)] = (n < N) ? W[(size_t)(k0 + kk) * N + n] * (gk ? gk[k0 + kk] : 1.f) : 0.f; }
    LDS_WAIT(); asm volatile("" ::: "memory");
    const int c = lane & 7;
#pragma unroll
    for (int j = 0; j < 4; ++j) { const int nn = (lane >> 3) + 8 * j; const LAS float* s = scr + (8 * c) * 33 + nn;
        u32x4 o; o.x = pk2(s[0 * 33], s[1 * 33]); o.y = pk2(s[2 * 33], s[3 * 33]); o.z = pk2(s[4 * 33], s[5 * 33]); o.w = pk2(s[6 * 33], s[7 * 33]);
        int drow = n0 + nn; if (gvmap) { const int isv = n0 >= 2816 ? 1 : 0, f = n0 - isv * 2816; drow = 256 * (f >> 7) + 128 * isv + (f & 127) + nn; }
        *(u32x4*)(WT + (size_t)drow * ldt + k0 + 8 * c) = o; }
    LDS_WAIT(); asm volatile("" ::: "memory");
}

__device__ __forceinline__ void norm_phase(const float* xf, const bf16_t* xb, const bf16_t* mm, const float* gpost, float* outf, bf16_t* outb, float* rs_out, int gw, int NGW, int lane) {
    for (int m = gw; m < M_; m += NGW) {
        f32x4 v[4];
        if (xf) { const f32x4* xr = (const f32x4*)(xf + (size_t)m * DM) + lane;
#pragma unroll
            for (int j = 0; j < 4; ++j) v[j] = xr[64 * j]; }
        else { const u32x2* xr = (const u32x2*)(xb + (size_t)m * DM) + lane;
#pragma unroll
            for (int j = 0; j < 4; ++j) { const u32x2 w = xr[64 * j]; v[j] = (f32x4){bf2f(w.x & 0xffffu), bf2f(w.x >> 16), bf2f(w.y & 0xffffu), bf2f(w.y >> 16)}; } }
        if (mm) {
            const u32x2* mr = (const u32x2*)(mm + (size_t)m * DM) + lane;
            f32x4 q[4]; float ss = 0.f;
#pragma unroll
            for (int j = 0; j < 4; ++j) { const u32x2 w = mr[64 * j]; q[j] = (f32x4){bf2f(w.x & 0xffffu), bf2f(w.x >> 16), bf2f(w.y & 0xffffu), bf2f(w.y >> 16)};
                ss += (q[j].x * q[j].x + q[j].y * q[j].y) + (q[j].z * q[j].z + q[j].w * q[j].w); }
            const float rs = rsqrtf(wave_sum(ss) * (1.f / DM) + NORM_EPS);
#pragma unroll
            for (int j = 0; j < 4; ++j) { const f32x4 g = *((const f32x4*)gpost + lane + 64 * j); v[j] = v[j] + q[j] * rs * g; }
        }
        if (outf) { f32x4* xo = (f32x4*)(outf + (size_t)m * DM) + lane;
#pragma unroll
            for (int j = 0; j < 4; ++j) xo[64 * j] = v[j]; }
        if (outb) { u32x2* xo = (u32x2*)(outb + (size_t)m * DM) + lane;
#pragma unroll
            for (int j = 0; j < 4; ++j) { u32x2 w; w.x = pk2(v[j].x, v[j].y); w.y = pk2(v[j].z, v[j].w); xo[64 * j] = w; } }
        if (rs_out) {
            float s2 = 0.f;
#pragma unroll
            for (int j = 0; j < 4; ++j) s2 += (v[j].x * v[j].x + v[j].y * v[j].y) + (v[j].z * v[j].z + v[j].w * v[j].w);
            const float rs2 = rsqrtf(wave_sum(s2) * (1.f / DM) + NORM_EPS);
            if (lane == 0) rs_out[m] = rs2;
        }
    }
}

constexpr int KROW = 144, VROW = 192, KT_BYTES = 64 * KROW, VT_BYTES = 64 * VROW;
constexpr float NEGBIG = -1e30f;
__device__ __forceinline__ int crow(int r, int hi) { return (r & 3) + 8 * (r >> 2) + 4 * hi; }
struct TileRegs { u32x4 k, v; };
__device__ __forceinline__ void tile_gload(TileRegs& r, const bf16_t* Kg, const bf16_t* Vg, size_t ld, int tid) {
    r.k = *(const u32x4*)(Kg + (size_t)(tid >> 3) * ld + (tid & 7) * 8);
    r.v = *(const u32x4*)(Vg + (size_t)(tid >> 3) * ld + (tid & 7) * 8);
}
__device__ __forceinline__ void tile_lstore(const TileRegs& r, LAS unsigned char* Ks, LAS unsigned char* Vs, int tid) {
    *(LAS u32x4*)(Ks + (tid >> 3) * KROW + (tid & 7) * 16) = r.k;
    *(LAS u32x4*)(Vs + (tid >> 3) * VROW + (tid & 7) * 16) = r.v;
}
constexpr float QSCALE = 0.125f * 1.4426950408889634f;
__device__ __forceinline__ void load_qfrag(bf16x8 (&qf)[4], const bf16_t* qrow, int hi) {
#pragma unroll
    for (int d0 = 0; d0 < 4; ++d0) { const u32x4 w = *(const u32x4*)(qrow + d0 * 16 + hi * 8);
        u32x4 o; o.x = pk2(bf2f(w.x & 0xffffu) * QSCALE, bf2f(w.x >> 16) * QSCALE); o.y = pk2(bf2f(w.y & 0xffffu) * QSCALE, bf2f(w.y >> 16) * QSCALE);
        o.z = pk2(bf2f(w.z & 0xffffu) * QSCALE, bf2f(w.z >> 16) * QSCALE); o.w = pk2(bf2f(w.w & 0xffffu) * QSCALE, bf2f(w.w >> 16) * QSCALE);
        qf[d0] = __builtin_bit_cast(bf16x8, o); }
}
constexpr float LOG2E = 1.4426950408889634f, RESCALE_THR = 14.f;
__device__ __forceinline__ float max3f(float a, float b, float c) { return fmaxf(fmaxf(a, b), c); }
template <int KSTEP>
__device__ __forceinline__ void attn_tile2(const LAS unsigned char* Ks, const LAS unsigned char* Vs, const bf16x8 (&qf)[4], f32x16 (&o)[2], float& mref, float& l,
                                           float basep, float ks2, int maskmode, int dl, int W, int r32, int hi, bool do_pv, f32x16* pout0, f32x16* pout1) {
    f32x16 s0, s1;
    const float off = ks2 * (float)(4 * hi) - basep;
#pragma unroll
    for (int r = 0; r < 16; ++r) { s0[r] = ks2 * (float)((r & 3) + 8 * (r >> 2)) + off; s1[r] = ks2 * (float)((r & 3) + 8 * (r >> 2) + 32) + off; }
#pragma unroll
    for (int d0 = 0; d0 < 4; ++d0) {
        const bf16x8 k0 = *(const LAS bf16x8*)(Ks + r32 * KROW + (d0 * 16 + hi * 8) * 2);
        const bf16x8 k1 = *(const LAS bf16x8*)(Ks + (32 + r32) * KROW + (d0 * 16 + hi * 8) * 2);
        s0 = __builtin_amdgcn_mfma_f32_32x32x16_bf16(k0, qf[d0], s0, 0, 0, 0);
        s1 = __builtin_amdgcn_mfma_f32_32x32x16_bf16(k1, qf[d0], s1, 0, 0, 0);
    }
    if (maskmode) {
        const int dl0 = dl - KSTEP * 4 * hi;
#pragma unroll
        for (int r = 0; r < 16; ++r) {
            const int d0 = dl0 - KSTEP * ((r & 3) + 8 * (r >> 2)), d1 = d0 - KSTEP * 32;
            const bool v0 = (!(maskmode & 1) || d0 >= 0) && (!(maskmode & 2) || d0 < W), v1 = (!(maskmode & 1) || d1 >= 0) && (!(maskmode & 2) || d1 < W);
            s0[r] = v0 ? s0[r] : NEGBIG; s1[r] = v1 ? s1[r] : NEGBIG;
        }
    }
    if (do_pv) {
        float mt = max3f(s0[0], s0[1], s1[0]);
        mt = max3f(mt, s1[1], s0[2]);
#pragma unroll
        for (int r = 2; r < 16; r += 2) { mt = max3f(mt, s0[r], s0[r + 1]); mt = max3f(mt, s1[r], s1[r + 1]); }
        mt = fmaxf(mt, __shfl_xor(mt, 32));
        if (__any(mt > RESCALE_THR)) {
            const float delta = fmaxf(mt, 0.f), sc = __builtin_amdgcn_exp2f(-delta);
            mref += delta; l *= sc;
#pragma unroll
            for (int r = 0; r < 16; ++r) { o[0][r] *= sc; o[1][r] *= sc; s0[r] -= delta; s1[r] -= delta; }
        }
    }
    float ps = 0.f;
#pragma unroll
    for (int r = 0; r < 16; ++r) { s0[r] = __builtin_amdgcn_exp2f(s0[r]); s1[r] = __builtin_amdgcn_exp2f(s1[r]); ps += s0[r] + s1[r]; }
    if (!do_pv) { *pout0 = s0; *pout1 = s1; return; }
    l += ps;
    const LAS unsigned char* vbase = Vs + (4 * hi + ((r32 & 15) >> 2)) * VROW + (16 * (r32 >> 4) + 4 * (r32 & 3)) * 2;
    bf16x8 pb[4];
    { u32x4 w; w.x = pk2(s0[0], s0[1]); w.y = pk2(s0[2], s0[3]); w.z = pk2(s0[4], s0[5]); w.w = pk2(s0[6], s0[7]); pb[0] = __builtin_bit_cast(bf16x8, w); }
    { u32x4 w; w.x = pk2(s0[8], s0[9]); w.y = pk2(s0[10], s0[11]); w.z = pk2(s0[12], s0[13]); w.w = pk2(s0[14], s0[15]); pb[1] = __builtin_bit_cast(bf16x8, w); }
    { u32x4 w; w.x = pk2(s1[0], s1[1]); w.y = pk2(s1[2], s1[3]); w.z = pk2(s1[4], s1[5]); w.w = pk2(s1[6], s1[7]); pb[2] = __builtin_bit_cast(bf16x8, w); }
    { u32x4 w; w.x = pk2(s1[8], s1[9]); w.y = pk2(s1[10], s1[11]); w.z = pk2(s1[12], s1[13]); w.w = pk2(s1[14], s1[15]); pb[3] = __builtin_bit_cast(bf16x8, w); }
#pragma unroll
    for (int dh = 0; dh < 2; ++dh) {
#pragma unroll
        for (int ks = 0; ks < 4; ++ks) {
            const LAS unsigned char* vp = vbase + ks * 16 * VROW + dh * 64;
            const s16x4 lo = __builtin_amdgcn_ds_read_tr16_b64_v4i16((LAS s16x4*)vp), hh = __builtin_amdgcn_ds_read_tr16_b64_v4i16((LAS s16x4*)(vp + 8 * VROW));
            const bf16x8 a8 = (bf16x8){lo[0], lo[1], lo[2], lo[3], hh[0], hh[1], hh[2], hh[3]};
            o[dh] = __builtin_amdgcn_mfma_f32_32x32x16_bf16(a8, pb[ks], o[dh], 0, 0, 0);
        }
        asm volatile("" ::: "memory");
    }
}
__device__ __forceinline__ void store_o(const f32x16 (&o)[2], bf16_t* orow, int hi) {
#pragma unroll
    for (int dh = 0; dh < 2; ++dh)
#pragma unroll
        for (int r4 = 0; r4 < 4; ++r4) { u32x2 w; w.x = pk2(o[dh][4 * r4], o[dh][4 * r4 + 1]); w.y = pk2(o[dh][4 * r4 + 2], o[dh][4 * r4 + 3]);
            *(u32x2*)(orow + dh * 32 + 8 * r4 + 4 * hi) = w; }
}

__device__ __forceinline__ void swa_unit(int u, const bf16_t* Z, bf16_t* O, const float* sinks, LAS unsigned char* lds, int tid) {
    const int g = u & 1, sb = (u >> 1) & 63, b = u >> 7;
    const int lane = tid & 63, w = tid >> 6, r32 = lane & 31, hi = lane >> 5;
    const int h = g * 4 + (w >> 1), t0 = sb * 64, t = t0 + (w & 1) * 32 + r32;
    const size_t mrow = (size_t)b * T_ + t;
    LAS unsigned char* Ks = lds; LAS unsigned char* Vs = lds + KT_BYTES;
    bf16x8 qf[4]; load_qfrag(qf, Z + mrow * ZLD0 + h * 64, hi);
    const float slope2 = exp2f(-(float)(h + 1)) * LOG2E;
    float mref = 0.f, l = hi == 0 ? __builtin_amdgcn_exp2f(sinks[h] * LOG2E) : 0.f;
    f32x16 o[2];
#pragma unroll
    for (int r = 0; r < 16; ++r) { o[0][r] = 0.f; o[1][r] = 0.f; }
    const int first = sb >= 2 ? 0 : 2 - sb;
    TileRegs tr;
    { const bf16_t* base = Z + ((size_t)b * T_ + t0) * ZLD0; tile_gload(tr, base + 512 + g * 64, base + 640 + g * 64, ZLD0, tid); }
    for (int ti = 2; ti >= first; --ti) {
        const int kp0 = t0 - 128 + 64 * ti;
        __syncthreads(); tile_lstore(tr, Ks, Vs, tid); __syncthreads();
        if (ti - 1 >= first) { const bf16_t* base = Z + ((size_t)b * T_ + kp0 - 64) * ZLD0; tile_gload(tr, base + 512 + g * 64, base + 640 + g * 64, ZLD0, tid); }
        const int dl = t - kp0;
        attn_tile2<1>(Ks, Vs, qf, o, mref, l, slope2 * (float)dl + mref, slope2, ti == 2 ? 1 : (ti == 0 ? 2 : 0), dl, 128, r32, hi, true, nullptr, nullptr);
    }
    l += __shfl_xor(l, 32);
    const float inv = 1.f / l;
#pragma unroll
    for (int r = 0; r < 16; ++r) { o[0][r] *= inv; o[1][r] *= inv; }
    store_o(o, O + mrow * DM + h * 64, hi);
}

constexpr int IMP_OFF = 21504, IMP_LD = 257, SELM_OFF = IMP_OFF + 64 * IMP_LD * 4  , UNI_OFF = SELM_OFF + 512;
__device__ __forceinline__ void nsa_unit(int u, const bf16_t* Z, const bf16_t* KC, const bf16_t* VC, bf16_t* O, LAS unsigned char* lds, int tid) {
    const int bg = u & 63, i = u >> 6, g = bg & 3, b = bg >> 2;
    const int lane = tid & 63, w = tid >> 6, r32 = lane & 31, hi = lane >> 5;
    const int hr = w >> 1, h = g * 4 + hr, t0 = i * 64, ql = (w & 1) * 32 + r32, t = t0 + ql;
    const size_t mrow = (size_t)b * T_ + t;
    LAS unsigned char* Ks = lds; LAS unsigned char* Vs = lds + KT_BYTES;
    LAS float* imp = (LAS float*)(lds + IMP_OFF);
    LAS unsigned* selm = (LAS unsigned*)(lds + SELM_OFF); LAS unsigned* uni = (LAS unsigned*)(lds + UNI_OFF);
    bf16x8 qf[4]; load_qfrag(qf, Z + mrow * ZLD1 + h * 64, hi);
    const float slope2 = exp2f(-0.5f * (float)(h + 1)) * LOG2E;
    const unsigned goff = (unsigned)(mrow * ZLD1) + 2560u + (unsigned)(h * 3);
    LAS float* park = (LAS float*)(lds + 88064) + tid;
    f32x16 o[2]; float mref, l; TileRegs tr;
    const size_t cbase = ((size_t)(b * 4 + g) * 256) * 64;
    const int ncv = min(4 * i + 3, 255), nct = (ncv + 63) >> 6;
    mref = 0.f; l = 0.f;
#pragma unroll
    for (int r = 0; r < 16; ++r) { o[0][r] = 0.f; o[1][r] = 0.f; }
    tile_gload(tr, KC + cbase + (size_t)(nct - 1) * 4096, VC + cbase + (size_t)(nct - 1) * 4096, 64, tid);
    for (int ti = nct - 1; ti >= 0; --ti) {
        __syncthreads(); tile_lstore(tr, Ks, Vs, tid); __syncthreads();
        if (ti > 0) tile_gload(tr, KC + cbase + (size_t)(ti - 1) * 4096, VC + cbase + (size_t)(ti - 1) * 4096, 64, tid);
        const int dl = t - 31 - 1024 * ti;
        attn_tile2<16>(Ks, Vs, qf, o, mref, l, slope2 * (float)dl + mref, 16.f * slope2, 1, dl, 0, r32, hi, true, nullptr, nullptr);
    }
    l += __shfl_xor(l, 32);
    const float invc = l > 0.f ? 1.f / l : 0.f;
    { const float wg = sigmoidf_(bf2f(Z[goff])) * invc;
#pragma unroll
      for (int r = 0; r < 16; ++r) { park[r * 512] = o[0][r] * wg; park[(16 + r) * 512] = o[1][r] * wg; } }
    if (i > 7) {
        tile_gload(tr, KC + cbase, VC + cbase, 64, tid);
        for (int ti = 0; ti < nct; ++ti) {
            __syncthreads(); tile_lstore(tr, Ks, Vs, tid); __syncthreads();
            if (ti + 1 < nct) tile_gload(tr, KC + cbase + (size_t)(ti + 1) * 4096, VC + cbase + (size_t)(ti + 1) * 4096, 64, tid);
            const int dl = t - 31 - 1024 * ti;
            f32x16 s0, s1; float dm = mref, dlq = 0.f;
            attn_tile2<16>(Ks, Vs, qf, o, dm, dlq, slope2 * (float)dl + mref, 16.f * slope2, 1, dl, 0, r32, hi, false, &s0, &s1);
            LAS float* ip = imp + ql * IMP_LD + ti * 64;
#pragma unroll
            for (int rr = 0; rr < 4; ++rr) {
                if (hr == rr) {
#pragma unroll
                    for (int r = 0; r < 16; ++r) { const int c = crow(r, hi);
                        if (rr == 0) { ip[c] = s0[r] * invc; ip[32 + c] = s1[r] * invc; } else { ip[c] += s0[r] * invc; ip[32 + c] += s1[r] * invc; } }
                }
                __syncthreads();
            }
        }
    }
    if (tid == 0) { uni[0] = 0u; uni[1] = 0u; }
    __syncthreads();
    if (tid < 64) {
        unsigned long long mask;
        if (i <= 7) mask = (2ull << i) - 1ull;
        else {
            float v0 = -1.f, v1 = -1.f, v2 = -1.f, v3 = -1.f, v4 = -1.f; int j0 = 0, j1 = 0, j2 = 0, j3 = 0, j4 = 0;
            const LAS float* ip = imp + tid * IMP_LD;
            for (int j = 1; j <= i - 2; ++j) {
                float v = ip[4 * j - 1] + 2.f * (ip[4 * j] + ip[4 * j + 1] + ip[4 * j + 2]) + ip[4 * j + 3]; int jj = j;
#define INS(vk, jk) if (v > vk) { const float tv = vk; const int tj = jk; vk = v; jk = jj; v = tv; jj = tj; }
                INS(v0, j0) INS(v1, j1) INS(v2, j2) INS(v3, j3) INS(v4, j4)
#undef INS
            }
            mask = 1ull | (1ull << i) | (1ull << (i - 1)) | (1ull << j0) | (1ull << j1) | (1ull << j2) | (1ull << j3) | (1ull << j4);
        }
        selm[2 * tid] = (unsigned)mask; selm[2 * tid + 1] = (unsigned)(mask >> 32);
        atomicOr((unsigned*)(uni), (unsigned)mask); atomicOr((unsigned*)(uni + 1), (unsigned)(mask >> 32));
    }
    __syncthreads();
    {
        unsigned long long um = (unsigned long long)uni[0] | ((unsigned long long)uni[1] << 32);
        mref = 0.f; l = 0.f;
#pragma unroll
        for (int r = 0; r < 16; ++r) { o[0][r] = 0.f; o[1][r] = 0.f; }
        int j = 63 - __builtin_clzll(um); um &= ~(1ull << j);
        { const bf16_t* base = Z + ((size_t)b * T_ + 64 * j) * ZLD1; tile_gload(tr, base + 1536 + g * 64, base + 1792 + g * 64, ZLD1, tid); }
        for (;;) {
            __syncthreads(); tile_lstore(tr, Ks, Vs, tid); __syncthreads();
            int jn = -1;
            if (um) { jn = 63 - __builtin_clzll(um); um &= ~(1ull << jn); }
            if (jn >= 0) { const bf16_t* base = Z + ((size_t)b * T_ + 64 * jn) * ZLD1; tile_gload(tr, base + 1536 + g * 64, base + 1792 + g * 64, ZLD1, tid); }
            const bool sel = (selm[2 * ql + (j >> 5)] >> (j & 31)) & 1u;
            const int dl = t - 64 * j;
            attn_tile2<1>(Ks, Vs, qf, o, mref, l, sel ? slope2 * (float)dl + mref : 1e30f, slope2, j == i ? 1 : 0, dl, 0, r32, hi, true, nullptr, nullptr);
            if (jn < 0) break;
            j = jn;
        }
        l += __shfl_xor(l, 32);
        const float wg = sigmoidf_(bf2f(Z[goff + 1])) / l;
#pragma unroll
        for (int r = 0; r < 16; ++r) { park[r * 512] += wg * o[0][r]; park[(16 + r) * 512] += wg * o[1][r]; }
    }
    {
        mref = 0.f; l = 0.f;
#pragma unroll
        for (int r = 0; r < 16; ++r) { o[0][r] = 0.f; o[1][r] = 0.f; }
        const int first = i >= 4 ? 0 : 4 - i;
        { const bf16_t* base = Z + ((size_t)b * T_ + t0) * ZLD1; tile_gload(tr, base + 2048 + g * 64, base + 2304 + g * 64, ZLD1, tid); }
        for (int ti = 4; ti >= first; --ti) {
            const int kp0 = t0 - 256 + 64 * ti;
            __syncthreads(); tile_lstore(tr, Ks, Vs, tid); __syncthreads();
            if (ti - 1 >= first) { const bf16_t* base = Z + ((size_t)b * T_ + kp0 - 64) * ZLD1; tile_gload(tr, base + 2048 + g * 64, base + 2304 + g * 64, ZLD1, tid); }
            const int dl = t - kp0;
            attn_tile2<1>(Ks, Vs, qf, o, mref, l, slope2 * (float)dl + mref, slope2, ti == 4 ? 1 : (ti == 0 ? 2 : 0), dl, 256, r32, hi, true, nullptr, nullptr);
        }
        l += __shfl_xor(l, 32);
        const float wg = sigmoidf_(bf2f(Z[goff + 2])) / l;
#pragma unroll
        for (int r = 0; r < 16; ++r) { o[0][r] = park[r * 512] + wg * o[0][r]; o[1][r] = park[(16 + r) * 512] + wg * o[1][r]; }
    }
    store_o(o, O + mrow * DM + h * 64, hi);
    __syncthreads();
}

__device__ __forceinline__ float dpp_xadd(float x, int which) {
    int r;
    const int xi = __float_as_int(x);
    if (which == 0) r = __builtin_amdgcn_update_dpp(0, xi, 0xB1, 0xf, 0xf, false);
    else if (which == 1) r = __builtin_amdgcn_update_dpp(0, xi, 0x4E, 0xf, 0xf, false);
    else if (which == 2) r = __builtin_amdgcn_update_dpp(0, xi, 0x141, 0xf, 0xf, false);
    else r = __builtin_amdgcn_update_dpp(0, xi, 0x140, 0xf, 0xf, false);
    return x + __int_as_float(r);
}
__device__ __forceinline__ float row16_sum(float x) { x = dpp_xadd(x, 0); x = dpp_xadd(x, 1); x = dpp_xadd(x, 2); x = dpp_xadd(x, 3); return x; }

#define UNPK4(w) (f32x4){bf2f((w).x & 0xffffu), bf2f((w).x >> 16), bf2f((w).y & 0xffffu), bf2f((w).y >> 16)}
#define PK4(v) (u32x2){pk2((v).x, (v).y), pk2((v).z, (v).w)}
__device__ __forceinline__ f32x4 sig4(f32x4 v) { return (f32x4){sigmoidf_(v.x), sigmoidf_(v.y), sigmoidf_(v.z), sigmoidf_(v.w)}; }
__device__ __forceinline__ void rwkv_prep(const Args& a, const bf16_t* Z, const bf16_t* L, unsigned* KW, bf16_t* WE, bf16_t* KKA, bf16_t* KT, bf16_t* VS, float* C, int gw, int NGW, int lane) {
    const int h = gw & 7, col = h * 64 + (lane & 15) * 4, q = lane >> 4;
    const f32x4 mu_r = *(const f32x4*)(a.in[8] + col), mu_k = *(const f32x4*)(a.in[8] + 512 + col), mu_v = *(const f32x4*)(a.in[8] + 1024 + col);
    const f32x4 w0 = *(const f32x4*)(a.in[9] + col), a0 = *(const f32x4*)(a.in[11] + col), k_k = *(const f32x4*)(a.in[14] + col), k_a = *(const f32x4*)(a.in[15] + col), r_k = *(const f32x4*)(a.in[16] + col);
    for (int m4 = gw >> 3; m4 < M_ / 4; m4 += NGW >> 3) {
        const int m = m4 * 4 + q;
        const bf16_t* zr = Z + (size_t)m * ZLD0 + 768 + col;
        f32x4 r = UNPK4(*(const u32x2*)zr), k = UNPK4(*(const u32x2*)(zr + 512)), v = UNPK4(*(const u32x2*)(zr + 1024));
        f32x4 rp = (f32x4){0.f, 0.f, 0.f, 0.f}, kp = rp, vp = rp;
        if ((m & (T_ - 1)) != 0) { rp = UNPK4(*(const u32x2*)(zr - ZLD0)); kp = UNPK4(*(const u32x2*)(zr + 512 - ZLD0)); vp = UNPK4(*(const u32x2*)(zr + 1024 - ZLD0)); }
        r += (rp - r) * mu_r; k += (kp - k) * mu_k; v += (vp - v) * mu_v;
        const f32x4 lw = UNPK4(*(const u32x2*)(L + (size_t)m * LLD + col)), la = UNPK4(*(const u32x2*)(L + (size_t)m * LLD + 512 + col));
        const f32x4 e = sig4(w0 + lw) * 0.60653065971f;
        const u32x2 eb = PK4(e);
        const f32x4 er = UNPK4(eb);
        const f32x4 wdec = (f32x4){__expf(-er.x), __expf(-er.y), __expf(-er.z), __expf(-er.w)};
        const f32x4 av = sig4(a0 + la);
        f32x4 kk = k * k_k;
        const float nrm = sqrtf(row16_sum((kk.x * kk.x + kk.y * kk.y) + (kk.z * kk.z + kk.w * kk.w)));
        kk = kk * (1.f / fmaxf(nrm, 1e-12f));
        const f32x4 kt = k * (1.f + (av - 1.f) * k_a);
        const f32x4 kka = kk * av;
        const f32x4 t1 = kka * r, t2 = kt * r, t3 = t2 * r_k;
        const float c1 = row16_sum((t1.x + t1.y) + (t1.z + t1.w)), c2 = row16_sum((t2.x + t2.y) + (t2.z + t2.w)), c3 = row16_sum((t3.x + t3.y) + (t3.z + t3.w));
        const size_t o = (size_t)m * 512 + col;
        const f32x4 wr = wdec * r;
        *(u32x4*)(KW + o) = (u32x4){pk2(kk.x, wr.x), pk2(kk.y, wr.y), pk2(kk.z, wr.z), pk2(kk.w, wr.w)}; *(u32x2*)(WE + o) = eb;
        *(u32x2*)(KKA + o) = PK4(kka); *(u32x2*)(KT + o) = PK4(kt); *(u32x2*)(VS + o) = PK4(v);
        if ((lane & 15) == 0) *(f32x4*)(C + (size_t)m * 32 + h * 4) = (f32x4){c1, c2, c3, 0.f};
    }
}

constexpr int SC_TS = 32, SC_D = 8, SC_BUF = 3 * SC_TS * 64 + SC_TS * 32 + SC_TS * 2;
__device__ __forceinline__ void scan_unit(int u, const unsigned* KW, const bf16_t* WE, const bf16_t* KKA, const bf16_t* KT, const bf16_t* VS, const float* C, float* Y, LAS unsigned char* lds, int tid) {
    const int half = u & 1, h = (u >> 1) & 7, b = u >> 4;
    const int il = tid >> 4, jg = tid & 15;
    LAS float* buf0 = (LAS float*)lds; LAS float* buf1 = buf0 + SC_BUF;
    f32x2 S01 = (f32x2){0.f, 0.f}, S23 = (f32x2){0.f, 0.f};
    const size_t rowbase = (size_t)b * T_;
    const size_t goff = (rowbase + il) * 512 + h * 64 + jg * 4;
    const size_t voff = (rowbase + il) * 512 + h * 64 + half * 32 + jg * 2;
    const unsigned* kwp = KW + rowbase * 512 + h * 64 + jg * 4;
    float* yp = Y + (rowbase + jg) * 512 + h * 64 + half * 32 + il;
    u32x2 rwe, rkka, rkt; unsigned rv; f32x2 rc;
#define SC_GLOAD(t0) do { const size_t d_ = (size_t)(t0) * 512; rwe = *(const u32x2*)(WE + goff + d_); \
        rkka = *(const u32x2*)(KKA + goff + d_); rkt = *(const u32x2*)(KT + goff + d_); rv = *(const unsigned*)(VS + voff + d_); \
        if (tid < SC_TS) rc = *(const f32x2*)(C + (rowbase + (t0) + tid) * 32 + h * 4); } while (0)
#define SC_EXP4(w) (f32x4){bf2f((w).x & 0xffffu), bf2f((w).x >> 16), bf2f((w).y & 0xffffu), bf2f((w).y >> 16)}
#define SC_LSTORE(bf) do { LAS float* p_ = (bf) + il * 64 + jg * 4; \
        { f32x4 e_ = SC_EXP4(rwe); *(LAS f32x4*)(p_) = (f32x4){__expf(-e_.x), __expf(-e_.y), __expf(-e_.z), __expf(-e_.w)}; } \
        *(LAS f32x4*)(p_ + 2048) = SC_EXP4(rkka); *(LAS f32x4*)(p_ + 4096) = SC_EXP4(rkt); \
        *(LAS f32x2*)((bf) + 6144 + il * 32 + jg * 2) = (f32x2){bf2f(rv & 0xffffu), bf2f(rv >> 16)}; \
        if (tid < SC_TS) *(LAS f32x2*)((bf) + 7168 + tid * 2) = rc; } while (0)
    u32x4 ring[SC_D];
#pragma unroll
    for (int d = 0; d < SC_D; ++d) ring[d] = *(const u32x4*)(kwp + (size_t)d * 512);
    __syncthreads();
    SC_GLOAD(0); SC_LSTORE(buf0);
    __syncthreads();
    float yacc = 0.f;
    for (int n = 0; n < T_ / SC_TS; ++n) {
        LAS float* cb = (n & 1) ? buf1 : buf0; LAS float* nb = (n & 1) ? buf0 : buf1;
        if (n + 1 < T_ / SC_TS) SC_GLOAD((n + 1) * SC_TS);
        const LAS float* B = cb + jg * 4;
        f32x4 w = *(const LAS f32x4*)B, kka = *(const LAS f32x4*)(B + 2048), kt = *(const LAS f32x4*)(B + 4096);
        float v = cb[6144 + il]; f32x2 c = *(const LAS f32x2*)(cb + 7168);
#pragma unroll
        for (int s = 0; s < SC_TS; ++s) {
            f32x4 wn = w, kkan = kka, ktn = kt; float vn = v; f32x2 cn = c;
            if (s + 1 < SC_TS) { wn = *(const LAS f32x4*)(B + (s + 1) * 64); kkan = *(const LAS f32x4*)(B + 2048 + (s + 1) * 64); ktn = *(const LAS f32x4*)(B + 4096 + (s + 1) * 64);
                vn = cb[6144 + (s + 1) * 32 + il]; cn = *(const LAS f32x2*)(cb + 7168 + (s + 1) * 2); }
            const u32x4 kw = ring[s % SC_D];
            { int tt = n * SC_TS + s + SC_D; tt = tt < T_ ? tt : T_ - 1; ring[s % SC_D] = *(const u32x4*)(kwp + (size_t)tt * 512); }
            const f32x2 p0 = (f32x2){__uint_as_float(kw.x << 16), __uint_as_float(kw.x & 0xffff0000u)}, p1 = (f32x2){__uint_as_float(kw.y << 16), __uint_as_float(kw.y & 0xffff0000u)};
            const f32x2 p2 = (f32x2){__uint_as_float(kw.z << 16), __uint_as_float(kw.z & 0xffff0000u)}, p3 = (f32x2){__uint_as_float(kw.w << 16), __uint_as_float(kw.w & 0xffff0000u)};
            f32x2 acc = p0 * S01.x; acc = p1 * S01.y + acc; acc = p2 * S23.x + acc; acc = p3 * S23.y + acc;
            const float sa = row16_sum(acc.x), uu = row16_sum(acc.y);
            const float y = uu - sa * c.x + v * c.y;
            yacc = (jg == (s & 15)) ? y : yacc;
            if ((s & 15) == 15) yp[(size_t)(n * SC_TS + s - 15) * 512] = yacc;
            const f32x2 w01 = (f32x2){w.x, w.y}, w23 = (f32x2){w.z, w.w}, a01 = (f32x2){kka.x, kka.y}, a23 = (f32x2){kka.z, kka.w}, k01 = (f32x2){kt.x, kt.y}, k23 = (f32x2){kt.z, kt.w};
            S01 = S01 * w01 + (k01 * v - a01 * sa); S23 = S23 * w23 + (k23 * v - a23 * sa);
            w = wn; kka = kkan; kt = ktn; v = vn; c = cn;
        }
        if (n + 1 < T_ / SC_TS) SC_LSTORE(nb);
        __syncthreads();
    }
#undef SC_GLOAD
#undef SC_EXP4
#undef SC_LSTORE
}

__device__ __forceinline__ void rwkv_post(const Args& a, const float* Y, const bf16_t* VS, const bf16_t* L, const float* C, bf16_t* O, int gw, int NGW, int lane) {
    const int h = gw & 7, col = h * 64 + (lane & 15) * 4, q = lane >> 4;
    const f32x4 lg = *(const f32x4*)(a.in[17] + col), lb = *(const f32x4*)(a.in[18] + col);
    for (int m4 = gw >> 3; m4 < M_ / 4; m4 += NGW >> 3) {
        const int m = m4 * 4 + q;
        const f32x4 y = *(const f32x4*)(Y + (size_t)m * 512 + col);
        const float mean = row16_sum((y.x + y.y) + (y.z + y.w)) * (1.f / 64.f); const f32x4 d = y - mean;
        const float var = row16_sum((d.x * d.x + d.y * d.y) + (d.z * d.z + d.w * d.w)) * (1.f / 64.f);
        const f32x4 yn = d * rsqrtf(var + GN_EPS) * lg + lb;
        const f32x4 v = UNPK4(*(const u32x2*)(VS + (size_t)m * 512 + col)), g = UNPK4(*(const u32x2*)(L + (size_t)m * LLD + 1024 + col));
        const float c3 = C[(size_t)m * 32 + h * 4 + 2];
        const f32x4 ov = (yn + v * c3) * g;
        *(u32x2*)(O + (size_t)m * DM + 512 + col) = PK4(ov);
    }
}

#define XB_TMO      128
#define XB_XCNT(j)  (256  + 64 * (j))
#define XB_XSUB(j)  (1280 + 64 * (j))
#define XB_XGEN(j)  (2304 + 64 * (j))
#define XB_TOP      3328
#define XB_TOPGEN   3392
#define XCD_BAR_WORDS 3456
#define XB_SPIN_CAP (1u << 18)

__device__ __forceinline__ unsigned xb_ld(unsigned* p)              { return __hip_atomic_load(p, __ATOMIC_RELAXED, __HIP_MEMORY_SCOPE_AGENT); }
__device__ __forceinline__ unsigned xb_add(unsigned* p, unsigned v) { return __hip_atomic_fetch_add(p, v, __ATOMIC_RELAXED, __HIP_MEMORY_SCOPE_AGENT); }
__device__ __forceinline__ unsigned xb_xcc_id() { return (unsigned)__builtin_amdgcn_s_getreg((3 << 11) | 20) & 0xFu; }
#define XB_SPIN(cond, bar) do { unsigned _sp = 0; while (cond) { __builtin_amdgcn_s_sleep(1); \
    if ((++_sp & 255u) == 0u) { if (xb_ld(&(bar)[XB_TMO])) break; if (_sp > XB_SPIN_CAP) { atomicAdd(&(bar)[XB_TMO], 1u); break; } } } } while (0)
struct XcdBarrier {
    unsigned* bar; unsigned x;
    volatile LAS unsigned* st;
};

__device__ __forceinline__ XcdBarrier xcd_barrier_post(unsigned* bar, volatile LAS unsigned* st) {
    XcdBarrier b; b.bar = bar; b.x = xb_xcc_id(); b.st = st;
    if (threadIdx.x == 0) (void)xb_add(&bar[XB_XCNT(b.x)], 1u);
    return b;
}
__device__ __forceinline__ void xcd_barrier_complete(unsigned* bar, unsigned x, unsigned& nloc, unsigned& nx) {
    const unsigned G = gridDim.x * gridDim.y * gridDim.z;
    unsigned sum, cnt, mine, sp = 0u;
    for (;;) {
        sum = 0u; cnt = 0u; mine = 0u;
#pragma unroll
        for (unsigned j = 0; j < 16; ++j) { const unsigned c = xb_ld(&bar[XB_XCNT(j)]); sum += c; cnt += (c > 0u) ? 1u : 0u; mine = (j == x) ? c : mine; }
        if (sum == G) break;
        __builtin_amdgcn_s_sleep(1);
        if ((++sp & 255u) == 0u) { if (xb_ld(&bar[XB_TMO])) break; if (sp > XB_SPIN_CAP) { atomicAdd(&bar[XB_TMO], 1u); break; } }
    }
    nloc = mine > 0u ? mine : 1u; nx = cnt > 0u ? cnt : 1u;
}

__device__ __forceinline__ void xcd_barrier(const XcdBarrier& b) {
    asm volatile("s_waitcnt vmcnt(0)" ::: "memory");
    __syncthreads();
    if (threadIdx.x == 0) {
        unsigned* bar = b.bar;
        __builtin_amdgcn_s_waitcnt(0);
        unsigned nloc = b.st[0], nx = b.st[1];
        if (nloc == 0u) { xcd_barrier_complete(bar, b.x, nloc, nx); b.st[0] = nloc; b.st[1] = nx; }
        const unsigned old = xb_add(&bar[XB_XSUB(b.x)], 1u);
        const unsigned gen = old / nloc;
        if (old + 1u == (gen + 1u) * nloc) {
            __builtin_amdgcn_fence(__ATOMIC_RELEASE, "agent");
            asm volatile("s_waitcnt vmcnt(0)" ::: "memory");
            const unsigned og = xb_add(&bar[XB_TOP], 1u);
            const unsigned tg = og / nx;
            if (og + 1u == (tg + 1u) * nx) xb_add(&bar[XB_TOPGEN], 1u);
            else XB_SPIN(xb_ld(&bar[XB_TOPGEN]) == tg, bar);
            __builtin_amdgcn_fence(__ATOMIC_ACQUIRE, "agent");
            xb_add(&bar[XB_XGEN(b.x)], 1u);
            asm volatile("s_waitcnt vmcnt(0)" ::: "memory");
        } else {
            XB_SPIN(xb_ld(&bar[XB_XGEN(b.x)]) == gen, bar);
            __builtin_amdgcn_fence(__ATOMIC_ACQUIRE, "agent");
            asm volatile("s_waitcnt vmcnt(0)" ::: "memory");
        }
    }
    __syncthreads();
}

__device__ __forceinline__ void run_gemm0(LAS unsigned char* lds, const bf16_t* A, const bf16_t* Bt, int M, int N, int K, int lda, bf16_t* Oo, int ldc, const float* rscale = nullptr) {
    pg8::Gemm g{A, Bt, M, N, K, lda, (size_t)128, 0}; pg8::StaticOrder S; S.init(M, N, (int)gridDim.x, (int)blockIdx.x);
    pg8::EpiStore<0> E{Oo, ldc, nullptr, rscale};

#ifndef NO_GEMM
    pg8::gemm_phase<pg8::EpiStore<0>, pg8::StaticOrder, true, true>(lds, g, S, E);
#endif
}


#define Wt_hyin ((bf16_t*)(ws + WS_HYIN))
#define Wt_hyout ((bf16_t*)(ws + WS_HYOUT))
#define Wt_nsain ((bf16_t*)(ws + WS_NSAIN))
#define Wt_nsaout ((bf16_t*)(ws + WS_NSAOUT))
#define Wt_lora ((bf16_t*)(ws + WS_LORA))
#define Wt_cw1k ((bf16_t*)(ws + WS_CW1K))
#define Wt_cw1v ((bf16_t*)(ws + WS_CW1V))
#define cbias ((float*)(ws + WS_CBIAS))
#define W2T ((bf16_t*)(ws + WS_CBIAS + 4096))
#define RS ((float*)(ws + WS_CBIAS + 131072))
#define H ((bf16_t*)(ws + WS_H))
#define Z ((bf16_t*)(ws + WS_Z))
#define AP ((bf16_t*)(ws + WS_AP))
#define O ((bf16_t*)(ws + WS_O))
#define L ((bf16_t*)(ws + WS_L))
#define C ((float*)(ws + WS_C))
#define MM ((bf16_t*)(ws + WS_MM))
#define Y ((float*)(ws + WS_MM))
#define HID ((bf16_t*)(ws + WS_HID))
#define KC ((bf16_t*)(ws + WS_KCMP))
#define VC ((bf16_t*)(ws + WS_VCMP))
#define U ((bf16_t*)(ws + WS_U))
#define HB ((float*)(ws + WS_O))
#define KW ((unsigned*)(ws + WS_H))
#define WE ((bf16_t*)(__attribute__((address_space(1))) bf16_t*)args.out)
#define KKA (WE + (size_t)M_ * 512)
#define KT (WE + (size_t)M_ * 1024)
#define VS (WE + (size_t)M_ * 1536)
#define XIN ((const float*)(__attribute__((address_space(1))) const float*)args.in[0])
#define X ((float*)(__attribute__((address_space(1))) float*)args.out)
#define PH_BEGIN unsigned char* const ws = args.ws; int tid_ = threadIdx.x; asm volatile("" : "+v"(tid_)); const int tid = tid_, lane = tid & 63, wave = __builtin_amdgcn_readfirstlane(tid >> 6); const int G = gridDim.x, gw = blockIdx.x * 8 + wave, NGW = G * 8; const int gtid = blockIdx.x * 512 + tid, NT = G * 512; (void)lane; (void)gw; (void)NGW; (void)gtid; (void)NT; (void)ws;
__global__ void __launch_bounds__(512, 2) mega_fwd(Args args) {
    extern __shared__ __attribute__((aligned(16))) unsigned char lds_raw[];
    LAS unsigned char* lds = (LAS unsigned char*)lds_raw;
    cg::grid_group grid = cg::this_grid();
    volatile LAS unsigned* xst = (volatile LAS unsigned*)(lds + LDS_BYTES - 64);
    if (threadIdx.x < 2) xst[threadIdx.x] = 0u;
    __syncthreads();
    const XcdBarrier xbar = xcd_barrier_post((unsigned*)args.ws, xst);
    const int lo = args.ph_lo, hi = args.ph_hi;
#define IN(k) (lo <= (k) && (k) < hi)
#ifndef DUP_MASK
#define DUP_MASK 0u
#endif
#define REP(k) for (int rep_ = 0; rep_ < (((DUP_MASK >> (k)) & 1u) ? 2 : 1); ++rep_)
#define SEAM(k) do { if (IN(k) && IN((k) + 1)) { if ((k) == 0) grid.sync(); else xcd_barrier(xbar); } } while (0)

#ifdef EXTRA_SYNCS
    if (IN(0) && IN(1)) for (int es_ = 0; es_ < EXTRA_SYNCS; ++es_) grid.sync();
#endif
    if (IN(0)) REP(0) { PH_BEGIN
        LAS float* scr = (LAS float*)(lds + wave * 16384);
        constexpr int I0 = 16 * 80, I1 = 16 * 32, I2 = 16 * 88, I3 = 16 * 32, I4 = 16 * 176, I5 = 44 * 32, I6 = 32 * 8;
        constexpr int NIT = I0 + I1 + I2 + I3 + 2 * I4 + 2 * I5 + 2 * I6;
        for (int it = gw; it < NIT; it += NGW) {
            int r = it;
            if (r < I0) { transpose_item(args.in[5], 2560, Wt_hyin, 1024, scr, r, 80, lane, args.in[1]); continue; } r -= I0;
            if (r < I1) { transpose_item(args.in[6], 1024, Wt_hyout, 1024, scr, r, 32, lane); continue; } r -= I1;
            if (r < I2) { transpose_item(args.in[19], 2608, Wt_nsain, 1024, scr, r, 88, lane, args.in[1] + 1024); continue; } r -= I2;
            if (r < I3) { transpose_item(args.in[20], 1024, Wt_nsaout, 1024, scr, r, 32, lane); continue; } r -= I3;
            if (r < 2 * I4) { const int l = r / I4; transpose_item(args.in[27] + (size_t)l * 1024 * 5632, 5632, (bf16_t*)(ws + (l ? WS_UP1 : WS_UP0)), 1024, scr, r % I4, 176, lane, args.in[3] + l * 1024, true); continue; } r -= 2 * I4;
            if (r < 2 * I5) { const int l = r / I5; transpose_item(args.in[30] + (size_t)l * 2816 * 1024, 1024, (bf16_t*)(ws + (l ? WS_DN1 : WS_DN0)), 2816, scr, r % I5, 32, lane); continue; } r -= 2 * I5;
            if (r < I6) { transpose_item(args.in[22], 256, Wt_cw1k, 2048, scr, r, 8, lane); continue; } r -= I6;
            transpose_item(args.in[25], 256, Wt_cw1v, 2048, scr, r, 8, lane);
        }
        for (int e = gtid; e < 1536 * 256; e += NT) {
            const int n = e >> 8, k = e & 255; float v = 0.f;
            if (n < 512) { if (k < 64) v = args.in[10][k * 512 + n]; }
            else if (n < 1024) { if (k >= 64 && k < 128) v = args.in[12][(k - 64) * 512 + (n - 512)]; }
            else { if (k >= 128) v = args.in[13][(k - 128) * 512 + (n - 1024)]; }
            Wt_lora[e] = (bf16_t)(pk2(v, 0.f) & 0xffffu);
        }
        for (int e = gtid; e < 2 * 16384; e += NT) { const int which = e >> 14, d = (e >> 8) & 63, f = e & 255; W2T[e] = (bf16_t)(pk2(args.in[which ? 26 : 23][f * 64 + d], 0.f) & 0xffffu); }
        for (int it = gw; it < 512; it += NGW) {
            const int which = it >> 8, f = it & 255; const float* pos = args.in[which ? 24 : 21]; const float* w1 = args.in[which ? 25 : 22];
            float s = 0.f;
            for (int e = lane; e < 2048; e += 64) s += pos[e] * w1[(size_t)e * 256 + f];
            s = wave_sum(s);
            if (lane == 0) cbias[it] = s;
        }
        norm_phase(XIN, nullptr, nullptr, nullptr, nullptr, H, RS, gw, NGW, lane);
    }
    SEAM(0);
    if (IN(1)) REP(1) { PH_BEGIN run_gemm0(lds, H, Wt_hyin, M_, ZLD0, 1024, 1024, Z, ZLD0, RS); }
    SEAM(1);
    if (IN(2)) REP(2) { PH_BEGIN
        const float* mu = args.in[8];
        for (int it = gtid; it < M_ * 32; it += NT) {
            const int m = it >> 5, col = (it & 31) * 8;
            const bf16_t* zp = Z + (size_t)m * ZLD0 + 2304 + col;
            const u32x4 zc = *(const u32x4*)zp; u32x4 zq = (u32x4){0u, 0u, 0u, 0u};
            if ((m & (T_ - 1)) != 0) zq = *(const u32x4*)(zp - ZLD0);
            const unsigned cw[4] = {zc.x, zc.y, zc.z, zc.w}, pw[4] = {zq.x, zq.y, zq.z, zq.w}; unsigned ow[4];
#pragma unroll
            for (int e = 0; e < 4; ++e) {
                float a0 = bf2f(cw[e] & 0xffffu), a1 = bf2f(cw[e] >> 16); const float p0 = bf2f(pw[e] & 0xffffu), p1 = bf2f(pw[e] >> 16);
                a0 += (p0 - a0) * mu[1536 + col + 2 * e]; a1 += (p1 - a1) * mu[1536 + col + 2 * e + 1];
                if (col < 64) { a0 = tanhf(a0); a1 = tanhf(a1); } else if (col >= 128) { a0 = sigmoidf_(a0); a1 = sigmoidf_(a1); }
                ow[e] = pk2(a0, a1);
            }
            *(u32x4*)(AP + (size_t)m * 256 + col) = (u32x4){ow[0], ow[1], ow[2], ow[3]};
        }

#ifndef NO_SWA
for (int u = blockIdx.x; u < NB_ * 64 * 2; u += G) swa_unit(u, Z, O, args.in[7], lds, tid);
#endif

        __syncthreads();
    }
    SEAM(2);
    if (IN(3)) REP(3) { PH_BEGIN run_gemm0(lds, AP, Wt_lora, M_, LLD, 256, 256, L, LLD); }
    SEAM(3);
    if (IN(4)) REP(4) { PH_BEGIN rwkv_prep(args, Z, L, KW, WE, KKA, KT, VS, C, gw, NGW, lane); }
    SEAM(4);
    if (IN(5)) REP(5) { PH_BEGIN
#ifndef NO_SCAN
for (int u = blockIdx.x; u < 256; u += G) scan_unit(u, KW, WE, KKA, KT, VS, C, Y, lds, tid);
#endif
 }
    SEAM(5);
    if (IN(6)) REP(6) { PH_BEGIN rwkv_post(args, Y, VS, L, C, O, gw, NGW, lane); }
    SEAM(6);
    if (IN(7)) REP(7) { PH_BEGIN run_gemm0(lds, O, Wt_hyout, M_, 1024, 1024, 1024, MM, 1024); }
    SEAM(7);
    if (IN(8)) REP(8) { PH_BEGIN norm_phase(XIN, nullptr, MM, args.in[2], nullptr, H, RS, gw, NGW, lane); }
    SEAM(8);
#pragma unroll
    for (int l = 0; l < 2; ++l) {
        const int pb = l ? 19 : 9;
        if (IN(pb)) REP(pb) { PH_BEGIN
            pg8::Gemm g{H, (const bf16_t*)(ws + (l ? WS_UP1 : WS_UP0)), M_, ULD, 1024, 1024, (size_t)128, 0}; pg8::StaticOrder S; S.init(M_, ULD, G, (int)blockIdx.x);
            pg8::EpiConv E{U, RS, args.in[28] + (size_t)l * 3 * FF_, args.in[29] + (size_t)l * FF_, HB};
            pg8::gemm_phase<pg8::EpiConv, pg8::StaticOrder, true, true>(lds, g, S, E);
        }
        SEAM(pb);
        if (IN(pb + 1)) REP(pb + 1) { PH_BEGIN
            const float* cw = args.in[28] + (size_t)l * 3 * FF_; const float* cbv = args.in[29] + (size_t)l * FF_;
            for (int e = gtid; e < 256 * 22 * 4 * 2 * 128; e += NT) {
                const int col = e & 127, r = (e >> 7) & 1, gq = e >> 8, gi = gq & 3, tp = gq >> 2, pn = tp % 22, pm = tp / 22, f = pn * 128 + col;
                const float* hb = HB + ((size_t)gq * 6) * 128 + col;
                const float* hp = gi > 0 ? hb - 6 * 128 : hb - (size_t)(22 * 4 - 3) * 6 * 128;
                const bool top = gi == 0 && ((pm * 256) & (T_ - 1)) == 0;
                const float g0 = hb[(2 + r) * 128], vv = hb[(4 + r) * 128];
                const float gm1 = r == 1 ? hb[2 * 128] : (top ? 0.f : hp[1 * 128]);
                const float gm2 = r == 1 ? (top ? 0.f : hp[1 * 128]) : (top ? 0.f : hp[0]);
                const float xv = cbv[f] + g0 * cw[2 * FF_ + f] + gm1 * cw[FF_ + f] + gm2 * cw[f];
                U[(size_t)(pm * 256 + gi * 64 + r) * FF_ + f] = (bf16_t)(pk2(pg8::gelu_tanh(xv) * vv, 0.f) & 0xffffu);
            }
        }
        SEAM(pb + 1);
        if (IN(pb + 2)) REP(pb + 2) { PH_BEGIN run_gemm0(lds, U, (const bf16_t*)(ws + (l ? WS_DN1 : WS_DN0)), M_, 1024, FF_, FF_, MM, 1024); }
        SEAM(pb + 2);
        if (IN(pb + 3)) REP(pb + 3) { PH_BEGIN
            if (l == 0) norm_phase(nullptr, H, MM, args.in[4], nullptr, H, RS, gw, NGW, lane);
            else norm_phase(nullptr, H, MM, args.in[4] + 1024, X, nullptr, nullptr, gw, NGW, lane);
        }
        if (l == 0) {
            SEAM(12);
            if (IN(13)) REP(13) { PH_BEGIN run_gemm0(lds, H, Wt_nsain, M_, ZLD1, 1024, 1024, Z, ZLD1, RS); }
            SEAM(13);
            if (IN(14)) REP(14) { PH_BEGIN
                const int G2 = G >> 1, which = (int)blockIdx.x >= G2 ? 1 : 0;
                pg8::Gemm g{Z + 1024 + which * 256, which ? Wt_cw1v : Wt_cw1k, 16384, 256, 2048, 16 * ZLD1, (size_t)ZLD1 * 2, 1};
                pg8::StaticOrder S; S.init(16384, 256, G2, (int)blockIdx.x - which * G2);
                pg8::EpiStore<2> E{HID + (size_t)which * 16384 * 256, 256, cbias + which * 256, nullptr};

#ifndef NO_GEMM2
if ((int)blockIdx.x < 2 * G2) pg8::gemm_phase<pg8::EpiStore<2>, pg8::StaticOrder, true, true>(lds, g, S, E);
#endif

            }
            SEAM(14);
            if (IN(15)) REP(15) { PH_BEGIN
                for (int wt = gw; wt < 2 * 512; wt += NGW) {
                    const int which = wt >> 9, row0 = (wt & 511) * 32, r32 = lane & 31, hi5 = lane >> 5;
                    const bf16_t* hp = HID + ((size_t)which * 16384 + row0 + r32) * 256 + hi5 * 8;
                    const bf16_t* wp = W2T + (size_t)which * 16384 + (size_t)r32 * 256 + hi5 * 8;
                    f32x16 c0, c1;
#pragma unroll
                    for (int r = 0; r < 16; ++r) { c0[r] = 0.f; c1[r] = 0.f; }
#pragma unroll 4
                    for (int ks = 0; ks < 16; ++ks) {
                        const bf16x8 av = *(const bf16x8*)(hp + ks * 16), b0 = *(const bf16x8*)(wp + ks * 16), b1 = *(const bf16x8*)(wp + 32 * 256 + ks * 16);
                        c0 = __builtin_amdgcn_mfma_f32_32x32x16_bf16(av, b0, c0, 0, 0, 0);
                        c1 = __builtin_amdgcn_mfma_f32_32x32x16_bf16(av, b1, c1, 0, 0, 0);
                    }
                    bf16_t* op = (which ? VC : KC) + (size_t)row0 * 64 + r32;
#pragma unroll
                    for (int r = 0; r < 16; ++r) { const int rw = crow(r, hi5); const bool pad = ((row0 + rw) & 255) == 255;
                        op[(size_t)rw * 64] = pad ? (bf16_t)0 : (bf16_t)(pk2(c0[r], 0.f) & 0xffffu); op[(size_t)rw * 64 + 32] = pad ? (bf16_t)0 : (bf16_t)(pk2(c1[r], 0.f) & 0xffffu); }
                }
            }
            SEAM(15);
            if (IN(16)) REP(16) { PH_BEGIN
#ifndef NO_NSA
{
                    unsigned* qctr = (unsigned*)args.ws + 3840 + rep_ * 16;
                    volatile LAS unsigned* qslot = (volatile LAS unsigned*)(lds + LDS_BYTES - 128);
                    for (;;) {
                        if (tid == 0) qslot[0] = atomicAdd(qctr, 1u);
                        __syncthreads();
                        const unsigned q = qslot[0];
                        __syncthreads();
                        if (q >= 4096u) break;
                        int ui, ug, ub;
                        if (q < 1024u) { ug = 3; ui = 63 - (int)(q >> 4); ub = (int)(q & 15u); }
                        else { const unsigned q2 = q - 1024u; ui = 63 - (int)(q2 / 48u); const unsigned rest = q2 % 48u; ug = (int)(rest % 3u); ub = (int)(rest / 3u); }
                        nsa_unit((ui << 6) | (ub << 2) | ug, Z, KC, VC, O, lds, tid);
                    }
                }
#endif
 }
            SEAM(16);
            if (IN(17)) REP(17) { PH_BEGIN run_gemm0(lds, O, Wt_nsaout, M_, 1024, 1024, 1024, MM, 1024); }
            SEAM(17);
            if (IN(18)) REP(18) { PH_BEGIN norm_phase(nullptr, H, MM, args.in[2] + 1024, nullptr, H, RS, gw, NGW, lane); }
            SEAM(18);
        }
    }
#undef IN
#undef SEAM
}

#undef XIN
#undef X
#undef H
#undef Z
#undef O
#undef L
#undef C
#undef U
#undef Y
extern "C" void kernel_launch(void* const* d_in, const int* in_sizes, int n_in, void* d_out, int out_size, void* d_ws, size_t ws_size, hipStream_t stream) {
    static int grid = 0;
    if (grid == 0) {
        if (n_in != 31 || out_size != M_ * DM || ws_size < WS_END) { fprintf(stderr, "kernel_launch: unexpected shapes (n_in %d out %d ws %zu)\n", n_in, out_size, ws_size); grid = -1; return; }
        int dev = 0, cus = 0, per_cu = 0;
        hipGetDevice(&dev); hipDeviceGetAttribute(&cus, hipDeviceAttributeMultiprocessorCount, dev);
        hipFuncSetAttribute((const void*)mega_fwd, hipFuncAttributeMaxDynamicSharedMemorySize, LDS_BYTES);
        hipOccupancyMaxActiveBlocksPerMultiprocessor(&per_cu, (const void*)mega_fwd, 512, LDS_BYTES);
        if (per_cu < 1) { fprintf(stderr, "kernel_launch: occupancy query says %d blocks/CU\n", per_cu); per_cu = 1; }
        (void)hipGetLastError();
        grid = cus * 1;
    }
    if (grid < 0) return;
    hipMemsetAsync(d_ws, 0, 16384, stream);
    Args a{};
    for (int i = 0; i < 31; ++i) a.in[i] = (const float*)d_in[i];
    a.out = (float*)d_out; a.ws = (unsigned char*)d_ws;
#if ONE_LAUNCH
    a.ph_lo = 0; a.ph_hi = NPHASE;
    void* kargs[] = {&a};
    hipError_t e = hipLaunchCooperativeKernel((const void*)mega_fwd, dim3(grid), dim3(512), kargs, LDS_BYTES, stream);
    if (e != hipSuccess) fprintf(stderr, "cooperative launch failed: %s (grid %d)\n", hipGetErrorString(e), grid);
#else
    for (int p = 0; p < NPHASE; ++p) { a.ph_lo = p; a.ph_hi = p + 1; hipLaunchKernelGGL(mega_fwd, dim3(grid), dim3(512), LDS_BYTES, stream, a); }
#endif
}
```

```cpp
#include <hip/hip_runtime.h>
#include <hip/hip_cooperative_groups.h>
#include <cstdio>
#include <cstdint>
namespace cg = cooperative_groups;

#ifndef ONE_LAUNCH
#define ONE_LAUNCH 1
#endif

namespace pg8 {
#define PG8_LAS __attribute__((address_space(3)))
typedef unsigned short bf16_t;
typedef short bf16x8 __attribute__((ext_vector_type(8)));
typedef float f32x4 __attribute__((ext_vector_type(4)));
typedef unsigned u32x4 __attribute__((ext_vector_type(4)));
constexpr int BM = 256, BK = 64, HALF = 128, HTB = HALF * BK * 2  , STAGE_BYTES = 8 * HTB, NXCD = 8, WGM = 8;

__host__ __device__ __forceinline__ int lds_byte(int r, int c) { const int st = (r >> 4) * 2 + (c >> 5), rr = r & 15, cc = c & 31, ob = rr * 64 + cc * 2; return st * 1024 + (ob ^ (((ob >> 9) & 1) << 5)); }
__host__ __device__ __forceinline__ void stage_rc(int b, int& R, int& C) { const int st = b / 1024, sb = b % 1024, swz = sb ^ (((sb >> 9) & 1) << 5); R = (st >> 1) * 16 + swz / 64; C = (st & 1) * 32 + (swz % 64) / 2; }
__host__ __device__ __forceinline__ int perm32(int rho) { const int n = rho >> 4, i = rho & 15; return 8 * (i >> 2) + 4 * n + (i & 3); }

struct Unit { int pm, pn; };
struct Gemm { const bf16_t* A; const bf16_t* Bt; int M, N, K; int lda; size_t a_kstep; int amode; };
__device__ __forceinline__ const char* a_base(const Gemm& g, int pm) { return g.amode == 0 ? (const char*)g.A + (size_t)pm * ((size_t)BM * g.lda * 2) : (const char*)g.A + (size_t)(pm >> 2) * ((size_t)4096 * 2816 * 2) + (size_t)(pm & 3) * 128; }

struct StaticOrder {
    int nM, nN, nwg, G, c;
    __host__ __device__ void init(int M, int N, int G_, int c_) { nM = M / BM; nN = N / BM; nwg = nM * nN; G = G_; c = c_; }
    __host__ __device__ bool next(int i, Unit& u) const {
        const long L = (long)i * G + c; if (L >= nwg) return false;
        int wgid = (int)L; { const int q = nwg / NXCD, r = nwg % NXCD, xcd = wgid % NXCD, off = wgid / NXCD; wgid = (xcd < r ? xcd * (q + 1) : r * (q + 1) + (xcd - r) * q) + off; }
        const int nig = WGM * nN, gid = wgid / nig, fm = gid * WGM, gsz = (nM - fm) < WGM ? (nM - fm) : WGM;
        u.pm = fm + ((wgid % nig) % gsz); u.pn = (wgid % nig) / gsz; return true;
    }
    __device__ __forceinline__ void a_ready(const Unit&) const {}
    __device__ __forceinline__ void done(const Unit&) const {}
};


__device__ __forceinline__ unsigned cvt_pk_bf16(float lo, float hi) { unsigned r; asm volatile("v_cvt_pk_bf16_f32 %0, %1, %2" : "=v"(r) : "v"(lo), "v"(hi)); return r; }
__device__ __forceinline__ float gelu_tanh(float x) { const float t = x * x; const float u = x * (-2.3022081945f - 0.1029432394f * t); return x * __builtin_amdgcn_rcpf(1.0f + __builtin_amdgcn_exp2f(u)); }
template <int ACT> struct EpiStore {
    static constexpr bool PERM = true, AFTER_DRAIN = false;
    bf16_t* O; int ldc; const float* bias; const float* rscale;
    __device__ __forceinline__ void operator()(const f32x4 (&acc)[2][2][4][2], const Unit& u, int wr, int wc, int fr, int fq) const {
        const int row0 = u.pm * BM + wr * 64 + fr; const int col0 = u.pn * BM + wc * 32 + 8 * fq;
        f32x4 bv[2][2];
#pragma unroll
        for (int bj = 0; bj < 2; ++bj)
#pragma unroll
            for (int n = 0; n < 2; ++n) bv[bj][n] = bias ? *(const f32x4*)(bias + col0 + bj * HALF + 4 * n) : (f32x4){0.f, 0.f, 0.f, 0.f};
#pragma unroll
        for (int ai = 0; ai < 2; ++ai)
#pragma unroll
            for (int m = 0; m < 4; ++m) { bf16_t* rowp = O + (size_t)(row0 + ai * HALF + m * 16) * ldc + col0; const float rsc = rscale ? rscale[row0 + ai * HALF + m * 16] : 1.f;
#pragma unroll
                for (int bj = 0; bj < 2; ++bj) { f32x4 v0 = acc[ai][bj][m][0] * rsc + bv[bj][0], v1 = acc[ai][bj][m][1] * rsc + bv[bj][1];
                    if (ACT == 2) { v0 = (f32x4){gelu_tanh(v0[0]), gelu_tanh(v0[1]), gelu_tanh(v0[2]), gelu_tanh(v0[3])}; v1 = (f32x4){gelu_tanh(v1[0]), gelu_tanh(v1[1]), gelu_tanh(v1[2]), gelu_tanh(v1[3])}; }
                    u32x4 w; w.x = cvt_pk_bf16(v0[0], v0[1]); w.y = cvt_pk_bf16(v0[2], v0[3]); w.z = cvt_pk_bf16(v1[0], v1[1]); w.w = cvt_pk_bf16(v1[2], v1[3]);
                    *(u32x4*)(rowp + bj * HALF) = w; } }
    }
};


__device__ __forceinline__ float dpp_ror1(float x) { return __int_as_float(__builtin_amdgcn_update_dpp(0, __float_as_int(x), 0x121, 0xf, 0xf, false)); }
__device__ __forceinline__ float dpp_ror2(float x) { return __int_as_float(__builtin_amdgcn_update_dpp(0, __float_as_int(x), 0x122, 0xf, 0xf, false)); }
struct EpiConv {
    static constexpr bool PERM = true, AFTER_DRAIN = false;
    bf16_t* ACT; const float* rscale; const float* cw; const float* cb; float* HB;
    __device__ __forceinline__ void operator()(const f32x4 (&acc)[2][2][4][2], const Unit& u, int wr, int wc, int fr, int fq) const {
        constexpr int FF = 2816;
        const int colw = wc * 32 + 8 * fq, f0 = u.pn * 128 + colw, row0 = u.pm * BM + wr * 64 + fr;
        f32x4 w0[2], w1[2], w2[2], cbv[2];
#pragma unroll
        for (int n = 0; n < 2; ++n) { w0[n] = *(const f32x4*)(cw + f0 + 4 * n); w1[n] = *(const f32x4*)(cw + FF + f0 + 4 * n); w2[n] = *(const f32x4*)(cw + 2 * FF + f0 + 4 * n); cbv[n] = *(const f32x4*)(cb + f0 + 4 * n); }
#pragma unroll
        for (int ai = 0; ai < 2; ++ai) {
            float* hb = HB + ((size_t)((u.pm * 22 + u.pn) * 4 + ai * 2 + wr) * 6) * 128 + colw;
            f32x4 prev[2];
#pragma unroll
            for (int n = 0; n < 2; ++n) prev[n] = (f32x4){0.f, 0.f, 0.f, 0.f};
#pragma unroll
            for (int m = 0; m < 4; ++m) {
                const float rsc = rscale[row0 + ai * HALF + m * 16];
                f32x4 g[2], v[2], res[2];
#pragma unroll
                for (int n = 0; n < 2; ++n) { g[n] = acc[ai][0][m][n] * rsc; v[n] = acc[ai][1][m][n] * rsc; }
#pragma unroll
                for (int n = 0; n < 2; ++n)
#pragma unroll
                    for (int e = 0; e < 4; ++e) {
                        const float gg = g[n][e], pp = prev[n][e];
                        const float r1g = dpp_ror1(gg), r1p = dpp_ror1(pp), r2g = dpp_ror2(gg), r2p = dpp_ror2(pp);
                        const float p1 = fr == 0 ? r1p : r1g, p2 = fr < 2 ? r2p : r2g;
                        const float xv = cbv[n][e] + gg * w2[n][e] + p1 * w1[n][e] + p2 * w0[n][e];
                        res[n][e] = gelu_tanh(xv) * v[n][e];
                    }
                if (m == 0 && fr < 2) {
#pragma unroll
                    for (int n = 0; n < 2; ++n) { *(f32x4*)(hb + (2 + fr) * 128 + 4 * n) = g[n]; *(f32x4*)(hb + (4 + fr) * 128 + 4 * n) = v[n]; }
                } else {
                    u32x4 w; w.x = cvt_pk_bf16(res[0][0], res[0][1]); w.y = cvt_pk_bf16(res[0][2], res[0][3]); w.z = cvt_pk_bf16(res[1][0], res[1][1]); w.w = cvt_pk_bf16(res[1][2], res[1][3]);
                    *(u32x4*)(ACT + (size_t)(row0 + ai * HALF + m * 16) * FF + f0) = w;
                }
                if (m == 3 && fr >= 14) {
#pragma unroll
                    for (int n = 0; n < 2; ++n) *(f32x4*)(hb + (fr - 14) * 128 + 4 * n) = g[n]; }
#pragma unroll
                for (int n = 0; n < 2; ++n) prev[n] = g[n];
            }
        }
    }
};

template <class Epi, class Sched, bool ALIGN_EPI = false, bool SP2 = false>
__device__ __forceinline__ void gemm_phase(PG8_LAS unsigned char* lds, const Gemm g, const Sched& S, const Epi& E) {
    int tid = threadIdx.x; asm volatile("" : "+v"(tid)); const int wid = __builtin_amdgcn_readfirstlane(tid >> 6), lane = tid & 63, wr = wid >> 2, wc = wid & 3, fr = lane & 15, fq = lane >> 4;
    const int K = g.K, nt = K / BK;
    unsigned voffA[2], voffB[2];
#pragma unroll
    for (int i = 0; i < 2; ++i) { int R, C; stage_rc(tid * 16 + i * 8192, R, C); const int Rb = Epi::PERM ? ((R & ~31) + perm32(R & 31)) : R;
        voffA[i] = (unsigned)(R * g.lda + C) * 2u; voffB[i] = (unsigned)(Rb * K + C) * 2u; }
    const size_t kstep = (size_t)(BK * 2);
    const size_t hstepB = (size_t)HALF * K * 2, hstepA = (size_t)HALF * g.lda * 2, kstepA = g.a_kstep;
    const size_t tstep = 2 * hstepB;
    const unsigned ldsw = (unsigned)wid * 1024u;
    const int aoff = lds_byte(wr * 64 + fr, fq * 8), boff = lds_byte(wc * 32 + fr, fq * 8);
#define PG8_SA(b, h) (((b) * 2 + (h)) * HTB)
#define PG8_SB(b, h) ((4 + (b) * 2 + (h)) * HTB)
#define PG8_STAGE(bufoff, gbase, voff) do { _Pragma("unroll") for (int _i = 0; _i < 2; ++_i) \
        __builtin_amdgcn_global_load_lds((const unsigned*)((const char*)(gbase) + (voff)[_i]), (PG8_LAS unsigned*)(lds + (bufoff) + ldsw + _i * 8192), 16, 0, 0); } while (0)
#define PG8_LDA(dst, b, h) do { _Pragma("unroll") for (int m = 0; m < 4; ++m) _Pragma("unroll") for (int k = 0; k < 2; ++k) dst[m][k] = *(const PG8_LAS bf16x8*)(lds + PG8_SA(b, h) + aoff + m * 2048 + k * 1024); } while (0)
#define PG8_LDB(dst, b, h) do { _Pragma("unroll") for (int n = 0; n < 2; ++n) _Pragma("unroll") for (int k = 0; k < 2; ++k) dst[n][k] = *(const PG8_LAS bf16x8*)(lds + PG8_SB(b, h) + boff + n * 2048 + k * 1024); } while (0)
#define PG8_MMA(ai, bj, At, Bt) do { __builtin_amdgcn_s_setprio(1); _Pragma("unroll") for (int m = 0; m < 4; ++m) _Pragma("unroll") for (int n = 0; n < 2; ++n) _Pragma("unroll") for (int k = 0; k < 2; ++k) \
        acc[ai][bj][m][n] = __builtin_amdgcn_mfma_f32_16x16x32_bf16(Bt[n][k], At[m][k], acc[ai][bj][m][n], 0, 0, 0); __builtin_amdgcn_s_setprio(0); } while (0)
#define PG8_WAIT_V(n) asm volatile("s_waitcnt vmcnt(" #n ")" ::: "memory")
#define PG8_WAIT_L(n) asm volatile("s_waitcnt lgkmcnt(" #n ")" ::: "memory")
#define PG8_BAR __builtin_amdgcn_s_barrier()
#define PG8_SCHED __builtin_amdgcn_sched_barrier(0)
    Unit cur, nxt; int ui = 0;
    if (!S.next(0, cur)) return;
    f32x4 acc[2][2][4][2];
#pragma unroll
    for (int a = 0; a < 2; ++a)
#pragma unroll
        for (int b = 0; b < 2; ++b)
#pragma unroll
            for (int m = 0; m < 4; ++m)
#pragma unroll
                for (int n = 0; n < 2; ++n) acc[a][b][m][n] = (f32x4){0.f, 0.f, 0.f, 0.f};
    bf16x8 At[4][2], B0[2][2], B1[2][2];
    const char* cA = a_base(g, cur.pm); const char* cB = (const char*)g.Bt + (size_t)cur.pn * tstep;
    S.a_ready(cur);
    if constexpr (SP2) {
        PG8_STAGE(PG8_SB(0, 0), cB, voffB); PG8_STAGE(PG8_SB(0, 1), cB + hstepB, voffB); PG8_STAGE(PG8_SA(0, 0), cA, voffA); PG8_STAGE(PG8_SA(0, 1), cA + hstepA, voffA);
        if (wr == 1) PG8_BAR;
        PG8_WAIT_V(2); PG8_BAR;
        PG8_STAGE(PG8_SB(1, 0), cB + kstep, voffB); PG8_STAGE(PG8_SA(1, 0), cA + kstepA, voffA); PG8_STAGE(PG8_SB(1, 1), cB + hstepB + kstep, voffB);
        PG8_WAIT_V(6); PG8_BAR;
    } else {
        PG8_STAGE(PG8_SB(0, 0), cB, voffB); PG8_STAGE(PG8_SA(0, 0), cA, voffA); PG8_STAGE(PG8_SB(0, 1), cB + hstepB, voffB); PG8_STAGE(PG8_SA(0, 1), cA + hstepA, voffA);
        if (wr == 1) PG8_BAR;
        PG8_WAIT_V(4); PG8_BAR;
        PG8_STAGE(PG8_SB(1, 0), cB + kstep, voffB); PG8_STAGE(PG8_SA(1, 0), cA + kstepA, voffA); PG8_STAGE(PG8_SB(1, 1), cB + hstepB + kstep, voffB);
        PG8_WAIT_V(6); PG8_BAR;
    }
    for (;;) {
        const bool has_next = S.next(ui + 1, nxt);
        const char* nA = has_next ? a_base(g, nxt.pm) : cA; const char* nB = has_next ? (const char*)g.Bt + (size_t)nxt.pn * tstep : cB;
        for (int t = 0; t < nt; t += 2) {
            const bool last = (t == nt - 2);
            const char* a1 = cA + (size_t)(t + 1) * kstepA;
            const char* a2 = last ? nA : cA + (size_t)(t + 2) * kstepA; const char* b2 = last ? nB : cB + (size_t)(t + 2) * kstep;
            const char* a3 = a2 + kstepA; const char* b3 = b2 + kstep;
            if (last && has_next) S.a_ready(nxt);
            if constexpr (SP2) {
            PG8_LDB(B0, 0, 0); PG8_LDB(B1, 0, 1); PG8_SCHED; PG8_LDA(At, 0, 0); PG8_STAGE(PG8_SA(1, 1), a1 + hstepA, voffA);
            PG8_WAIT_V(8); PG8_WAIT_L(0); PG8_BAR; PG8_MMA(0, 0, At, B0); PG8_MMA(0, 1, At, B1); PG8_BAR; PG8_SCHED;
            PG8_LDA(At, 0, 1); PG8_STAGE(PG8_SB(0, 0), b2, voffB); PG8_STAGE(PG8_SB(0, 1), b2 + hstepB, voffB); PG8_STAGE(PG8_SA(0, 0), a2, voffA);
            PG8_WAIT_V(8); PG8_WAIT_L(0); PG8_BAR; PG8_MMA(1, 0, At, B0); PG8_MMA(1, 1, At, B1); PG8_BAR; PG8_SCHED;
            PG8_LDB(B0, 1, 0); PG8_LDB(B1, 1, 1); PG8_SCHED; PG8_LDA(At, 1, 0); PG8_STAGE(PG8_SA(0, 1), a2 + hstepA, voffA);
            PG8_WAIT_V(8); PG8_WAIT_L(0); PG8_BAR; PG8_MMA(0, 0, At, B0); PG8_MMA(0, 1, At, B1); PG8_BAR; PG8_SCHED;
            PG8_LDA(At, 1, 1); PG8_STAGE(PG8_SB(1, 0), b3, voffB); PG8_STAGE(PG8_SB(1, 1), b3 + hstepB, voffB); PG8_STAGE(PG8_SA(1, 0), a3, voffA);
            PG8_WAIT_V(8); PG8_WAIT_L(0); PG8_BAR; PG8_MMA(1, 0, At, B0); PG8_MMA(1, 1, At, B1); PG8_BAR; PG8_SCHED;
            } else {
            PG8_LDB(B0, 0, 0); PG8_SCHED; PG8_LDA(At, 0, 0); PG8_STAGE(PG8_SA(1, 1), a1 + hstepA, voffA);
            PG8_WAIT_L(8); PG8_BAR; PG8_WAIT_L(0); PG8_MMA(0, 0, At, B0); PG8_BAR; PG8_SCHED;
            PG8_LDB(B1, 0, 1); PG8_STAGE(PG8_SB(0, 0), b2, voffB);
            PG8_BAR; PG8_WAIT_L(0); PG8_MMA(0, 1, At, B1); PG8_BAR;
            PG8_LDA(At, 0, 1); PG8_STAGE(PG8_SA(0, 0), a2, voffA);
            PG8_BAR; PG8_WAIT_L(0); PG8_MMA(1, 0, At, B0); PG8_BAR; PG8_SCHED;
            PG8_STAGE(PG8_SB(0, 1), b2 + hstepB, voffB);
            PG8_WAIT_V(6); PG8_BAR; PG8_MMA(1, 1, At, B1); PG8_BAR;
            PG8_LDB(B0, 1, 0); PG8_SCHED; PG8_LDA(At, 1, 0); PG8_STAGE(PG8_SA(0, 1), a2 + hstepA, voffA);
            PG8_WAIT_L(8); PG8_BAR; PG8_WAIT_L(0); PG8_MMA(0, 0, At, B0); PG8_BAR; PG8_SCHED;
            PG8_LDB(B1, 1, 1); PG8_STAGE(PG8_SB(1, 0), b3, voffB);
            PG8_BAR; PG8_WAIT_L(0); PG8_MMA(0, 1, At, B1); PG8_BAR;
            PG8_LDA(At, 1, 1); PG8_STAGE(PG8_SA(1, 0), a3, voffA);
            PG8_BAR; PG8_WAIT_L(0); PG8_MMA(1, 0, At, B0); PG8_BAR; PG8_SCHED;
            PG8_STAGE(PG8_SB(1, 1), b3 + hstepB, voffB);
            PG8_WAIT_V(6); PG8_BAR; PG8_MMA(1, 1, At, B1); PG8_BAR;
            }
        }
        if constexpr (ALIGN_EPI) { if (wr == 0) PG8_BAR; }
        if constexpr (!Epi::AFTER_DRAIN) { E(acc, cur, wr, wc, fr, fq); S.done(cur); }
        if (!has_next) break;
#pragma unroll
        for (int a = 0; a < 2; ++a)
#pragma unroll
            for (int b = 0; b < 2; ++b)
#pragma unroll
                for (int m = 0; m < 4; ++m)
#pragma unroll
                    for (int n = 0; n < 2; ++n) acc[a][b][m][n] = (f32x4){0.f, 0.f, 0.f, 0.f};
        cur = nxt; cA = nA; cB = nB; ++ui;
        if constexpr (ALIGN_EPI) { if (wr == 1) PG8_BAR; }
    }
    PG8_WAIT_V(0);
    if constexpr (!ALIGN_EPI) { if (wr == 0) PG8_BAR; }
    PG8_BAR;
    if constexpr (Epi::AFTER_DRAIN) { E.fused(acc, cur, wr, wc, fr, fq, lds, wid, lane); S.done(cur); }
#undef PG8_SA
#undef PG8_SB
#undef PG8_STAGE
#undef PG8_LDA
#undef PG8_LDB
#undef PG8_MMA
#undef PG8_WAIT_V
#undef PG8_WAIT_L
#undef PG8_BAR
#undef PG8_SCHED
}
}


#define LAS __attribute__((address_space(3)))
typedef unsigned short bf16_t;
typedef short bf16x8 __attribute__((ext_vector_type(8)));
typedef short s16x4 __attribute__((ext_vector_type(4)));
typedef float f32x4 __attribute__((ext_vector_type(4)));
typedef float f32x2 __attribute__((ext_vector_type(2)));
typedef float f32x16 __attribute__((ext_vector_type(16)));
typedef unsigned u32x4 __attribute__((ext_vector_type(4)));
typedef unsigned u32x2 __attribute__((ext_vector_type(2)));

constexpr int T_ = 4096, NB_ = 16, M_ = NB_ * T_, DM = 1024;
constexpr int ZLD0 = 2560, ZLD1 = 2816, FF_ = 2816, ULD = 5632, LLD = 1536;
constexpr float NORM_EPS = 1e-6f, GN_EPS = 64e-5f;
constexpr size_t MiB = (size_t)1 << 20;
constexpr size_t WS_HYIN = 1 * MiB, WS_HYOUT = 6 * MiB, WS_NSAIN = 8 * MiB, WS_NSAOUT = 14 * MiB, WS_UP0 = 16 * MiB, WS_UP1 = 27 * MiB,
                 WS_DN0 = 38 * MiB, WS_DN1 = 44 * MiB, WS_LORA = 50 * MiB, WS_CW1K = 51 * MiB, WS_CW1V = 52 * MiB, WS_CBIAS = 53 * MiB;
constexpr size_t WS_H = 64 * MiB, WS_Z = 192 * MiB, WS_AP = 512 * MiB, WS_O = 544 * MiB, WS_L = 672 * MiB, WS_C = 864 * MiB, WS_MM = 896 * MiB;
constexpr size_t WS_HID = 672 * MiB, WS_KCMP = 688 * MiB, WS_VCMP = 690 * MiB, WS_U = 192 * MiB, WS_END = 1024 * MiB;
constexpr int LDS_BYTES = 163840;
constexpr int NPHASE = 23;

__device__ __forceinline__ float bf2f(unsigned u) { return __uint_as_float(u << 16); }
__device__ __forceinline__ unsigned pk2(float lo, float hi) { return pg8::cvt_pk_bf16(lo, hi); }
__device__ __forceinline__ float wave_sum(float v) {
#pragma unroll
    for (int o = 1; o < 64; o <<= 1) v += __shfl_xor(v, o);
    return v;
}
__device__ __forceinline__ float sigmoidf_(float x) { return 1.0f / (1.0f + __expf(-x)); }
#define LDS_WAIT() asm volatile("s_waitcnt lgkmcnt(0)" ::: "memory")

struct Args { const float* in[31]; float* out; unsigned char* ws; int ph_lo, ph_hi; };

__device__ __forceinline__ void transpose_item(const float* W, int N, bf16_t* WT, int ldt, LAS float* scr, int item, int nblk, int lane, const float* gk = nullptr, bool gvmap = false) {
    const int kb = item / nblk, nb = item % nblk, k0 = 64 * kb, n0 = 32 * nb;
    const int n = n0 + (lane & 31);
#pragma unroll 8
    for (int i = 0; i < 32; ++i) { const int kk = 2 * i + (lane >> 5); scr[kk * 33 + (lane & 31)] = (n < N) ? W[(size_t)(k0 + kk) * N + n] * (gk ? gk[k0 + kk] : 1.f) : 0.f; }
    LDS_WAIT(); asm volatile("" ::: "memory");
    const int c = lane & 7;
#pragma unroll
    for (int j = 0; j < 4; ++j) { const int nn = (lane >> 3) + 8 * j; const LAS float* s = scr + (8 * c) * 33 + nn;
        u32x4 o; o.x = pk2(s[0 * 33], s[1 * 33]); o.y = pk2(s[2 * 33], s[3 * 33]); o.z = pk2(s[4 * 33], s[5 * 33]); o.w = pk2(s[6 * 33], s[7 * 33]);
        int drow = n0 + nn; if (gvmap) { const int isv = n0 >= 2816 ? 1 : 0, f = n0 - isv * 2816; drow = 256 * (f >> 7) + 128 * isv + (f & 127) + nn; }
        *(u32x4*)(WT + (size_t)drow * ldt + k0 + 8 * c) = o; }
    LDS_WAIT(); asm volatile("" ::: "memory");
}

__device__ __forceinline__ void norm_phase(const float* xf, const bf16_t* xb, const bf16_t* mm, const float* gpost, float* outf, bf16_t* outb, float* rs_out, int gw, int NGW, int lane) {
    for (int m = gw; m < M_; m += NGW) {
        f32x4 v[4];
        if (xf) { const f32x4* xr = (const f32x4*)(xf + (size_t)m * DM) + lane;
#pragma unroll
            for (int j = 0; j < 4; ++j) v[j] = xr[64 * j]; }
        else { const u32x2* xr = (const u32x2*)(xb + (size_t)m * DM) + lane;
#pragma unroll
            for (int j = 0; j < 4; ++j) { const u32x2 w = xr[64 * j]; v[j] = (f32x4){bf2f(w.x & 0xffffu), bf2f(w.x >> 16), bf2f(w.y & 0xffffu), bf2f(w.y >> 16)}; } }
        if (mm) {
            const u32x2* mr = (const u32x2*)(mm + (size_t)m * DM) + lane;
            f32x4 q[4]; float ss = 0.f;
#pragma unroll
            for (int j = 0; j < 4; ++j) { const u32x2 w = mr[64 * j]; q[j] = (f32x4){bf2f(w.x & 0xffffu), bf2f(w.x >> 16), bf2f(w.y & 0xffffu), bf2f(w.y >> 16)};
                ss += (q[j].x * q[j].x + q[j].y * q[j].y) + (q[j].z * q[j].z + q[j].w * q[j].w); }
            const float rs = rsqrtf(wave_sum(ss) * (1.f / DM) + NORM_EPS);
#pragma unroll
            for (int j = 0; j < 4; ++j) { const f32x4 g = *((const f32x4*)gpost + lane + 64 * j); v[j] = v[j] + q[j] * rs * g; }
        }
        if (outf) { f32x4* xo = (f32x4*)(outf + (size_t)m * DM) + lane;
#pragma unroll
            for (int j = 0; j < 4; ++j) xo[64 * j] = v[j]; }
        if (outb) { u32x2* xo = (u32x2*)(outb + (size_t)m * DM) + lane;
#pragma unroll
            for (int j = 0; j < 4; ++j) { u32x2 w; w.x = pk2(v[j].x, v[j].y); w.y = pk2(v[j].z, v[j].w); xo[64 * j] = w; } }
        if (rs_out) {
            float s2 = 0.f;
#pragma unroll
            for (int j = 0; j < 4; ++j) s2 += (v[j].x * v[j].x + v[j].y * v[j].y) + (v[j].z * v[j].z + v[j].w * v[j].w);
            const float rs2 = rsqrtf(wave_sum(s2) * (1.f / DM) + NORM_EPS);
            if (lane == 0) rs_out[m] = rs2;
        }
    }
}

constexpr int KROW = 144, VROW = 192, KT_BYTES = 64 * KROW, VT_BYTES = 64 * VROW;
constexpr float NEGBIG = -1e30f;
__device__ __forceinline__ int crow(int r, int hi) { return (r & 3) + 8 * (r >> 2) + 4 * hi; }
struct TileRegs { u32x4 k, v; };
__device__ __forceinline__ void tile_gload(TileRegs& r, const bf16_t* Kg, const bf16_t* Vg, size_t ld, int tid) {
    r.k = *(const u32x4*)(Kg + (size_t)(tid >> 3) * ld + (tid & 7) * 8);
    r.v = *(const u32x4*)(Vg + (size_t)(tid >> 3) * ld + (tid & 7) * 8);
}
__device__ __forceinline__ void tile_lstore(const TileRegs& r, LAS unsigned char* Ks, LAS unsigned char* Vs, int tid) {
    *(LAS u32x4*)(Ks + (tid >> 3) * KROW + (tid & 7) * 16) = r.k;
    *(LAS u32x4*)(Vs + (tid >> 3) * VROW + (tid & 7) * 16) = r.v;
}
constexpr float QSCALE = 0.125f * 1.4426950408889634f;
__device__ __forceinline__ void load_qfrag(bf16x8 (&qf)[4], const bf16_t* qrow, int hi) {
#pragma unroll
    for (int d0 = 0; d0 < 4; ++d0) { const u32x4 w = *(const u32x4*)(qrow + d0 * 16 + hi * 8);
        u32x4 o; o.x = pk2(bf2f(w.x & 0xffffu) * QSCALE, bf2f(w.x >> 16) * QSCALE); o.y = pk2(bf2f(w.y & 0xffffu) * QSCALE, bf2f(w.y >> 16) * QSCALE);
        o.z = pk2(bf2f(w.z & 0xffffu) * QSCALE, bf2f(w.z >> 16) * QSCALE); o.w = pk2(bf2f(w.w & 0xffffu) * QSCALE, bf2f(w.w >> 16) * QSCALE);
        qf[d0] = __builtin_bit_cast(bf16x8, o); }
}
constexpr float LOG2E = 1.4426950408889634f, RESCALE_THR = 14.f;
__device__ __forceinline__ float max3f(float a, float b, float c) { return fmaxf(fmaxf(a, b), c); }
template <int KSTEP>
__device__ __forceinline__ void attn_tile2(const LAS unsigned char* Ks, const LAS unsigned char* Vs, const bf16x8 (&qf)[4], f32x16 (&o)[2], float& mref, float& l,
                                           float basep, float ks2, int maskmode, int dl, int W, int r32, int hi, bool do_pv, f32x16* pout0, f32x16* pout1) {
    f32x16 s0, s1;
    const float off = ks2 * (float)(4 * hi) - basep;
#pragma unroll
    for (int r = 0; r < 16; ++r) { s0[r] = ks2 * (float)((r & 3) + 8 * (r >> 2)) + off; s1[r] = ks2 * (float)((r & 3) + 8 * (r >> 2) + 32) + off; }
#pragma unroll
    for (int d0 = 0; d0 < 4; ++d0) {
        const bf16x8 k0 = *(const LAS bf16x8*)(Ks + r32 * KROW + (d0 * 16 + hi * 8) * 2);
        const bf16x8 k1 = *(const LAS bf16x8*)(Ks + (32 + r32) * KROW + (d0 * 16 + hi * 8) * 2);
        s0 = __builtin_amdgcn_mfma_f32_32x32x16_bf16(k0, qf[d0], s0, 0, 0, 0);
        s1 = __builtin_amdgcn_mfma_f32_32x32x16_bf16(k1, qf[d0], s1, 0, 0, 0);
    }
    if (maskmode) {
        const int dl0 = dl - KSTEP * 4 * hi;
#pragma unroll
        for (int r = 0; r < 16; ++r) {
            const int d0 = dl0 - KSTEP * ((r & 3) + 8 * (r >> 2)), d1 = d0 - KSTEP * 32;
            const bool v0 = (!(maskmode & 1) || d0 >= 0) && (!(maskmode & 2) || d0 < W), v1 = (!(maskmode & 1) || d1 >= 0) && (!(maskmode & 2) || d1 < W);
            s0[r] = v0 ? s0[r] : NEGBIG; s1[r] = v1 ? s1[r] : NEGBIG;
        }
    }
    if (do_pv) {
        float mt = max3f(s0[0], s0[1], s1[0]);
        mt = max3f(mt, s1[1], s0[2]);
#pragma unroll
        for (int r = 2; r < 16; r += 2) { mt = max3f(mt, s0[r], s0[r + 1]); mt = max3f(mt, s1[r], s1[r + 1]); }
        mt = fmaxf(mt, __shfl_xor(mt, 32));
        if (__any(mt > RESCALE_THR)) {
            const float delta = fmaxf(mt, 0.f), sc = __builtin_amdgcn_exp2f(-delta);
            mref += delta; l *= sc;
#pragma unroll
            for (int r = 0; r < 16; ++r) { o[0][r] *= sc; o[1][r] *= sc; s0[r] -= delta; s1[r] -= delta; }
        }
    }
    float ps = 0.f;
#pragma unroll
    for (int r = 0; r < 16; ++r) { s0[r] = __builtin_amdgcn_exp2f(s0[r]); s1[r] = __builtin_amdgcn_exp2f(s1[r]); ps += s0[r] + s1[r]; }
    if (!do_pv) { *pout0 = s0; *pout1 = s1; return; }
    l += ps;
    const LAS unsigned char* vbase = Vs + (4 * hi + ((r32 & 15) >> 2)) * VROW + (16 * (r32 >> 4) + 4 * (r32 & 3)) * 2;
    bf16x8 pb[4];
    { u32x4 w; w.x = pk2(s0[0], s0[1]); w.y = pk2(s0[2], s0[3]); w.z = pk2(s0[4], s0[5]); w.w = pk2(s0[6], s0[7]); pb[0] = __builtin_bit_cast(bf16x8, w); }
    { u32x4 w; w.x = pk2(s0[8], s0[9]); w.y = pk2(s0[10], s0[11]); w.z = pk2(s0[12], s0[13]); w.w = pk2(s0[14], s0[15]); pb[1] = __builtin_bit_cast(bf16x8, w); }
    { u32x4 w; w.x = pk2(s1[0], s1[1]); w.y = pk2(s1[2], s1[3]); w.z = pk2(s1[4], s1[5]); w.w = pk2(s1[6], s1[7]); pb[2] = __builtin_bit_cast(bf16x8, w); }
    { u32x4 w; w.x = pk2(s1[8], s1[9]); w.y = pk2(s1[10], s1[11]); w.z = pk2(s1[12], s1[13]); w.w = pk2(s1[14], s1[15]); pb[3] = __builtin_bit_cast(bf16x8, w); }
#pragma unroll
    for (int dh = 0; dh < 2; ++dh) {
#pragma unroll
        for (int ks = 0; ks < 4; ++ks) {
            const LAS unsigned char* vp = vbase + ks * 16 * VROW + dh * 64;
            const s16x4 lo = __builtin_amdgcn_ds_read_tr16_b64_v4i16((LAS s16x4*)vp), hh = __builtin_amdgcn_ds_read_tr16_b64_v4i16((LAS s16x4*)(vp + 8 * VROW));
            const bf16x8 a8 = (bf16x8){lo[0], lo[1], lo[2], lo[3], hh[0], hh[1], hh[2], hh[3]};
            o[dh] = __builtin_amdgcn_mfma_f32_32x32x16_bf16(a8, pb[ks], o[dh], 0, 0, 0);
        }
        asm volatile("" ::: "memory");
    }
}
__device__ __forceinline__ void store_o(const f32x16 (&o)[2], bf16_t* orow, int hi) {
#pragma unroll
    for (int dh = 0; dh < 2; ++dh)
#pragma unroll
        for (int r4 = 0; r4 < 4; ++r4) { u32x2 w; w.x = pk2(o[dh][4 * r4], o[dh][4 * r4 + 1]); w.y = pk2(o[dh][4 * r4 + 2], o[dh][4 * r4 + 3]);
            *(u32x2*)(orow + dh * 32 + 8 * r4 + 4 * hi) = w; }
}

__device__ __forceinline__ void swa_unit(int u, const bf16_t* Z, bf16_t* O, const float* sinks, LAS unsigned char* lds, int tid) {
    const int g = u & 1, sb = (u >> 1) & 63, b = u >> 7;
    const int lane = tid & 63, w = tid >> 6, r32 = lane & 31, hi = lane >> 5;
    const int h = g * 4 + (w >> 1), t0 = sb * 64, t = t0 + (w & 1) * 32 + r32;
    const size_t mrow = (size_t)b * T_ + t;
    LAS unsigned char* Ks = lds; LAS unsigned char* Vs = lds + KT_BYTES;
    bf16x8 qf[4]; load_qfrag(qf, Z + mrow * ZLD0 + h * 64, hi);
    const float slope2 = exp2f(-(float)(h + 1)) * LOG2E;
    float mref = 0.f, l = hi == 0 ? __builtin_amdgcn_exp2f(sinks[h] * LOG2E) : 0.f;
    f32x16 o[2];
#pragma unroll
    for (int r = 0; r < 16; ++r) { o[0][r] = 0.f; o[1][r] = 0.f; }
    const int first = sb >= 2 ? 0 : 2 - sb;
    TileRegs tr;
    { const bf16_t* base = Z + ((size_t)b * T_ + t0) * ZLD0; tile_gload(tr, base + 512 + g * 64, base + 640 + g * 64, ZLD0, tid); }
    for (int ti = 2; ti >= first; --ti) {
        const int kp0 = t0 - 128 + 64 * ti;
        __syncthreads(); tile_lstore(tr, Ks, Vs, tid); __syncthreads();
        if (ti - 1 >= first) { const bf16_t* base = Z + ((size_t)b * T_ + kp0 - 64) * ZLD0; tile_gload(tr, base + 512 + g * 64, base + 640 + g * 64, ZLD0, tid); }
        const int dl = t - kp0;
        attn_tile2<1>(Ks, Vs, qf, o, mref, l, slope2 * (float)dl + mref, slope2, ti == 2 ? 1 : (ti == 0 ? 2 : 0), dl, 128, r32, hi, true, nullptr, nullptr);
    }
    l += __shfl_xor(l, 32);
    const float inv = 1.f / l;
#pragma unroll
    for (int r = 0; r < 16; ++r) { o[0][r] *= inv; o[1][r] *= inv; }
    store_o(o, O + mrow * DM + h * 64, hi);
}

constexpr int IMP_OFF = 21504, IMP_LD = 257, SELM_OFF = IMP_OFF + 64 * IMP_LD * 4  , UNI_OFF = SELM_OFF + 512;
__device__ __forceinline__ void nsa_unit(int u, const bf16_t* Z, const bf16_t* KC, const bf16_t* VC, bf16_t* O, LAS unsigned char* lds, int tid) {
    const int bg = u & 63, i = u >> 6, g = bg & 3, b = bg >> 2;
    const int lane = tid & 63, w = tid >> 6, r32 = lane & 31, hi = lane >> 5;
    const int hr = w >> 1, h = g * 4 + hr, t0 = i * 64, ql = (w & 1) * 32 + r32, t = t0 + ql;
    const size_t mrow = (size_t)b * T_ + t;
    LAS unsigned char* Ks = lds; LAS unsigned char* Vs = lds + KT_BYTES;
    LAS float* imp = (LAS float*)(lds + IMP_OFF);
    LAS unsigned* selm = (LAS unsigned*)(lds + SELM_OFF); LAS unsigned* uni = (LAS unsigned*)(lds + UNI_OFF);
    bf16x8 qf[4]; load_qfrag(qf, Z + mrow * ZLD1 + h * 64, hi);
    const float slope2 = exp2f(-0.5f * (float)(h + 1)) * LOG2E;
    const unsigned goff = (unsigned)(mrow * ZLD1) + 2560u + (unsigned)(h * 3);
    LAS float* park = (LAS float*)(lds + 88064) + tid;
    f32x16 o[2]; float mref, l; TileRegs tr;
    const size_t cbase = ((size_t)(b * 4 + g) * 256) * 64;
    const int ncv = min(4 * i + 3, 255), nct = (ncv + 63) >> 6;
    mref = 0.f; l = 0.f;
#pragma unroll
    for (int r = 0; r < 16; ++r) { o[0][r] = 0.f; o[1][r] = 0.f; }
    tile_gload(tr, KC + cbase + (size_t)(nct - 1) * 4096, VC + cbase + (size_t)(nct - 1) * 4096, 64, tid);
    for (int ti = nct - 1; ti >= 0; --ti) {
        __syncthreads(); tile_lstore(tr, Ks, Vs, tid); __syncthreads();
        if (ti > 0) tile_gload(tr, KC + cbase + (size_t)(ti - 1) * 4096, VC + cbase + (size_t)(ti - 1) * 4096, 64, tid);
        const int dl = t - 31 - 1024 * ti;
        attn_tile2<16>(Ks, Vs, qf, o, mref, l, slope2 * (float)dl + mref, 16.f * slope2, 1, dl, 0, r32, hi, true, nullptr, nullptr);
    }
    l += __shfl_xor(l, 32);
    const float invc = l > 0.f ? 1.f / l : 0.f;
    { const float wg = sigmoidf_(bf2f(Z[goff])) * invc;
#pragma unroll
      for (int r = 0; r < 16; ++r) { park[r * 512] = o[0][r] * wg; park[(16 + r) * 512] = o[1][r] * wg; } }
    if (i > 7) {
        tile_gload(tr, KC + cbase, VC + cbase, 64, tid);
        for (int ti = 0; ti < nct; ++ti) {
            __syncthreads(); tile_lstore(tr, Ks, Vs, tid); __syncthreads();
            if (ti + 1 < nct) tile_gload(tr, KC + cbase + (size_t)(ti + 1) * 4096, VC + cbase + (size_t)(ti + 1) * 4096, 64, tid);
            const int dl = t - 31 - 1024 * ti;
            f32x16 s0, s1; float dm = mref, dlq = 0.f;
            attn_tile2<16>(Ks, Vs, qf, o, dm, dlq, slope2 * (float)dl + mref, 16.f * slope2, 1, dl, 0, r32, hi, false, &s0, &s1);
            LAS float* ip = imp + ql * IMP_LD + ti * 64;
#pragma unroll
            for (int rr = 0; rr < 4; ++rr) {
                if (hr == rr) {
#pragma unroll
                    for (int r = 0; r < 16; ++r) { const int c = crow(r, hi);
                        if (rr == 0) { ip[c] = s0[r] * invc; ip[32 + c] = s1[r] * invc; } else { ip[c] += s0[r] * invc; ip[32 + c] += s1[r] * invc; } }
                }
                __syncthreads();
            }
        }
    }
    if (tid == 0) { uni[0] = 0u; uni[1] = 0u; }
    __syncthreads();
    if (tid < 64) {
        unsigned long long mask;
        if (i <= 7) mask = (2ull << i) - 1ull;
        else {
            float v0 = -1.f, v1 = -1.f, v2 = -1.f, v3 = -1.f, v4 = -1.f; int j0 = 0, j1 = 0, j2 = 0, j3 = 0, j4 = 0;
            const LAS float* ip = imp + tid * IMP_LD;
            for (int j = 1; j <= i - 2; ++j) {
                float v = ip[4 * j - 1] + 2.f * (ip[4 * j] + ip[4 * j + 1] + ip[4 * j + 2]) + ip[4 * j + 3]; int jj = j;
#define INS(vk, jk) if (v > vk) { const float tv = vk; const int tj = jk; vk = v; jk = jj; v = tv; jj = tj; }
                INS(v0, j0) INS(v1, j1) INS(v2, j2) INS(v3, j3) INS(v4, j4)
#undef INS
            }
            mask = 1ull | (1ull << i) | (1ull << (i - 1)) | (1ull << j0) | (1ull << j1) | (1ull << j2) | (1ull << j3) | (1ull << j4);
        }
        selm[2 * tid] = (unsigned)mask; selm[2 * tid + 1] = (unsigned)(mask >> 32);
        atomicOr((unsigned*)(uni), (unsigned)mask); atomicOr((unsigned*)(uni + 1), (unsigned)(mask >> 32));
    }
    __syncthreads();
    {
        unsigned long long um = (unsigned long long)uni[0] | ((unsigned long long)uni[1] << 32);
        mref = 0.f; l = 0.f;
#pragma unroll
        for (int r = 0; r < 16; ++r) { o[0][r] = 0.f; o[1][r] = 0.f; }
        int j = 63 - __builtin_clzll(um); um &= ~(1ull << j);
        { const bf16_t* base = Z + ((size_t)b * T_ + 64 * j) * ZLD1; tile_gload(tr, base + 1536 + g * 64, base + 1792 + g * 64, ZLD1, tid); }
        for (;;) {
            __syncthreads(); tile_lstore(tr, Ks, Vs, tid); __syncthreads();
            int jn = -1;
            if (um) { jn = 63 - __builtin_clzll(um); um &= ~(1ull << jn); }
            if (jn >= 0) { const bf16_t* base = Z + ((size_t)b * T_ + 64 * jn) * ZLD1; tile_gload(tr, base + 1536 + g * 64, base + 1792 + g * 64, ZLD1, tid); }
            const bool sel = (selm[2 * ql + (j >> 5)] >> (j & 31)) & 1u;
            const int dl = t - 64 * j;
            attn_tile2<1>(Ks, Vs, qf, o, mref, l, sel ? slope2 * (float)dl + mref : 1e30f, slope2, j == i ? 1 : 0, dl, 0, r32, hi, true, nullptr, nullptr);
            if (jn < 0) break;
            j = jn;
        }
        l += __shfl_xor(l, 32);
        const float wg = sigmoidf_(bf2f(Z[goff + 1])) / l;
#pragma unroll
        for (int r = 0; r < 16; ++r) { park[r * 512] += wg * o[0][r]; park[(16 + r) * 512] += wg * o[1][r]; }
    }
    {
        mref = 0.f; l = 0.f;
#pragma unroll
        for (int r = 0; r < 16; ++r) { o[0][r] = 0.f; o[1][r] = 0.f; }
        const int first = i >= 4 ? 0 : 4 - i;
        { const bf16_t* base = Z + ((size_t)b * T_ + t0) * ZLD1; tile_gload(tr, base + 2048 + g * 64, base + 2304 + g * 64, ZLD1, tid); }
        for (int ti = 4; ti >= first; --ti) {
            const int kp0 = t0 - 256 + 64 * ti;
            __syncthreads(); tile_lstore(tr, Ks, Vs, tid); __syncthreads();
            if (ti - 1 >= first) { const bf16_t* base = Z + ((size_t)b * T_ + kp0 - 64) * ZLD1; tile_gload(tr, base + 2048 + g * 64, base + 2304 + g * 64, ZLD1, tid); }
            const int dl = t - kp0;
            attn_tile2<1>(Ks, Vs, qf, o, mref, l, slope2 * (float)dl + mref, slope2, ti == 4 ? 1 : (ti == 0 ? 2 : 0), dl, 256, r32, hi, true, nullptr, nullptr);
        }
        l += __shfl_xor(l, 32);
        const float wg = sigmoidf_(bf2f(Z[goff + 2])) / l;
#pragma unroll
        for (int r = 0; r < 16; ++r) { o[0][r] = park[r * 512] + wg * o[0][r]; o[1][r] = park[(16 + r) * 512] + wg * o[1][r]; }
    }
    store_o(o, O + mrow * DM + h * 64, hi);
    __syncthreads();
}

__device__ __forceinline__ float dpp_xadd(float x, int which) {
    int r;
    const int xi = __float_as_int(x);
    if (which == 0) r = __builtin_amdgcn_update_dpp(0, xi, 0xB1, 0xf, 0xf, false);
    else if (which == 1) r = __builtin_amdgcn_update_dpp(0, xi, 0x4E, 0xf, 0xf, false);
    else if (which == 2) r = __builtin_amdgcn_update_dpp(0, xi, 0x141, 0xf, 0xf, false);
    else r = __builtin_amdgcn_update_dpp(0, xi, 0x140, 0xf, 0xf, false);
    return x + __int_as_float(r);
}
__device__ __forceinline__ float row16_sum(float x) { x = dpp_xadd(x, 0); x = dpp_xadd(x, 1); x = dpp_xadd(x, 2); x = dpp_xadd(x, 3); return x; }

#define UNPK4(w) (f32x4){bf2f((w).x & 0xffffu), bf2f((w).x >> 16), bf2f((w).y & 0xffffu), bf2f((w).y >> 16)}
#define PK4(v) (u32x2){pk2((v).x, (v).y), pk2((v).z, (v).w)}
__device__ __forceinline__ f32x4 sig4(f32x4 v) { return (f32x4){sigmoidf_(v.x), sigmoidf_(v.y), sigmoidf_(v.z), sigmoidf_(v.w)}; }
__device__ __forceinline__ void rwkv_prep(const Args& a, const bf16_t* Z, const bf16_t* L, unsigned* KW, bf16_t* WE, bf16_t* KKA, bf16_t* KT, bf16_t* VS, float* C, int gw, int NGW, int lane) {
    const int h = gw & 7, col = h * 64 + (lane & 15) * 4, q = lane >> 4;
    const f32x4 mu_r = *(const f32x4*)(a.in[8] + col), mu_k = *(const f32x4*)(a.in[8] + 512 + col), mu_v = *(const f32x4*)(a.in[8] + 1024 + col);
    const f32x4 w0 = *(const f32x4*)(a.in[9] + col), a0 = *(const f32x4*)(a.in[11] + col), k_k = *(const f32x4*)(a.in[14] + col), k_a = *(const f32x4*)(a.in[15] + col), r_k = *(const f32x4*)(a.in[16] + col);
    for (int m4 = gw >> 3; m4 < M_ / 4; m4 += NGW >> 3) {
        const int m = m4 * 4 + q;
        const bf16_t* zr = Z + (size_t)m * ZLD0 + 768 + col;
        f32x4 r = UNPK4(*(const u32x2*)zr), k = UNPK4(*(const u32x2*)(zr + 512)), v = UNPK4(*(const u32x2*)(zr + 1024));
        f32x4 rp = (f32x4){0.f, 0.f, 0.f, 0.f}, kp = rp, vp = rp;
        if ((m & (T_ - 1)) != 0) { rp = UNPK4(*(const u32x2*)(zr - ZLD0)); kp = UNPK4(*(const u32x2*)(zr + 512 - ZLD0)); vp = UNPK4(*(const u32x2*)(zr + 1024 - ZLD0)); }
        r += (rp - r) * mu_r; k += (kp - k) * mu_k; v += (vp - v) * mu_v;
        const f32x4 lw = UNPK4(*(const u32x2*)(L + (size_t)m * LLD + col)), la = UNPK4(*(const u32x2*)(L + (size_t)m * LLD + 512 + col));
        const f32x4 e = sig4(w0 + lw) * 0.60653065971f;
        const u32x2 eb = PK4(e);
        const f32x4 er = UNPK4(eb);
        const f32x4 wdec = (f32x4){__expf(-er.x), __expf(-er.y), __expf(-er.z), __expf(-er.w)};
        const f32x4 av = sig4(a0 + la);
        f32x4 kk = k * k_k;
        const float nrm = sqrtf(row16_sum((kk.x * kk.x + kk.y * kk.y) + (kk.z * kk.z + kk.w * kk.w)));
        kk = kk * (1.f / fmaxf(nrm, 1e-12f));
        const f32x4 kt = k * (1.f + (av - 1.f) * k_a);
        const f32x4 kka = kk * av;
        const f32x4 t1 = kka * r, t2 = kt * r, t3 = t2 * r_k;
        const float c1 = row16_sum((t1.x + t1.y) + (t1.z + t1.w)), c2 = row16_sum((t2.x + t2.y) + (t2.z + t2.w)), c3 = row16_sum((t3.x + t3.y) + (t3.z + t3.w));
        const size_t o = (size_t)m * 512 + col;
        const f32x4 wr = wdec * r;
        *(u32x4*)(KW + o) = (u32x4){pk2(kk.x, wr.x), pk2(kk.y, wr.y), pk2(kk.z, wr.z), pk2(kk.w, wr.w)}; *(u32x2*)(WE + o) = eb;
        *(u32x2*)(KKA + o) = PK4(kka); *(u32x2*)(KT + o) = PK4(kt); *(u32x2*)(VS + o) = PK4(v);
        if ((lane & 15) == 0) *(f32x4*)(C + (size_t)m * 32 + h * 4) = (f32x4){c1, c2, c3, 0.f};
    }
}

constexpr int SC_TS = 32, SC_D = 8, SC_BUF = 3 * SC_TS * 64 + SC_TS * 32 + SC_TS * 2;
__device__ __forceinline__ void scan_unit(int u, const unsigned* KW, const bf16_t* WE, const bf16_t* KKA, const bf16_t* KT, const bf16_t* VS, const float* C, float* Y, LAS unsigned char* lds, int tid) {
    const int half = u & 1, h = (u >> 1) & 7, b = u >> 4;
    const int il = tid >> 4, jg = tid & 15;
    LAS float* buf0 = (LAS float*)lds; LAS float* buf1 = buf0 + SC_BUF;
    f32x2 S01 = (f32x2){0.f, 0.f}, S23 = (f32x2){0.f, 0.f};
    const size_t rowbase = (size_t)b * T_;
    const size_t goff = (rowbase + il) * 512 + h * 64 + jg * 4;
    const size_t voff = (rowbase + il) * 512 + h * 64 + half * 32 + jg * 2;
    const unsigned* kwp = KW + rowbase * 512 + h * 64 + jg * 4;
    float* yp = Y + (rowbase + jg) * 512 + h * 64 + half * 32 + il;
    u32x2 rwe, rkka, rkt; unsigned rv; f32x2 rc;
#define SC_GLOAD(t0) do { const size_t d_ = (size_t)(t0) * 512; rwe = *(const u32x2*)(WE + goff + d_); \
        rkka = *(const u32x2*)(KKA + goff + d_); rkt = *(const u32x2*)(KT + goff + d_); rv = *(const unsigned*)(VS + voff + d_); \
        if (tid < SC_TS) rc = *(const f32x2*)(C + (rowbase + (t0) + tid) * 32 + h * 4); } while (0)
#define SC_EXP4(w) (f32x4){bf2f((w).x & 0xffffu), bf2f((w).x >> 16), bf2f((w).y & 0xffffu), bf2f((w).y >> 16)}
#define SC_LSTORE(bf) do { LAS float* p_ = (bf) + il * 64 + jg * 4; \
        { f32x4 e_ = SC_EXP4(rwe); *(LAS f32x4*)(p_) = (f32x4){__expf(-e_.x), __expf(-e_.y), __expf(-e_.z), __expf(-e_.w)}; } \
        *(LAS f32x4*)(p_ + 2048) = SC_EXP4(rkka); *(LAS f32x4*)(p_ + 4096) = SC_EXP4(rkt); \
        *(LAS f32x2*)((bf) + 6144 + il * 32 + jg * 2) = (f32x2){bf2f(rv & 0xffffu), bf2f(rv >> 16)}; \
        if (tid < SC_TS) *(LAS f32x2*)((bf) + 7168 + tid * 2) = rc; } while (0)
    u32x4 ring[SC_D];
#pragma unroll
    for (int d = 0; d < SC_D; ++d) ring[d] = *(const u32x4*)(kwp + (size_t)d * 512);
    __syncthreads();
    SC_GLOAD(0); SC_LSTORE(buf0);
    __syncthreads();
    float yacc = 0.f;
    for (int n = 0; n < T_ / SC_TS; ++n) {
        LAS float* cb = (n & 1) ? buf1 : buf0; LAS float* nb = (n & 1) ? buf0 : buf1;
        if (n + 1 < T_ / SC_TS) SC_GLOAD((n + 1) * SC_TS);
        const LAS float* B = cb + jg * 4;
        f32x4 w = *(const LAS f32x4*)B, kka = *(const LAS f32x4*)(B + 2048), kt = *(const LAS f32x4*)(B + 4096);
        float v = cb[6144 + il]; f32x2 c = *(const LAS f32x2*)(cb + 7168);
#pragma unroll
        for (int s = 0; s < SC_TS; ++s) {
            f32x4 wn = w, kkan = kka, ktn = kt; float vn = v; f32x2 cn = c;
            if (s + 1 < SC_TS) { wn = *(const LAS f32x4*)(B + (s + 1) * 64); kkan = *(const LAS f32x4*)(B + 2048 + (s + 1) * 64); ktn = *(const LAS f32x4*)(B + 4096 + (s + 1) * 64);
                vn = cb[6144 + (s + 1) * 32 + il]; cn = *(const LAS f32x2*)(cb + 7168 + (s + 1) * 2); }
            const u32x4 kw = ring[s % SC_D];
            { int tt = n * SC_TS + s + SC_D; tt = tt < T_ ? tt : T_ - 1; ring[s % SC_D] = *(const u32x4*)(kwp + (size_t)tt * 512); }
            const f32x2 p0 = (f32x2){__uint_as_float(kw.x << 16), __uint_as_float(kw.x)}, p1 = (f32x2){__uint_as_float(kw.y << 16), __uint_as_float(kw.y)};
            const f32x2 p2 = (f32x2){__uint_as_float(kw.z << 16), __uint_as_float(kw.z)}, p3 = (f32x2){__uint_as_float(kw.w << 16), __uint_as_float(kw.w)};
            f32x2 acc = p0 * S01.x; acc = p1 * S01.y + acc; acc = p2 * S23.x + acc; acc = p3 * S23.y + acc;
            const float sa = row16_sum(acc.x), uu = row16_sum(acc.y);
            const float y = uu - sa * c.x + v * c.y;
            yacc = (jg == (s & 15)) ? y : yacc;
            if ((s & 15) == 15) yp[(size_t)(n * SC_TS + s - 15) * 512] = yacc;
            const f32x2 w01 = (f32x2){w.x, w.y}, w23 = (f32x2){w.z, w.w}, a01 = (f32x2){kka.x, kka.y}, a23 = (f32x2){kka.z, kka.w}, k01 = (f32x2){kt.x, kt.y}, k23 = (f32x2){kt.z, kt.w};
            S01 = S01 * w01 + (k01 * v - a01 * sa); S23 = S23 * w23 + (k23 * v - a23 * sa);
            w = wn; kka = kkan; kt = ktn; v = vn; c = cn;
        }
        if (n + 1 < T_ / SC_TS) SC_LSTORE(nb);
        __syncthreads();
    }
#undef SC_GLOAD
#undef SC_EXP4
#undef SC_LSTORE
}

__device__ __forceinline__ void rwkv_post(const Args& a, const float* Y, const bf16_t* VS, const bf16_t* L, const float* C, bf16_t* O, int gw, int NGW, int lane) {
    const int h = gw & 7, col = h * 64 + (lane & 15) * 4, q = lane >> 4;
    const f32x4 lg = *(const f32x4*)(a.in[17] + col), lb = *(const f32x4*)(a.in[18] + col);
    for (int m4 = gw >> 3; m4 < M_ / 4; m4 += NGW >> 3) {
        const int m = m4 * 4 + q;
        const f32x4 y = *(const f32x4*)(Y + (size_t)m * 512 + col);
        const float mean = row16_sum((y.x + y.y) + (y.z + y.w)) * (1.f / 64.f); const f32x4 d = y - mean;
        const float var = row16_sum((d.x * d.x + d.y * d.y) + (d.z * d.z + d.w * d.w)) * (1.f / 64.f);
        const f32x4 yn = d * rsqrtf(var + GN_EPS) * lg + lb;
        const f32x4 v = UNPK4(*(const u32x2*)(VS + (size_t)m * 512 + col)), g = UNPK4(*(const u32x2*)(L + (size_t)m * LLD + 1024 + col));
        const float c3 = C[(size_t)m * 32 + h * 4 + 2];
        const f32x4 ov = (yn + v * c3) * g;
        *(u32x2*)(O + (size_t)m * DM + 512 + col) = PK4(ov);
    }
}

#define XB_TMO      128
#define XB_XCNT(j)  (256  + 64 * (j))
#define XB_XSUB(j)  (1280 + 64 * (j))
#define XB_XGEN(j)  (2304 + 64 * (j))
#define XB_TOP      3328
#define XB_TOPGEN   3392
#define XCD_BAR_WORDS 3456
#define XB_SPIN_CAP (1u << 18)

__device__ __forceinline__ unsigned xb_ld(unsigned* p)              { return __hip_atomic_load(p, __ATOMIC_RELAXED, __HIP_MEMORY_SCOPE_AGENT); }
__device__ __forceinline__ unsigned xb_add(unsigned* p, unsigned v) { return __hip_atomic_fetch_add(p, v, __ATOMIC_RELAXED, __HIP_MEMORY_SCOPE_AGENT); }
__device__ __forceinline__ unsigned xb_xcc_id() { return (unsigned)__builtin_amdgcn_s_getreg((3 << 11) | 20) & 0xFu; }
#define XB_SPIN(cond, bar) do { unsigned _sp = 0; while (cond) { __builtin_amdgcn_s_sleep(1); \
    if ((++_sp & 255u) == 0u) { if (xb_ld(&(bar)[XB_TMO])) break; if (_sp > XB_SPIN_CAP) { atomicAdd(&(bar)[XB_TMO], 1u); break; } } } } while (0)
struct XcdBarrier {
    unsigned* bar; unsigned x;
    volatile LAS unsigned* st;
};

__device__ __forceinline__ XcdBarrier xcd_barrier_post(unsigned* bar, volatile LAS unsigned* st) {
    XcdBarrier b; b.bar = bar; b.x = xb_xcc_id(); b.st = st;
    if (threadIdx.x == 0) (void)xb_add(&bar[XB_XCNT(b.x)], 1u);
    return b;
}
__device__ __forceinline__ void xcd_barrier_complete(unsigned* bar, unsigned x, unsigned& nloc, unsigned& nx) {
    const unsigned G = gridDim.x * gridDim.y * gridDim.z;
    unsigned sum, cnt, mine, sp = 0u;
    for (;;) {
        sum = 0u; cnt = 0u; mine = 0u;
#pragma unroll
        for (unsigned j = 0; j < 16; ++j) { const unsigned c = xb_ld(&bar[XB_XCNT(j)]); sum += c; cnt += (c > 0u) ? 1u : 0u; mine = (j == x) ? c : mine; }
        if (sum == G) break;
        __builtin_amdgcn_s_sleep(1);
        if ((++sp & 255u) == 0u) { if (xb_ld(&bar[XB_TMO])) break; if (sp > XB_SPIN_CAP) { atomicAdd(&bar[XB_TMO], 1u); break; } }
    }
    nloc = mine > 0u ? mine : 1u; nx = cnt > 0u ? cnt : 1u;
}

__device__ __forceinline__ void xcd_barrier(const XcdBarrier& b) {
    asm volatile("s_waitcnt vmcnt(0)" ::: "memory");
    __syncthreads();
    if (threadIdx.x == 0) {
        unsigned* bar = b.bar;
        __builtin_amdgcn_s_waitcnt(0);
        unsigned nloc = b.st[0], nx = b.st[1];
        if (nloc == 0u) { xcd_barrier_complete(bar, b.x, nloc, nx); b.st[0] = nloc; b.st[1] = nx; }
        const unsigned old = xb_add(&bar[XB_XSUB(b.x)], 1u);
        const unsigned gen = old / nloc;
        if (old + 1u == (gen + 1u) * nloc) {
            __builtin_amdgcn_fence(__ATOMIC_RELEASE, "agent");
            asm volatile("s_waitcnt vmcnt(0)" ::: "memory");
            const unsigned og = xb_add(&bar[XB_TOP], 1u);
            const unsigned tg = og / nx;
            if (og + 1u == (tg + 1u) * nx) xb_add(&bar[XB_TOPGEN], 1u);
            else XB_SPIN(xb_ld(&bar[XB_TOPGEN]) == tg, bar);
            __builtin_amdgcn_fence(__ATOMIC_ACQUIRE, "agent");
            xb_add(&bar[XB_XGEN(b.x)], 1u);
            asm volatile("s_waitcnt vmcnt(0)" ::: "memory");
        } else {
            XB_SPIN(xb_ld(&bar[XB_XGEN(b.x)]) == gen, bar);
            __builtin_amdgcn_fence(__ATOMIC_ACQUIRE, "agent");
            asm volatile("s_waitcnt vmcnt(0)" ::: "memory");
        }
    }
    __syncthreads();
}

__device__ __forceinline__ void run_gemm0(LAS unsigned char* lds, const bf16_t* A, const bf16_t* Bt, int M, int N, int K, int lda, bf16_t* Oo, int ldc, const float* rscale = nullptr) {
    pg8::Gemm g{A, Bt, M, N, K, lda, (size_t)128, 0}; pg8::StaticOrder S; S.init(M, N, (int)gridDim.x, (int)blockIdx.x);
    pg8::EpiStore<0> E{Oo, ldc, nullptr, rscale};

#ifndef NO_GEMM
    pg8::gemm_phase<pg8::EpiStore<0>, pg8::StaticOrder, true, true>(lds, g, S, E);
#endif
}


#define Wt_hyin ((bf16_t*)(ws + WS_HYIN))
#define Wt_hyout ((bf16_t*)(ws + WS_HYOUT))
#define Wt_nsain ((bf16_t*)(ws + WS_NSAIN))
#define Wt_nsaout ((bf16_t*)(ws + WS_NSAOUT))
#define Wt_lora ((bf16_t*)(ws + WS_LORA))
#define Wt_cw1k ((bf16_t*)(ws + WS_CW1K))
#define Wt_cw1v ((bf16_t*)(ws + WS_CW1V))
#define cbias ((float*)(ws + WS_CBIAS))
#define W2T ((bf16_t*)(ws + WS_CBIAS + 4096))
#define RS ((float*)(ws + WS_CBIAS + 131072))
#define H ((bf16_t*)(ws + WS_H))
#define Z ((bf16_t*)(ws + WS_Z))
#define AP ((bf16_t*)(ws + WS_AP))
#define O ((bf16_t*)(ws + WS_O))
#define L ((bf16_t*)(ws + WS_L))
#define C ((float*)(ws + WS_C))
#define MM ((bf16_t*)(ws + WS_MM))
#define Y ((float*)(ws + WS_MM))
#define HID ((bf16_t*)(ws + WS_HID))
#define KC ((bf16_t*)(ws + WS_KCMP))
#define VC ((bf16_t*)(ws + WS_VCMP))
#define U ((bf16_t*)(ws + WS_U))
#define HB ((float*)(ws + WS_O))
#define KW ((unsigned*)(ws + WS_H))
#define WE ((bf16_t*)(__attribute__((address_space(1))) bf16_t*)args.out)
#define KKA (WE + (size_t)M_ * 512)
#define KT (WE + (size_t)M_ * 1024)
#define VS (WE + (size_t)M_ * 1536)
#define XIN ((const float*)(__attribute__((address_space(1))) const float*)args.in[0])
#define X ((float*)(__attribute__((address_space(1))) float*)args.out)
#define PH_BEGIN unsigned char* const ws = args.ws; int tid_ = threadIdx.x; asm volatile("" : "+v"(tid_)); const int tid = tid_, lane = tid & 63, wave = __builtin_amdgcn_readfirstlane(tid >> 6); const int G = gridDim.x, gw = blockIdx.x * 8 + wave, NGW = G * 8; const int gtid = blockIdx.x * 512 + tid, NT = G * 512; (void)lane; (void)gw; (void)NGW; (void)gtid; (void)NT; (void)ws;
__global__ void __launch_bounds__(512, 2) mega_fwd(Args args) {
    extern __shared__ __attribute__((aligned(16))) unsigned char lds_raw[];
    LAS unsigned char* lds = (LAS unsigned char*)lds_raw;
    cg::grid_group grid = cg::this_grid();
    volatile LAS unsigned* xst = (volatile LAS unsigned*)(lds + LDS_BYTES - 64);
    if (threadIdx.x < 2) xst[threadIdx.x] = 0u;
    __syncthreads();
    const XcdBarrier xbar = xcd_barrier_post((unsigned*)args.ws, xst);
    const int lo = args.ph_lo, hi = args.ph_hi;
#define IN(k) (lo <= (k) && (k) < hi)
#ifndef DUP_MASK
#define DUP_MASK 0u
#endif
#define REP(k) for (int rep_ = 0; rep_ < (((DUP_MASK >> (k)) & 1u) ? 2 : 1); ++rep_)
#define SEAM(k) do { if (IN(k) && IN((k) + 1)) { if ((k) == 0) grid.sync(); else xcd_barrier(xbar); } } while (0)

#ifdef EXTRA_SYNCS
    if (IN(0) && IN(1)) for (int es_ = 0; es_ < EXTRA_SYNCS; ++es_) grid.sync();
#endif
    if (IN(0)) REP(0) { PH_BEGIN
        LAS float* scr = (LAS float*)(lds + wave * 16384);
        constexpr int I0 = 16 * 80, I1 = 16 * 32, I2 = 16 * 88, I3 = 16 * 32, I4 = 16 * 176, I5 = 44 * 32, I6 = 32 * 8;
        constexpr int NIT = I0 + I1 + I2 + I3 + 2 * I4 + 2 * I5 + 2 * I6;
        for (int it = gw; it < NIT; it += NGW) {
            int r = it;
            if (r < I0) { transpose_item(args.in[5], 2560, Wt_hyin, 1024, scr, r, 80, lane, args.in[1]); continue; } r -= I0;
            if (r < I1) { transpose_item(args.in[6], 1024, Wt_hyout, 1024, scr, r, 32, lane); continue; } r -= I1;
            if (r < I2) { transpose_item(args.in[19], 2608, Wt_nsain, 1024, scr, r, 88, lane, args.in[1] + 1024); continue; } r -= I2;
            if (r < I3) { transpose_item(args.in[20], 1024, Wt_nsaout, 1024, scr, r, 32, lane); continue; } r -= I3;
            if (r < 2 * I4) { const int l = r / I4; transpose_item(args.in[27] + (size_t)l * 1024 * 5632, 5632, (bf16_t*)(ws + (l ? WS_UP1 : WS_UP0)), 1024, scr, r % I4, 176, lane, args.in[3] + l * 1024, true); continue; } r -= 2 * I4;
            if (r < 2 * I5) { const int l = r / I5; transpose_item(args.in[30] + (size_t)l * 2816 * 1024, 1024, (bf16_t*)(ws + (l ? WS_DN1 : WS_DN0)), 2816, scr, r % I5, 32, lane); continue; } r -= 2 * I5;
            if (r < I6) { transpose_item(args.in[22], 256, Wt_cw1k, 2048, scr, r, 8, lane); continue; } r -= I6;
            transpose_item(args.in[25], 256, Wt_cw1v, 2048, scr, r, 8, lane);
        }
        for (int e = gtid; e < 1536 * 256; e += NT) {
            const int n = e >> 8, k = e & 255; float v = 0.f;
            if (n < 512) { if (k < 64) v = args.in[10][k * 512 + n]; }
            else if (n < 1024) { if (k >= 64 && k < 128) v = args.in[12][(k - 64) * 512 + (n - 512)]; }
            else { if (k >= 128) v = args.in[13][(k - 128) * 512 + (n - 1024)]; }
            Wt_lora[e] = (bf16_t)(pk2(v, 0.f) & 0xffffu);
        }
        for (int e = gtid; e < 2 * 16384; e += NT) { const int which = e >> 14, d = (e >> 8) & 63, f = e & 255; W2T[e] = (bf16_t)(pk2(args.in[which ? 26 : 23][f * 64 + d], 0.f) & 0xffffu); }
        for (int it = gw; it < 512; it += NGW) {
            const int which = it >> 8, f = it & 255; const float* pos = args.in[which ? 24 : 21]; const float* w1 = args.in[which ? 25 : 22];
            float s = 0.f;
            for (int e = lane; e < 2048; e += 64) s += pos[e] * w1[(size_t)e * 256 + f];
            s = wave_sum(s);
            if (lane == 0) cbias[it] = s;
        }
        norm_phase(XIN, nullptr, nullptr, nullptr, nullptr, H, RS, gw, NGW, lane);
    }
    SEAM(0);
    if (IN(1)) REP(1) { PH_BEGIN run_gemm0(lds, H, Wt_hyin, M_, ZLD0, 1024, 1024, Z, ZLD0, RS); }
    SEAM(1);
    if (IN(2)) REP(2) { PH_BEGIN
        const float* mu = args.in[8];
        for (int it = gtid; it < M_ * 32; it += NT) {
            const int m = it >> 5, col = (it & 31) * 8;
            const bf16_t* zp = Z + (size_t)m * ZLD0 + 2304 + col;
            const u32x4 zc = *(const u32x4*)zp; u32x4 zq = (u32x4){0u, 0u, 0u, 0u};
            if ((m & (T_ - 1)) != 0) zq = *(const u32x4*)(zp - ZLD0);
            const unsigned cw[4] = {zc.x, zc.y, zc.z, zc.w}, pw[4] = {zq.x, zq.y, zq.z, zq.w}; unsigned ow[4];
#pragma unroll
            for (int e = 0; e < 4; ++e) {
                float a0 = bf2f(cw[e] & 0xffffu), a1 = bf2f(cw[e] >> 16); const float p0 = bf2f(pw[e] & 0xffffu), p1 = bf2f(pw[e] >> 16);
                a0 += (p0 - a0) * mu[1536 + col + 2 * e]; a1 += (p1 - a1) * mu[1536 + col + 2 * e + 1];
                if (col < 64) { a0 = tanhf(a0); a1 = tanhf(a1); } else if (col >= 128) { a0 = sigmoidf_(a0); a1 = sigmoidf_(a1); }
                ow[e] = pk2(a0, a1);
            }
            *(u32x4*)(AP + (size_t)m * 256 + col) = (u32x4){ow[0], ow[1], ow[2], ow[3]};
        }

#ifndef NO_SWA
for (int u = blockIdx.x; u < NB_ * 64 * 2; u += G) swa_unit(u, Z, O, args.in[7], lds, tid);
#endif

        __syncthreads();
    }
    SEAM(2);
    if (IN(3)) REP(3) { PH_BEGIN run_gemm0(lds, AP, Wt_lora, M_, LLD, 256, 256, L, LLD); }
    SEAM(3);
    if (IN(4)) REP(4) { PH_BEGIN rwkv_prep(args, Z, L, KW, WE, KKA, KT, VS, C, gw, NGW, lane); }
    SEAM(4);
    if (IN(5)) REP(5) { PH_BEGIN
#ifndef NO_SCAN
for (int u = blockIdx.x; u < 256; u += G) scan_unit(u, KW, WE, KKA, KT, VS, C, Y, lds, tid);
#endif
 }
    SEAM(5);
    if (IN(6)) REP(6) { PH_BEGIN rwkv_post(args, Y, VS, L, C, O, gw, NGW, lane); }
    SEAM(6);
    if (IN(7)) REP(7) { PH_BEGIN run_gemm0(lds, O, Wt_hyout, M_, 1024, 1024, 1024, MM, 1024); }
    SEAM(7);
    if (IN(8)) REP(8) { PH_BEGIN norm_phase(XIN, nullptr, MM, args.in[2], nullptr, H, RS, gw, NGW, lane); }
    SEAM(8);
#pragma unroll
    for (int l = 0; l < 2; ++l) {
        const int pb = l ? 19 : 9;
        if (IN(pb)) REP(pb) { PH_BEGIN
            pg8::Gemm g{H, (const bf16_t*)(ws + (l ? WS_UP1 : WS_UP0)), M_, ULD, 1024, 1024, (size_t)128, 0}; pg8::StaticOrder S; S.init(M_, ULD, G, (int)blockIdx.x);
            pg8::EpiConv E{U, RS, args.in[28] + (size_t)l * 3 * FF_, args.in[29] + (size_t)l * FF_, HB};
            pg8::gemm_phase<pg8::EpiConv, pg8::StaticOrder, true, true>(lds, g, S, E);
        }
        SEAM(pb);
        if (IN(pb + 1)) REP(pb + 1) { PH_BEGIN
            const float* cw = args.in[28] + (size_t)l * 3 * FF_; const float* cbv = args.in[29] + (size_t)l * FF_;
            for (int e = gtid; e < 256 * 22 * 4 * 2 * 128; e += NT) {
                const int col = e & 127, r = (e >> 7) & 1, gq = e >> 8, gi = gq & 3, tp = gq >> 2, pn = tp % 22, pm = tp / 22, f = pn * 128 + col;
                const float* hb = HB + ((size_t)gq * 6) * 128 + col;
                const float* hp = gi > 0 ? hb - 6 * 128 : hb - (size_t)(22 * 4 - 3) * 6 * 128;
                const bool top = gi == 0 && ((pm * 256) & (T_ - 1)) == 0;
                const float g0 = hb[(2 + r) * 128], vv = hb[(4 + r) * 128];
                const float gm1 = r == 1 ? hb[2 * 128] : (top ? 0.f : hp[1 * 128]);
                const float gm2 = r == 1 ? (top ? 0.f : hp[1 * 128]) : (top ? 0.f : hp[0]);
                const float xv = cbv[f] + g0 * cw[2 * FF_ + f] + gm1 * cw[FF_ + f] + gm2 * cw[f];
                U[(size_t)(pm * 256 + gi * 64 + r) * FF_ + f] = (bf16_t)(pk2(pg8::gelu_tanh(xv) * vv, 0.f) & 0xffffu);
            }
        }
        SEAM(pb + 1);
        if (IN(pb + 2)) REP(pb + 2) { PH_BEGIN run_gemm0(lds, U, (const bf16_t*)(ws + (l ? WS_DN1 : WS_DN0)), M_, 1024, FF_, FF_, MM, 1024); }
        SEAM(pb + 2);
        if (IN(pb + 3)) REP(pb + 3) { PH_BEGIN
            if (l == 0) norm_phase(nullptr, H, MM, args.in[4], nullptr, H, RS, gw, NGW, lane);
            else norm_phase(nullptr, H, MM, args.in[4] + 1024, X, nullptr, nullptr, gw, NGW, lane);
        }
        if (l == 0) {
            SEAM(12);
            if (IN(13)) REP(13) { PH_BEGIN run_gemm0(lds, H, Wt_nsain, M_, ZLD1, 1024, 1024, Z, ZLD1, RS); }
            SEAM(13);
            if (IN(14)) REP(14) { PH_BEGIN
                const int G2 = G >> 1, which = (int)blockIdx.x >= G2 ? 1 : 0;
                pg8::Gemm g{Z + 1024 + which * 256, which ? Wt_cw1v : Wt_cw1k, 16384, 256, 2048, 16 * ZLD1, (size_t)ZLD1 * 2, 1};
                pg8::StaticOrder S; S.init(16384, 256, G2, (int)blockIdx.x - which * G2);
                pg8::EpiStore<2> E{HID + (size_t)which * 16384 * 256, 256, cbias + which * 256, nullptr};

#ifndef NO_GEMM2
if ((int)blockIdx.x < 2 * G2) pg8::gemm_phase<pg8::EpiStore<2>, pg8::StaticOrder, true, true>(lds, g, S, E);
#endif

            }
            SEAM(14);
            if (IN(15)) REP(15) { PH_BEGIN
                for (int wt = gw; wt < 2 * 512; wt += NGW) {
                    const int which = wt >> 9, row0 = (wt & 511) * 32, r32 = lane & 31, hi5 = lane >> 5;
                    const bf16_t* hp = HID + ((size_t)which * 16384 + row0 + r32) * 256 + hi5 * 8;
                    const bf16_t* wp = W2T + (size_t)which * 16384 + (size_t)r32 * 256 + hi5 * 8;
                    f32x16 c0, c1;
#pragma unroll
                    for (int r = 0; r < 16; ++r) { c0[r] = 0.f; c1[r] = 0.f; }
#pragma unroll 4
                    for (int ks = 0; ks < 16; ++ks) {
                        const bf16x8 av = *(const bf16x8*)(hp + ks * 16), b0 = *(const bf16x8*)(wp + ks * 16), b1 = *(const bf16x8*)(wp + 32 * 256 + ks * 16);
                        c0 = __builtin_amdgcn_mfma_f32_32x32x16_bf16(av, b0, c0, 0, 0, 0);
                        c1 = __builtin_amdgcn_mfma_f32_32x32x16_bf16(av, b1, c1, 0, 0, 0);
                    }
                    bf16_t* op = (which ? VC : KC) + (size_t)row0 * 64 + r32;
#pragma unroll
                    for (int r = 0; r < 16; ++r) { const int rw = crow(r, hi5); const bool pad = ((row0 + rw) & 255) == 255;
                        op[(size_t)rw * 64] = pad ? (bf16_t)0 : (bf16_t)(pk2(c0[r], 0.f) & 0xffffu); op[(size_t)rw * 64 + 32] = pad ? (bf16_t)0 : (bf16_t)(pk2(c1[r], 0.f) & 0xffffu); }
                }
            }
            SEAM(15);
            if (IN(16)) REP(16) { PH_BEGIN
#ifndef NO_NSA
{
                    unsigned* qctr = (unsigned*)args.ws + 3840 + rep_ * 16;
                    volatile LAS unsigned* qslot = (volatile LAS unsigned*)(lds + LDS_BYTES - 128);
                    for (;;) {
                        if (tid == 0) qslot[0] = atomicAdd(qctr, 1u);
                        __syncthreads();
                        const unsigned q = qslot[0];
                        __syncthreads();
                        if (q >= 4096u) break;
                        int ui, ug, ub;
                        if (q < 1024u) { ug = 3; ui = 63 - (int)(q >> 4); ub = (int)(q & 15u); }
                        else { const unsigned q2 = q - 1024u; ui = 63 - (int)(q2 / 48u); const unsigned rest = q2 % 48u; ug = (int)(rest % 3u); ub = (int)(rest / 3u); }
                        nsa_unit((ui << 6) | (ub << 2) | ug, Z, KC, VC, O, lds, tid);
                    }
                }
#endif
 }
            SEAM(16);
            if (IN(17)) REP(17) { PH_BEGIN run_gemm0(lds, O, Wt_nsaout, M_, 1024, 1024, 1024, MM, 1024); }
            SEAM(17);
            if (IN(18)) REP(18) { PH_BEGIN norm_phase(nullptr, H, MM, args.in[2] + 1024, nullptr, H, RS, gw, NGW, lane); }
            SEAM(18);
        }
    }
#undef IN
#undef SEAM
}

#undef XIN
#undef X
#undef H
#undef Z
#undef O
#undef L
#undef C
#undef U
#undef Y
extern "C" void kernel_launch(void* const* d_in, const int* in_sizes, int n_in, void* d_out, int out_size, void* d_ws, size_t ws_size, hipStream_t stream) {
    static int grid = 0;
    if (grid == 0) {
        if (n_in != 31 || out_size != M_ * DM || ws_size < WS_END) { fprintf(stderr, "kernel_launch: unexpected shapes (n_in %d out %d ws %zu)\n", n_in, out_size, ws_size); grid = -1; return; }
        int dev = 0, cus = 0, per_cu = 0;
        hipGetDevice(&dev); hipDeviceGetAttribute(&cus, hipDeviceAttributeMultiprocessorCount, dev);
        hipFuncSetAttribute((const void*)mega_fwd, hipFuncAttributeMaxDynamicSharedMemorySize, LDS_BYTES);
        hipOccupancyMaxActiveBlocksPerMultiprocessor(&per_cu, (const void*)mega_fwd, 512, LDS_BYTES);
        if (per_cu < 1) { fprintf(stderr, "kernel_launch: occupancy query says %d blocks/CU\n", per_cu); per_cu = 1; }
        (void)hipGetLastError();
        grid = cus * 1;
    }
    if (grid < 0) return;
    hipMemsetAsync(d_ws, 0, 16384, stream);
    Args a{};
    for (int i = 0; i < 31; ++i) a.in[i] = (const float*)d_in[i];
    a.out = (float*)d_out; a.ws = (unsigned char*)d_ws;
#if ONE_LAUNCH
    a.ph_lo = 0; a.ph_hi = NPHASE;
    void* kargs[] = {&a};
    hipError_t e = hipLaunchCooperativeKernel((const void*)mega_fwd, dim3(grid), dim3(512), kargs, LDS_BYTES, stream);
    if (e != hipSuccess) fprintf(stderr, "cooperative launch failed: %s (grid %d)\n", hipGetErrorString(e), grid);
#else
    for (int p = 0; p < NPHASE; ++p) { a.ph_lo = p; a.ph_hi = p + 1; hipLaunchKernelGGL(mega_fwd, dim3(grid), dim3(512), LDS_BYTES, stream, a); }
#endif
}
```
